# Optimizing an MI355X kernel written in HIP

```python
import math
import jax, jax.numpy as jnp
from jax import lax
import numpy as np

D_MODEL = 1024
BATCH = 1
SEQ = 16384
DEPTH = 2
DEC_BATCH = 128
DEC_SEQ = 8
PAST_LEN = 16384
PAGE_SIZE = 128

A_HEADS = 8
A_KV_HEADS = 2
A_GROUP = A_HEADS // A_KV_HEADS
A_HEAD_DIM = 64
WINDOW = 128
ATTN_BLOCK = 128
B_HEADS = 4
B_KEY_DIM = 128
B_VAL_DIM = 128
RET_CHUNK = 128
S5_GROUP = 16
S5_GROUPS = D_MODEL // S5_GROUP
S5_STATE = 64
SSM_CHUNK = 128
D_FF = ((8 * D_MODEL + 3 * 256 - 1) // (3 * 256)) * 256
IN_WIDTHS = (A_HEADS * A_HEAD_DIM, A_KV_HEADS * A_HEAD_DIM, A_KV_HEADS * A_HEAD_DIM,
             B_HEADS * B_KEY_DIM, B_HEADS * B_KEY_DIM, B_HEADS * B_VAL_DIM, B_HEADS * B_VAL_DIM)
IN_WIDTH = sum(IN_WIDTHS)
MIX_WIDTH = A_HEADS * A_HEAD_DIM + B_HEADS * B_VAL_DIM
N_EVEN = (DEPTH + 1) // 2
N_ODD = DEPTH // 2
EPS = 1e-6
NEG_INF = -1e30

kernel_name = 'hybrid_swa_sink_retention_s5_decoder_step'


def rmsnorm(x, g):
    xf = x.astype(jnp.float32)
    y = xf * lax.rsqrt(jnp.mean(xf * xf, axis=-1, keepdims=True) + EPS)
    return (y * g.astype(jnp.float32)).astype(x.dtype)


def alibi_slopes():
    h = jnp.arange(1, A_HEADS + 1, dtype=jnp.float32)
    return jnp.exp2(-8.0 * h / A_HEADS).reshape(A_KV_HEADS, A_GROUP)


def split_cols(proj):
    idx, acc = [], 0
    for w in IN_WIDTHS[:-1]:
        acc += w
        idx.append(acc)
    return jnp.split(proj, idx, axis=-1)


def sink_attention(q, k, v, dist, valid, sinks):
    s = jnp.einsum('...qkgd,...skd->...kgqs', q.astype(jnp.float32), k.astype(jnp.float32)) * (A_HEAD_DIM ** -0.5)
    s = s - alibi_slopes()[:, :, None, None] * dist[..., None, None, :, :].astype(jnp.float32)
    s = jnp.where(valid[..., None, None, :, :], s, NEG_INF)
    sink = jnp.broadcast_to(sinks.astype(jnp.float32).reshape(A_KV_HEADS, A_GROUP)[:, :, None, None],
                            s.shape[:-1] + (1,))
    p = jax.nn.softmax(jnp.concatenate([s, sink], axis=-1), axis=-1)[..., :-1]
    return jnp.einsum('...kgqs,...skd->...qkgd', p, v.astype(jnp.float32))


def swa_prompt(q, k, v, sinks):
    bsz, L = q.shape[:2]
    nb = L // ATTN_BLOCK
    qb = q.reshape(bsz, nb, ATTN_BLOCK, A_KV_HEADS, A_GROUP, A_HEAD_DIM)

    def with_prev(t):
        tb = t.reshape(bsz, nb, ATTN_BLOCK, A_KV_HEADS, A_HEAD_DIM)
        prev = jnp.pad(tb, ((0, 0), (1, 0), (0, 0), (0, 0), (0, 0)))[:, :-1]
        return jnp.concatenate([prev, tb], axis=2)

    kb, vb = with_prev(k), with_prev(v)
    blk = jnp.arange(nb)[:, None] * ATTN_BLOCK
    q_pos = blk + jnp.arange(ATTN_BLOCK)[None, :]
    k_pos = blk - ATTN_BLOCK + jnp.arange(2 * ATTN_BLOCK)[None, :]
    dist = q_pos[:, :, None] - k_pos[:, None, :]
    valid = (dist >= 0) & (dist < WINDOW) & (k_pos[:, None, :] >= 0)
    o = sink_attention(qb, kb, vb, dist, valid, sinks)
    return o.reshape(bsz, L, A_HEADS * A_HEAD_DIM)


def swa_sample(q, k, v, cache_k, cache_v, sinks):
    bsz, L = q.shape[:2]
    W = cache_k.shape[1]
    k_all = jnp.concatenate([cache_k.astype(k.dtype), k], axis=1)
    v_all = jnp.concatenate([cache_v.astype(v.dtype), v], axis=1)
    q_pos = PAST_LEN + jnp.arange(L)
    k_pos = PAST_LEN - W + jnp.arange(W + L)
    dist = q_pos[:, None] - k_pos[None, :]
    valid = (dist >= 0) & (dist < WINDOW)
    o = sink_attention(q, k_all, v_all, dist, valid, sinks)
    return o.reshape(bsz, L, A_HEADS * A_HEAD_DIM), k_all[:, L:], v_all[:, L:]


def retention(q, k, v, S0):
    bsz, L = q.shape[:2]
    blk = min(RET_CHUNK, L)
    nc = L // blk
    log_g = jnp.log1p(-jnp.exp2(-5.0 - jnp.arange(B_HEADS, dtype=jnp.float32)))
    idx = jnp.arange(blk, dtype=jnp.float32)
    diff = idx[:, None] - idx[None, :]
    decay_in = jnp.where(diff >= 0, jnp.exp(log_g[:, None, None] * jnp.maximum(diff, 0.0)), 0.0)
    decay_q = jnp.exp(log_g[None, :] * (idx[:, None] + 1.0))
    decay_k = jnp.exp(log_g[None, :] * (blk - 1.0 - idx[:, None]))
    decay_c = jnp.exp(log_g * blk)

    def chunks(t):
        return t.astype(jnp.float32).reshape(bsz, nc, blk, B_HEADS, t.shape[-1]).transpose(1, 0, 2, 3, 4)

    def step(S, xs):
        qc, kc, vc = xs
        inner = jnp.einsum('bihd,bjhd->bhij', qc, kc) * decay_in
        o = (jnp.einsum('bhij,bjhe->bihe', inner, vc)
             + jnp.einsum('bihd,bhde->bihe', qc, S) * decay_q[None, :, :, None])
        S = S * decay_c[None, :, None, None] + jnp.einsum('bjhd,bjhe->bhde', kc * decay_k[None, :, :, None], vc)
        return S, o

    S, o = lax.scan(step, S0.astype(jnp.float32), (chunks(q), chunks(k), chunks(v)))
    return o.transpose(1, 0, 2, 3, 4).reshape(bsz, L, B_HEADS, B_VAL_DIM), S


def s5_scan(u, h_re, h_im, A_re, A_im, log_dt, B_re, B_im, C_re, C_im, D_skip):
    f32 = jnp.float32
    bsz, L, _ = u.shape
    A_re, A_im = A_re.astype(f32), A_im.astype(f32)
    dt = jnp.exp(log_dt.astype(f32))[:, None]
    mag = jnp.exp(A_re * dt)
    lam_re, lam_im = mag * jnp.cos(A_im * dt), mag * jnp.sin(A_im * dt)
    den = A_re * A_re + A_im * A_im
    n_re, n_im = lam_re - 1.0, lam_im
    f_re = (n_re * A_re + n_im * A_im) / den
    f_im = (n_im * A_re - n_re * A_im) / den
    Br, Bi = B_re.astype(f32), B_im.astype(f32)
    bb_re = f_re[..., None] * Br - f_im[..., None] * Bi
    bb_im = f_re[..., None] * Bi + f_im[..., None] * Br
    Cr, Ci = C_re.astype(f32), C_im.astype(f32)
    blk = min(SSM_CHUNK, L)
    nc = L // blk
    uf = u.astype(f32)
    uc = uf.reshape(bsz, nc, blk, S5_GROUPS, S5_GROUP).transpose(1, 0, 2, 3, 4)

    def combine(e1, e2):
        a1r, a1i, b1r, b1i = e1
        a2r, a2i, b2r, b2i = e2
        return (a2r * a1r - a2i * a1i, a2r * a1i + a2i * a1r,
                a2r * b1r - a2i * b1i + b2r, a2r * b1i + a2i * b1r + b2i)

    def step(carry, x):
        hr, hi = carry
        bu_re = jnp.einsum('bcgi,gpi->bcgp', x, bb_re)
        bu_im = jnp.einsum('bcgi,gpi->bcgp', x, bb_im)
        bu_re = bu_re.at[:, 0].add(lam_re * hr - lam_im * hi)
        bu_im = bu_im.at[:, 0].add(lam_re * hi + lam_im * hr)
        a_re = jnp.broadcast_to(lam_re, bu_re.shape)
        a_im = jnp.broadcast_to(lam_im, bu_im.shape)
        _, _, hs_re, hs_im = lax.associative_scan(combine, (a_re, a_im, bu_re, bu_im), axis=1)
        y = jnp.einsum('bcgp,gip->bcgi', hs_re, Cr) - jnp.einsum('bcgp,gip->bcgi', hs_im, Ci)
        return (hs_re[:, -1], hs_im[:, -1]), y

    (hr, hi), ys = lax.scan(step, (h_re.astype(f32), h_im.astype(f32)), uc)
    y = ys.transpose(1, 0, 2, 3, 4).reshape(bsz, L, D_MODEL) + D_skip.astype(f32) * uf
    return y, hr, hi


def mix_even(h, w_in, q_gain, k_gain, sinks, ret_gain, w_out, cache_k, cache_v, ret_state):
    bsz, L, _ = h.shape
    q_a, k_a, v_a, q_b, k_b, v_b, g_b = split_cols(h @ w_in)
    q_a = rmsnorm(q_a.reshape(bsz, L, A_KV_HEADS, A_GROUP, A_HEAD_DIM), q_gain)
    k_a = rmsnorm(k_a.reshape(bsz, L, A_KV_HEADS, A_HEAD_DIM), k_gain)
    v_a = v_a.reshape(bsz, L, A_KV_HEADS, A_HEAD_DIM)
    if cache_k is None:
        o_a = swa_prompt(q_a, k_a, v_a, sinks)
        keep = min(WINDOW, L)
        new_k, new_v = k_a[:, L - keep:], v_a[:, L - keep:]
        ret_state = jnp.zeros((bsz, B_HEADS, B_KEY_DIM, B_VAL_DIM), jnp.float32)
    else:
        o_a, new_k, new_v = swa_sample(q_a, k_a, v_a, cache_k, cache_v, sinks)
    o_b, new_s = retention(q_b.reshape(bsz, L, B_HEADS, B_KEY_DIM),
                           k_b.reshape(bsz, L, B_HEADS, B_KEY_DIM) * (B_KEY_DIM ** -0.5),
                           v_b.reshape(bsz, L, B_HEADS, B_VAL_DIM), ret_state)
    mu = jnp.mean(o_b, axis=-1, keepdims=True)
    var = jnp.mean(jnp.square(o_b - mu), axis=-1, keepdims=True)
    o_b = (o_b - mu) * lax.rsqrt(var + EPS) * ret_gain.astype(jnp.float32).reshape(B_HEADS, B_VAL_DIM)
    o_b = o_b.reshape(bsz, L, B_HEADS * B_VAL_DIM).astype(h.dtype) * jax.nn.silu(g_b)
    o = jnp.concatenate([o_a.astype(h.dtype), o_b], axis=-1) @ w_out
    return o, new_k, new_v, new_s


def mix_odd(h, A_re, A_im, log_dt, B_re, B_im, C_re, C_im, D_skip, glu_a, glu_b, s_re, s_im):
    bsz = h.shape[0]
    if s_re is None:
        s_re = jnp.zeros((bsz, S5_GROUPS, S5_STATE), jnp.float32)
        s_im = jnp.zeros((bsz, S5_GROUPS, S5_STATE), jnp.float32)
    y, n_re, n_im = s5_scan(h, s_re, s_im, A_re, A_im, log_dt, B_re, B_im, C_re, C_im, D_skip)
    y = jax.nn.gelu(y).astype(h.dtype)
    return (y @ glu_a) * jax.nn.sigmoid(y @ glu_b), n_re, n_im


def swiglu(h, wg, wu, wd):
    return (jax.nn.silu(h @ wg) * (h @ wu)) @ wd


def trunk(x, c, cache_k, cache_v, ret, s5r, s5i, p):
    ks, vs, rets, res, ims = [], [], [], [], []
    for layer in range(DEPTH):
        i = layer // 2
        mod = jax.nn.silu(c) @ p['ada_w'][layer] + p['ada_b'][layer]
        sh1, sc1, g1, sh2, sc2, g2 = [m[:, None, :] for m in jnp.split(mod, 6, axis=-1)]
        h = rmsnorm(x, p['norm_mix'][layer]) * (1.0 + sc1) + sh1
        if layer % 2 == 0:
            out, nk, nv, ns = mix_even(
                h, p['even_w_in'][i], p['even_q_gain'][i], p['even_k_gain'][i], p['even_sinks'][i],
                p['even_ret_gain'][i], p['even_w_out'][i],
                None if cache_k is None else cache_k[i], None if cache_v is None else cache_v[i],
                None if ret is None else ret[i])
            ks.append(nk); vs.append(nv); rets.append(ns)
        else:
            out, nr, ni = mix_odd(
                h, p['odd_A_re'][i], p['odd_A_im'][i], p['odd_log_dt'][i], p['odd_B_re'][i], p['odd_B_im'][i],
                p['odd_C_re'][i], p['odd_C_im'][i], p['odd_D'][i], p['odd_glu_a'][i], p['odd_glu_b'][i],
                None if s5r is None else s5r[i], None if s5i is None else s5i[i])
            res.append(nr); ims.append(ni)
        x = x + g1 * out
        h = rmsnorm(x, p['norm_ffn'][layer]) * (1.0 + sc2) + sh2
        x = x + g2 * swiglu(h, p['ffn_wg'][layer], p['ffn_wu'][layer], p['ffn_wd'][layer])
    return x, jnp.stack(ks), jnp.stack(vs), jnp.stack(rets), jnp.stack(res), jnp.stack(ims)


def setup_inputs(seed: int = 0) -> dict:
    key = jax.random.key(seed)
    k = jax.random.split(key, 40)

    def nrm(kk, shape, scale=1.0):
        return scale * jax.random.normal(kk, shape, jnp.float32)

    W = min(WINDOW, PAST_LEN)
    n = jnp.arange(S5_STATE, dtype=jnp.float32)
    return {
        'x_prompt': nrm(k[0], (BATCH, SEQ, D_MODEL)),
        'x_sample': nrm(k[1], (DEC_BATCH, DEC_SEQ, D_MODEL)),
        'cache_win_k': nrm(k[2], (N_EVEN, DEC_BATCH, W, A_KV_HEADS, A_HEAD_DIM)),
        'cache_win_v': nrm(k[3], (N_EVEN, DEC_BATCH, W, A_KV_HEADS, A_HEAD_DIM)),
        'state_ret': nrm(k[4], (N_EVEN, DEC_BATCH, B_HEADS, B_KEY_DIM, B_VAL_DIM)),
        'state_s5_re': nrm(k[5], (N_ODD, DEC_BATCH, S5_GROUPS, S5_STATE), 0.2),
        'state_s5_im': nrm(k[6], (N_ODD, DEC_BATCH, S5_GROUPS, S5_STATE), 0.2),
        'c_prompt': nrm(k[7], (BATCH, D_MODEL)),
        'c_sample': nrm(k[8], (DEC_BATCH, D_MODEL)),
        'ada_w': nrm(k[9], (DEPTH, D_MODEL, 6 * D_MODEL), 0.5 * D_MODEL ** -0.5),
        'ada_b': nrm(k[10], (DEPTH, 6 * D_MODEL), 0.05),
        'norm_mix': 1.0 + nrm(k[11], (DEPTH, D_MODEL), 0.02),
        'norm_ffn': 1.0 + nrm(k[12], (DEPTH, D_MODEL), 0.02),
        'ffn_wg': nrm(k[13], (DEPTH, D_MODEL, D_FF), D_MODEL ** -0.5),
        'ffn_wu': nrm(k[14], (DEPTH, D_MODEL, D_FF), D_MODEL ** -0.5),
        'ffn_wd': nrm(k[15], (DEPTH, D_FF, D_MODEL), D_FF ** -0.5),
        'even_w_in': nrm(k[16], (N_EVEN, D_MODEL, IN_WIDTH), D_MODEL ** -0.5),
        'even_q_gain': 1.0 + nrm(k[17], (N_EVEN, A_HEAD_DIM), 0.02),
        'even_k_gain': 1.0 + nrm(k[18], (N_EVEN, A_HEAD_DIM), 0.02),
        'even_sinks': nrm(k[19], (N_EVEN, A_HEADS), 0.5),
        'even_ret_gain': 1.0 + nrm(k[20], (N_EVEN, B_HEADS * B_VAL_DIM), 0.02),
        'even_w_out': nrm(k[21], (N_EVEN, MIX_WIDTH, D_MODEL), MIX_WIDTH ** -0.5),
        'odd_A_re': -0.5 + nrm(k[22], (N_ODD, S5_GROUPS, S5_STATE), 0.01),
        'odd_A_im': math.pi * n + nrm(k[23], (N_ODD, S5_GROUPS, S5_STATE), 0.01),
        'odd_log_dt': jax.random.uniform(k[24], (N_ODD, S5_GROUPS), jnp.float32, math.log(0.001), math.log(0.1)),
        'odd_B_re': nrm(k[25], (N_ODD, S5_GROUPS, S5_STATE, S5_GROUP), (2.0 * S5_GROUP) ** -0.5),
        'odd_B_im': nrm(k[26], (N_ODD, S5_GROUPS, S5_STATE, S5_GROUP), (2.0 * S5_GROUP) ** -0.5),
        'odd_C_re': nrm(k[27], (N_ODD, S5_GROUPS, S5_GROUP, S5_STATE), S5_STATE ** -0.5),
        'odd_C_im': nrm(k[28], (N_ODD, S5_GROUPS, S5_GROUP, S5_STATE), S5_STATE ** -0.5),
        'odd_D': nrm(k[29], (N_ODD, D_MODEL), 0.5),
        'odd_glu_a': nrm(k[30], (N_ODD, D_MODEL, D_MODEL), D_MODEL ** -0.5),
        'odd_glu_b': nrm(k[31], (N_ODD, D_MODEL, D_MODEL), D_MODEL ** -0.5),
    }


def reference(x_prompt, x_sample, cache_win_k, cache_win_v, state_ret, state_s5_re, state_s5_im,
              c_prompt, c_sample, ada_w, ada_b, norm_mix, norm_ffn, ffn_wg, ffn_wu, ffn_wd,
              even_w_in, even_q_gain, even_k_gain, even_sinks, even_ret_gain, even_w_out,
              odd_A_re, odd_A_im, odd_log_dt, odd_B_re, odd_B_im, odd_C_re, odd_C_im, odd_D,
              odd_glu_a, odd_glu_b):
    p = dict(ada_w=ada_w, ada_b=ada_b, norm_mix=norm_mix, norm_ffn=norm_ffn,
             ffn_wg=ffn_wg, ffn_wu=ffn_wu, ffn_wd=ffn_wd,
             even_w_in=even_w_in, even_q_gain=even_q_gain, even_k_gain=even_k_gain,
             even_sinks=even_sinks, even_ret_gain=even_ret_gain, even_w_out=even_w_out,
             odd_A_re=odd_A_re, odd_A_im=odd_A_im, odd_log_dt=odd_log_dt,
             odd_B_re=odd_B_re, odd_B_im=odd_B_im, odd_C_re=odd_C_re, odd_C_im=odd_C_im,
             odd_D=odd_D, odd_glu_a=odd_glu_a, odd_glu_b=odd_glu_b)
    y_prompt, p_k, p_v, p_ret, p_re, p_im = trunk(x_prompt, c_prompt, None, None, None, None, None, p)
    y_sample, s_k, s_v, s_ret, s_re, s_im = trunk(x_sample, c_sample, cache_win_k, cache_win_v,
                                                  state_ret, state_s5_re, state_s5_im, p)
    return (y_prompt, y_sample, p_k, p_v, p_ret, p_re, p_im, s_k, s_v, s_ret, s_re, s_im)
```

```cpp
#include <hip/hip_runtime.h>
#include <hip/hip_cooperative_groups.h>
#include <cstdio>
#include <cstdint>
namespace cg = cooperative_groups;
namespace pg8 {
#define PG8_LAS __attribute__((address_space(3)))
typedef unsigned short bf16_t;
typedef short bf16x8 __attribute__((ext_vector_type(8)));
typedef float f32x4 __attribute__((ext_vector_type(4)));
typedef unsigned u32x4 __attribute__((ext_vector_type(4)));
constexpr int BM = 256, BK = 64, HALF = 128, HTB = HALF * BK * 2  , STAGE_BYTES = 8 * HTB, NXCD = 8, WGM = 8;

__host__ __device__ __forceinline__ int lds_byte(int r, int c) { const int st = (r >> 4) * 2 + (c >> 5), rr = r & 15, cc = c & 31, ob = rr * 64 + cc * 2; return st * 1024 + (ob ^ (((ob >> 9) & 1) << 5)); }
__host__ __device__ __forceinline__ void stage_rc(int b, int& R, int& C) { const int st = b / 1024, sb = b % 1024, swz = sb ^ (((sb >> 9) & 1) << 5); R = (st >> 1) * 16 + swz / 64; C = (st & 1) * 32 + (swz % 64) / 2; }
__host__ __device__ __forceinline__ int perm32(int rho) { const int n = rho >> 4, i = rho & 15; return 8 * (i >> 2) + 4 * n + (i & 3); }

struct Unit { int pm, pn, ks; };
struct Gemm { const bf16_t* A; const bf16_t* Bt; int M, N, K, ld; };

struct StaticOrder {
    int nM, nN, nwg, G, c;
    __host__ __device__ void init(int M, int N, int G_, int c_) { nM = M / BM; nN = N / BM; nwg = nM * nN; G = G_; c = c_; }
    __host__ __device__ bool next(int i, Unit& u) const {
        const long L = (long)i * G + c; if (L >= nwg) return false;
        int wgid = (int)L; { const int q = nwg / NXCD, r = nwg % NXCD, xcd = wgid % NXCD, off = wgid / NXCD; wgid = (xcd < r ? xcd * (q + 1) : r * (q + 1) + (xcd - r) * q) + off; }
        const int nig = WGM * nN, gid = wgid / nig, fm = gid * WGM, gsz = (nM - fm) < WGM ? (nM - fm) : WGM;
        u.pm = fm + ((wgid % nig) % gsz); u.pn = (wgid % nig) / gsz; u.ks = 0; return true;
    }
    __device__ __forceinline__ void a_ready(const Unit&) const {}
    __device__ __forceinline__ void done(const Unit&) const {}
};

struct SplitOrder {
    int nM, nN, nwg, G, c;
    __host__ __device__ void init(int nM_, int nN_, int S, int G_, int c_) { nM = nM_; nN = nN_; nwg = nM_ * nN_ * S; G = G_; c = c_; }
    __host__ __device__ bool next(int i, Unit& u) const { const int L = i * G + c; if (L >= nwg) return false; const int t = nM * nN, r = L % t; u.ks = L / t; u.pm = r % nM; u.pn = r / nM; return true; }
    __device__ __forceinline__ void a_ready(const Unit&) const {}
    __device__ __forceinline__ void done(const Unit&) const {}
};
__device__ __forceinline__ unsigned cvt_pk_bf16(float lo, float hi) { unsigned r; asm volatile("v_cvt_pk_bf16_f32 %0, %1, %2" : "=v"(r) : "v"(lo), "v"(hi)); return r; }
typedef float f32x2 __attribute__((ext_vector_type(2)));
__device__ __forceinline__ f32x2 gelu_pk(f32x2 v) {
    const f32x2 av = __builtin_elementwise_abs(v), d = av * 0.2316418882f + 1.0f;
    f32x2 t; t.x = __builtin_amdgcn_rcpf(d.x); t.y = __builtin_amdgcn_rcpf(d.y);
    f32x2 q = t * 0.5307027145f + (-0.7265760135f); q = q * t + 0.7107068705f; q = q * t + (-0.142248368f); q = q * t + 0.127414796f; q = q * t;
    const f32x2 s = (v * v) * (-0.72134752044f);
    f32x2 e; e.x = __builtin_amdgcn_exp2f(s.x); e.y = __builtin_amdgcn_exp2f(s.y);
    const f32x2 m = v * (q * e), r = v - m;
    f32x2 o; o.x = v.x < 0.f ? m.x : r.x; o.y = v.y < 0.f ? m.y : r.y; return o;
}

template <int ACT  > struct EpiBf16 {
    static constexpr bool PERM = true, AFTER_DRAIN = false; static_assert(ACT == 0 || ACT == 1, "EpiBf16: ACT is 0 (none) or 1 (gelu_pk)");
    bf16_t* O; int ldc; const float* bias; int split_cols; size_t split_stride; float scale0;
    __device__ __forceinline__ void operator()(const f32x4 (&acc)[2][2][4][2], const Unit& u, int wr, int wc, int fr, int fq) const {
        const int row0 = u.pm * BM + wr * 64 + fr; int colt = u.pn * BM; bf16_t* base = O;
        float sc = 1.f; if (split_cols) { const int t = colt / split_cols; base += (size_t)t * split_stride; colt -= t * split_cols; if (t == 0) sc = scale0; }
        const int col0 = colt + wc * 32 + 8 * fq, bcol0 = u.pn * BM + wc * 32 + 8 * fq;
        f32x4 bv[2][2];
#pragma unroll
        for (int bj = 0; bj < 2; ++bj)
#pragma unroll
            for (int n = 0; n < 2; ++n) bv[bj][n] = bias ? *(const f32x4*)(bias + bcol0 + bj * HALF + 4 * n) : (f32x4){0.f, 0.f, 0.f, 0.f};
#pragma unroll
        for (int ai = 0; ai < 2; ++ai)
#pragma unroll
            for (int m = 0; m < 4; ++m) { bf16_t* rowp = base + (size_t)(row0 + ai * HALF + m * 16) * ldc + col0;
#pragma unroll
                for (int bj = 0; bj < 2; ++bj) { f32x4 v0 = acc[ai][bj][m][0] + bv[bj][0], v1 = acc[ai][bj][m][1] + bv[bj][1];
                    if (ACT == 1) { f32x2 a = gelu_pk((f32x2){v0[0], v0[1]}), b = gelu_pk((f32x2){v0[2], v0[3]}), c = gelu_pk((f32x2){v1[0], v1[1]}), d = gelu_pk((f32x2){v1[2], v1[3]});
                        v0 = (f32x4){a.x, a.y, b.x, b.y}; v1 = (f32x4){c.x, c.y, d.x, d.y}; }
                    v0 = v0 * sc; v1 = v1 * sc; u32x4 w; w.x = cvt_pk_bf16(v0[0], v0[1]); w.y = cvt_pk_bf16(v0[2], v0[3]); w.z = cvt_pk_bf16(v1[0], v1[1]); w.w = cvt_pk_bf16(v1[2], v1[3]);
                    *(u32x4*)(rowp + bj * HALF) = w; } }
    }
};
constexpr int TPROMPT = 16384, NMODC = 12288;
__device__ __forceinline__ int seq_of_row(int row) { return row < TPROMPT ? 0 : 1 + ((row - TPROMPT) >> 3); }
__device__ __forceinline__ float sigm(float x) { return __builtin_amdgcn_rcpf(1.0f + __expf(-x)); }
typedef unsigned u32x2 __attribute__((ext_vector_type(2)));

struct EpiF32Bias {
    static constexpr bool PERM = false, AFTER_DRAIN = false;
    float* O; int ldc; const float* bias;
    __device__ __forceinline__ void operator()(const f32x4 (&acc)[2][2][4][2], const Unit& u, int wr, int wc, int fr, int fq) const {
        const int row0 = u.pm * BM + wr * 64 + fr, col0 = u.pn * BM + wc * 32 + 4 * fq;
#pragma unroll
        for (int bj = 0; bj < 2; ++bj)
#pragma unroll
            for (int n = 0; n < 2; ++n) { const int col = col0 + bj * HALF + n * 16; const f32x4 bv = *(const f32x4*)(bias + col);
#pragma unroll
                for (int ai = 0; ai < 2; ++ai)
#pragma unroll
                    for (int m = 0; m < 4; ++m) *(f32x4*)(O + (size_t)(row0 + ai * HALF + m * 16) * ldc + col) = acc[ai][bj][m][n] + bv; }
    }
};
struct EpiPartial {
    static constexpr bool PERM = false, AFTER_DRAIN = false;
    bf16_t* P; int rows;
    __device__ __forceinline__ void operator()(const f32x4 (&acc)[2][2][4][2], const Unit& u, int wr, int wc, int fr, int fq) const {
        const int row0 = u.pm * BM + wr * 64 + fr, col0 = u.pn * BM + wc * 32 + 4 * fq; bf16_t* base = P + (size_t)u.ks * rows * 1024;
#pragma unroll
        for (int ai = 0; ai < 2; ++ai)
#pragma unroll
            for (int m = 0; m < 4; ++m) { bf16_t* orow = base + (size_t)(row0 + ai * HALF + m * 16) * 1024;
#pragma unroll
                for (int bj = 0; bj < 2; ++bj)
#pragma unroll
                    for (int n = 0; n < 2; ++n) { const f32x4 v = acc[ai][bj][m][n]; u32x2 w; w.x = cvt_pk_bf16(v[0], v[1]); w.y = cvt_pk_bf16(v[2], v[3]); *(u32x2*)(orow + col0 + bj * HALF + n * 16) = w; } }
    }
};
struct EpiResid {
    static constexpr bool PERM = false, AFTER_DRAIN = false;
    const float* bp; const float* bs; float* out; const float* gate;
    __device__ __forceinline__ void operator()(const f32x4 (&acc)[2][2][4][2], const Unit& u, int wr, int wc, int fr, int fq) const {
        const int row0 = u.pm * BM + wr * 64 + fr, col0 = u.pn * BM + wc * 32 + 4 * fq;
#pragma unroll
        for (int ai = 0; ai < 2; ++ai)
#pragma unroll
            for (int m = 0; m < 4; ++m) { const int row = row0 + ai * HALF + m * 16;
                const float* brow = row < TPROMPT ? bp + (size_t)row * 1024 : bs + (size_t)(row - TPROMPT) * 1024;
                const float* grow = gate + (size_t)seq_of_row(row) * NMODC; float* orow = out + (size_t)row * 1024;
#pragma unroll
                for (int bj = 0; bj < 2; ++bj)
#pragma unroll
                    for (int n = 0; n < 2; ++n) { const int col = col0 + bj * HALF + n * 16;
                        const f32x4 b = *(const f32x4*)(brow + col), g = *(const f32x4*)(grow + col);
                        *(f32x4*)(orow + col) = b + g * acc[ai][bj][m][n]; } }
    }
};
struct EpiSwiGLU {
    static constexpr bool PERM = false, AFTER_DRAIN = false;
    bf16_t* H; int ldh;
    __device__ __forceinline__ void operator()(const f32x4 (&acc)[2][2][4][2], const Unit& u, int wr, int wc, int fr, int fq) const {
        const int row0 = u.pm * BM + wr * 64 + fr, col0 = u.pn * 128 + wc * 16 + 4 * fq;
#pragma unroll
        for (int ai = 0; ai < 2; ++ai)
#pragma unroll
            for (int m = 0; m < 4; ++m) { bf16_t* rowp = H + (size_t)(row0 + ai * HALF + m * 16) * ldh + col0;
#pragma unroll
                for (int bj = 0; bj < 2; ++bj) { const f32x4 g = acc[ai][bj][m][0], uu = acc[ai][bj][m][1]; f32x4 hv;
#pragma unroll
                    for (int i = 0; i < 4; ++i) hv[i] = g[i] * sigm(g[i]) * uu[i];
                    u32x2 w; w.x = cvt_pk_bf16(hv[0], hv[1]); w.y = cvt_pk_bf16(hv[2], hv[3]);
                    *(u32x2*)(rowp + bj * 64) = w; } }
    }
};
struct EpiGLUResid {
    static constexpr bool PERM = false, AFTER_DRAIN = false;
    float* out; const float* gate;
    __device__ __forceinline__ void operator()(const f32x4 (&acc)[2][2][4][2], const Unit& u, int wr, int wc, int fr, int fq) const {
        const int row0 = u.pm * BM + wr * 64 + fr, col0 = u.pn * 128 + wc * 16 + 4 * fq;
#pragma unroll
        for (int ai = 0; ai < 2; ++ai)
#pragma unroll
            for (int m = 0; m < 4; ++m) { const int row = row0 + ai * HALF + m * 16;
                const float* grow = gate + (size_t)seq_of_row(row) * NMODC; float* orow = out + (size_t)row * 1024;
#pragma unroll
                for (int bj = 0; bj < 2; ++bj) { const int col = col0 + bj * 64; const f32x4 a = acc[ai][bj][m][0], b = acc[ai][bj][m][1];
                    const f32x4 x = *(const f32x4*)(orow + col), g = *(const f32x4*)(grow + col); f32x4 v;
#pragma unroll
                    for (int i = 0; i < 4; ++i) v[i] = x[i] + g[i] * (a[i] * sigm(b[i]));
                    *(f32x4*)(orow + col) = v; } }
    }
};
template <class Epi, class Sched, bool ALIGN_EPI = false, bool SP2 = false>
__device__ __forceinline__ void gemm_phase(PG8_LAS unsigned char* lds, const Gemm g, const Sched& S, const Epi& E) {
    const int tid = threadIdx.x, wid = __builtin_amdgcn_readfirstlane(tid >> 6), lane = tid & 63, wr = wid >> 2, wc = wid & 3, fr = lane & 15, fq = lane >> 4;
    const int K = g.K, nt = K / BK, ld = g.ld ? g.ld : g.K;
    unsigned voffA[2], voffB[2];
#pragma unroll
    for (int i = 0; i < 2; ++i) { int R, C; stage_rc(tid * 16 + i * 8192, R, C); const int Rb = Epi::PERM ? ((R & ~31) + perm32(R & 31)) : R;
        voffA[i] = (unsigned)(R * ld + C) * 2u; voffB[i] = (unsigned)(Rb * ld + C) * 2u; }
    const size_t kstep = (size_t)(BK * 2);
    const size_t hstep = (size_t)HALF * ld * 2;
    const size_t tstep = 2 * hstep;
    const unsigned ldsw = (unsigned)wid * 1024u;
    const int aoff = lds_byte(wr * 64 + fr, fq * 8), boff = lds_byte(wc * 32 + fr, fq * 8);
#define PG8_SA(b, h) (((b) * 2 + (h)) * HTB)
#define PG8_SB(b, h) ((4 + (b) * 2 + (h)) * HTB)
#define PG8_STAGE(bufoff, gbase, voff) do { _Pragma("unroll") for (int _i = 0; _i < 2; ++_i) \
        __builtin_amdgcn_global_load_lds((const unsigned*)((const char*)(gbase) + (voff)[_i]), (PG8_LAS unsigned*)(lds + (bufoff) + ldsw + _i * 8192), 16, 0, 0); } while (0)
#define PG8_LDA(dst, b, h) do { _Pragma("unroll") for (int m = 0; m < 4; ++m) _Pragma("unroll") for (int k = 0; k < 2; ++k) dst[m][k] = *(const PG8_LAS bf16x8*)(lds + PG8_SA(b, h) + aoff + m * 2048 + k * 1024); } while (0)
#define PG8_LDB(dst, b, h) do { _Pragma("unroll") for (int n = 0; n < 2; ++n) _Pragma("unroll") for (int k = 0; k < 2; ++k) dst[n][k] = *(const PG8_LAS bf16x8*)(lds + PG8_SB(b, h) + boff + n * 2048 + k * 1024); } while (0)
#define PG8_MMA(ai, bj, At, Bt) do { __builtin_amdgcn_s_setprio(1); _Pragma("unroll") for (int m = 0; m < 4; ++m) _Pragma("unroll") for (int n = 0; n < 2; ++n) _Pragma("unroll") for (int k = 0; k < 2; ++k) \
        acc[ai][bj][m][n] = __builtin_amdgcn_mfma_f32_16x16x32_bf16(Bt[n][k], At[m][k], acc[ai][bj][m][n], 0, 0, 0); __builtin_amdgcn_s_setprio(0); } while (0)
#define PG8_WAIT_V(n) asm volatile("s_waitcnt vmcnt(" #n ")" ::: "memory")
#define PG8_WAIT_L(n) asm volatile("s_waitcnt lgkmcnt(" #n ")" ::: "memory")
#define PG8_BAR __builtin_amdgcn_s_barrier()
#define PG8_SCHED __builtin_amdgcn_sched_barrier(0)
    Unit cur, nxt; int ui = 0;
    if (!S.next(0, cur)) return;
    f32x4 acc[2][2][4][2];
#pragma unroll
    for (int a = 0; a < 2; ++a)
#pragma unroll
        for (int b = 0; b < 2; ++b)
#pragma unroll
            for (int m = 0; m < 4; ++m)
#pragma unroll
                for (int n = 0; n < 2; ++n) acc[a][b][m][n] = (f32x4){0.f, 0.f, 0.f, 0.f};
    bf16x8 At[4][2], B0[2][2], B1[2][2];
    const char* cA = (const char*)g.A + (size_t)cur.pm * tstep + (size_t)cur.ks * K * 2; const char* cB = (const char*)g.Bt + (size_t)cur.pn * tstep + (size_t)cur.ks * K * 2;
    S.a_ready(cur);
    if constexpr (SP2) {
        PG8_STAGE(PG8_SB(0, 0), cB, voffB); PG8_STAGE(PG8_SB(0, 1), cB + hstep, voffB); PG8_STAGE(PG8_SA(0, 0), cA, voffA); PG8_STAGE(PG8_SA(0, 1), cA + hstep, voffA);
        if (wr == 1) PG8_BAR;
        PG8_WAIT_V(2); PG8_BAR;
        PG8_STAGE(PG8_SB(1, 0), cB + kstep, voffB); PG8_STAGE(PG8_SA(1, 0), cA + kstep, voffA); PG8_STAGE(PG8_SB(1, 1), cB + hstep + kstep, voffB);
        PG8_WAIT_V(6); PG8_BAR;
    } else {
        PG8_STAGE(PG8_SB(0, 0), cB, voffB); PG8_STAGE(PG8_SA(0, 0), cA, voffA); PG8_STAGE(PG8_SB(0, 1), cB + hstep, voffB); PG8_STAGE(PG8_SA(0, 1), cA + hstep, voffA);
        if (wr == 1) PG8_BAR;
        PG8_WAIT_V(4); PG8_BAR;
        PG8_STAGE(PG8_SB(1, 0), cB + kstep, voffB); PG8_STAGE(PG8_SA(1, 0), cA + kstep, voffA); PG8_STAGE(PG8_SB(1, 1), cB + hstep + kstep, voffB);
        PG8_WAIT_V(6); PG8_BAR;
    }
    for (;;) {
        const bool has_next = S.next(ui + 1, nxt);
        const char* nA = has_next ? (const char*)g.A + (size_t)nxt.pm * tstep + (size_t)nxt.ks * K * 2 : cA; const char* nB = has_next ? (const char*)g.Bt + (size_t)nxt.pn * tstep + (size_t)nxt.ks * K * 2 : cB;
        for (int t = 0; t < nt; t += 2) {
            const bool last = (t == nt - 2);
            const char* a1 = cA + (size_t)(t + 1) * kstep;
            const char* a2 = last ? nA : cA + (size_t)(t + 2) * kstep; const char* b2 = last ? nB : cB + (size_t)(t + 2) * kstep;
            const char* a3 = a2 + kstep; const char* b3 = b2 + kstep;
            if (last && has_next) S.a_ready(nxt);
            if constexpr (SP2) {
            PG8_LDB(B0, 0, 0); PG8_LDB(B1, 0, 1); PG8_SCHED; PG8_LDA(At, 0, 0); PG8_STAGE(PG8_SA(1, 1), a1 + hstep, voffA);
            PG8_WAIT_V(8); PG8_WAIT_L(0); PG8_BAR; PG8_MMA(0, 0, At, B0); PG8_MMA(0, 1, At, B1); PG8_BAR; PG8_SCHED;
            PG8_LDA(At, 0, 1); PG8_STAGE(PG8_SB(0, 0), b2, voffB); PG8_STAGE(PG8_SB(0, 1), b2 + hstep, voffB); PG8_STAGE(PG8_SA(0, 0), a2, voffA);
            PG8_WAIT_V(8); PG8_WAIT_L(0); PG8_BAR; PG8_MMA(1, 0, At, B0); PG8_MMA(1, 1, At, B1); PG8_BAR; PG8_SCHED;
            PG8_LDB(B0, 1, 0); PG8_LDB(B1, 1, 1); PG8_SCHED; PG8_LDA(At, 1, 0); PG8_STAGE(PG8_SA(0, 1), a2 + hstep, voffA);
            PG8_WAIT_V(8); PG8_WAIT_L(0); PG8_BAR; PG8_MMA(0, 0, At, B0); PG8_MMA(0, 1, At, B1); PG8_BAR; PG8_SCHED;
            PG8_LDA(At, 1, 1); PG8_STAGE(PG8_SB(1, 0), b3, voffB); PG8_STAGE(PG8_SB(1, 1), b3 + hstep, voffB); PG8_STAGE(PG8_SA(1, 0), a3, voffA);
            PG8_WAIT_V(8); PG8_WAIT_L(0); PG8_BAR; PG8_MMA(1, 0, At, B0); PG8_MMA(1, 1, At, B1); PG8_BAR; PG8_SCHED;
            } else {
            PG8_LDB(B0, 0, 0); PG8_SCHED; PG8_LDA(At, 0, 0); PG8_STAGE(PG8_SA(1, 1), a1 + hstep, voffA);
            PG8_WAIT_L(8); PG8_BAR; PG8_WAIT_L(0); PG8_MMA(0, 0, At, B0); PG8_BAR; PG8_SCHED;
            PG8_LDB(B1, 0, 1); PG8_STAGE(PG8_SB(0, 0), b2, voffB);
            PG8_BAR; PG8_WAIT_L(0); PG8_MMA(0, 1, At, B1); PG8_BAR;
            PG8_LDA(At, 0, 1); PG8_STAGE(PG8_SA(0, 0), a2, voffA);
            PG8_BAR; PG8_WAIT_L(0); PG8_MMA(1, 0, At, B0); PG8_BAR; PG8_SCHED;
            PG8_STAGE(PG8_SB(0, 1), b2 + hstep, voffB);
            PG8_WAIT_V(6); PG8_BAR; PG8_MMA(1, 1, At, B1); PG8_BAR;
            PG8_LDB(B0, 1, 0); PG8_SCHED; PG8_LDA(At, 1, 0); PG8_STAGE(PG8_SA(0, 1), a2 + hstep, voffA);
            PG8_WAIT_L(8); PG8_BAR; PG8_WAIT_L(0); PG8_MMA(0, 0, At, B0); PG8_BAR; PG8_SCHED;
            PG8_LDB(B1, 1, 1); PG8_STAGE(PG8_SB(1, 0), b3, voffB);
            PG8_BAR; PG8_WAIT_L(0); PG8_MMA(0, 1, At, B1); PG8_BAR;
            PG8_LDA(At, 1, 1); PG8_STAGE(PG8_SA(1, 0), a3, voffA);
            PG8_BAR; PG8_WAIT_L(0); PG8_MMA(1, 0, At, B0); PG8_BAR; PG8_SCHED;
            PG8_STAGE(PG8_SB(1, 1), b3 + hstep, voffB);
            PG8_WAIT_V(6); PG8_BAR; PG8_MMA(1, 1, At, B1); PG8_BAR;
            }
        }
        if constexpr (ALIGN_EPI) { if (wr == 0) PG8_BAR; }
        if constexpr (!Epi::AFTER_DRAIN) { E(acc, cur, wr, wc, fr, fq); S.done(cur); }
        if (!has_next) break;
#pragma unroll
        for (int a = 0; a < 2; ++a)
#pragma unroll
            for (int b = 0; b < 2; ++b)
#pragma unroll
                for (int m = 0; m < 4; ++m)
#pragma unroll
                    for (int n = 0; n < 2; ++n) acc[a][b][m][n] = (f32x4){0.f, 0.f, 0.f, 0.f};
        cur = nxt; cA = nA; cB = nB; ++ui;
        if constexpr (ALIGN_EPI) { if (wr == 1) PG8_BAR; }
    }
    PG8_WAIT_V(0);
    if constexpr (!ALIGN_EPI) { if (wr == 0) PG8_BAR; }
    PG8_BAR;
    if constexpr (Epi::AFTER_DRAIN) { E.fused(acc, cur, wr, wc, fr, fq, lds, wid, lane); S.done(cur); }
#undef PG8_SA
#undef PG8_SB
#undef PG8_STAGE
#undef PG8_LDA
#undef PG8_LDB
#undef PG8_MMA
#undef PG8_WAIT_V
#undef PG8_WAIT_L
#undef PG8_BAR
#undef PG8_SCHED
}
}

constexpr int TP = 16384, TS = 1024, MT = TP + TS, DM = 1024, NBATCH = 128;
constexpr int NIN = 2816, DFF = 2816, NMOD = 12288, LMOD = 6144;
constexpr float EPSN = 1e-6f, LOG2E = 1.4426950408889634f;
constexpr int NWAVES = 8;
constexpr size_t O_Y = 0, O_PK = (size_t)MT * DM, O_PV = O_PK + 16384, O_PRET = O_PV + 16384, O_PS5R = O_PRET + 65536, O_PS5I = O_PS5R + 4096,
                 O_SK = O_PS5I + 4096, O_SV = O_SK + 2097152, O_SRET = O_SV + 2097152, O_SS5R = O_SRET + 8388608, O_SS5I = O_SS5R + 524288, O_END = O_SS5I + 524288;
constexpr size_t MiB = 1u << 20;
constexpr size_t WS_CA = 1 * MiB, WS_MOD = 2 * MiB, WS_S5P = 14 * MiB, WS_WIN = 16 * MiB, WS_WOUT = 22 * MiB, WS_WGU0 = 24 * MiB, WS_WGU1 = 35 * MiB,
                 WS_WD0 = 46 * MiB, WS_WD1 = 52 * MiB, WS_WGLU = 58 * MiB, WS_XN = 62 * MiB, WS_RKV = 62 * MiB, WS_MIX = 96 * MiB, WS_PROJ = 130 * MiB,
                 WS_WADA = 130 * MiB, WS_S5E = 130 * MiB, WS_S5H = 134 * MiB, WS_SIN = 224 * MiB, WS_PART0 = 240 * MiB, WS_PART1 = 248 * MiB, WS_END = 256 * MiB;
constexpr size_t S5_LAM = 0, S5_LAM128 = 32768, S5_BBT = 65536, S5_CCT = 65536 + 262144;
constexpr int LDS_BYTES = 147456;

#define LAS __attribute__((address_space(3)))
typedef unsigned short bf16;
typedef unsigned u32x4 __attribute__((ext_vector_type(4)));
typedef unsigned u32x2 __attribute__((ext_vector_type(2)));
typedef float f32x4 __attribute__((ext_vector_type(4)));
typedef float f32x2 __attribute__((ext_vector_type(2)));
typedef float f32x16 __attribute__((ext_vector_type(16)));
typedef short bf16x8 __attribute__((ext_vector_type(8)));
typedef short s16x4 __attribute__((ext_vector_type(4)));
typedef short v4i16_t __attribute__((ext_vector_type(4)));
typedef __bf16 bf16x2_t __attribute__((ext_vector_type(2)));
#define DI __device__ __forceinline__
#define MFMA32(a, b, c) __builtin_amdgcn_mfma_f32_32x32x16_bf16((a), (b), (c), 0, 0, 0)
DI unsigned pk2(float lo, float hi) { f32x2 v = {lo, hi}; bf16x2_t b = __builtin_convertvector(v, bf16x2_t); return __builtin_bit_cast(unsigned, b); }
DI unsigned short f2bf(float f) { return (unsigned short)(pk2(f, 0.f) & 0xffffu); }
DI float bflo(unsigned w) { return __uint_as_float(w << 16); }
DI float bfhi(unsigned w) { return __uint_as_float(w & 0xffff0000u); }
DI float bf2f(unsigned short b) { return __uint_as_float((unsigned)b << 16); }
DI int crow(int r, int h) { return (r & 3) + 8 * (r >> 2) + 4 * h; }
DI float wave_sum(float v) {
#pragma unroll
    for (int o = 1; o < 64; o <<= 1) v += __shfl_xor(v, o);
    return v;
}
DI s16x4 tr_read(const LAS unsigned char* p) { return __builtin_bit_cast(s16x4, __builtin_amdgcn_ds_read_tr16_b64_v4i16((LAS v4i16_t*)p)); }
DI bf16x8 tr_frag(const LAS unsigned char* lo, int hi_off) { const s16x4 a = tr_read(lo), b = tr_read(lo + hi_off); return __builtin_shufflevector(a, b, 0, 1, 2, 3, 4, 5, 6, 7); }
DI bf16x8 pack8(float a0, float a1, float a2, float a3, float a4, float a5, float a6, float a7) {
    u32x4 p; p.x = pk2(a0, a1); p.y = pk2(a2, a3); p.z = pk2(a4, a5); p.w = pk2(a6, a7); return __builtin_bit_cast(bf16x8, p);
}
#define PACK_STEP(x, s) pack8((x)[8 * (s)], (x)[8 * (s) + 1], (x)[8 * (s) + 2], (x)[8 * (s) + 3], (x)[8 * (s) + 4], (x)[8 * (s) + 5], (x)[8 * (s) + 6], (x)[8 * (s) + 7])
DI f32x16 zero16() { f32x16 z;
#pragma unroll
    for (int i = 0; i < 16; ++i) z[i] = 0.f; return z; }
DI void unpack8(const u32x4 w, float* f) { f[0] = bflo(w.x); f[1] = bfhi(w.x); f[2] = bflo(w.y); f[3] = bfhi(w.y); f[4] = bflo(w.z); f[5] = bfhi(w.z); f[6] = bflo(w.w); f[7] = bfhi(w.w); }

struct Args { const float* in[32]; float* out; unsigned char* ws; int ph_lo, ph_hi; };
struct Frame {
    LAS unsigned char* lds; int tid, lane, wave, G, bid;
    float* out; unsigned char* ws;
    DI bf16* CA() const { return (bf16*)(ws + WS_CA); }
    DI bf16* Win_t() const { return (bf16*)(ws + WS_WIN); }
    DI bf16* Wout_t() const { return (bf16*)(ws + WS_WOUT); }
    DI bf16* Wgu_t(int l) const { return (bf16*)(ws + (l ? WS_WGU1 : WS_WGU0)); }
    DI bf16* Wd_t(int l) const { return (bf16*)(ws + (l ? WS_WD1 : WS_WD0)); }
    DI bf16* Wglu_t() const { return (bf16*)(ws + WS_WGLU); }
    DI bf16* Wada_t() const { return (bf16*)(ws + WS_WADA); }
    DI bf16* XN() const { return (bf16*)(ws + WS_XN); }
    DI bf16* MIX() const { return (bf16*)(ws + WS_MIX); }
    DI bf16* PROJ() const { return (bf16*)(ws + WS_PROJ); }
    DI bf16* SIN() const { return (bf16*)(ws + WS_SIN); }
    DI float* MOD() const { return (float*)(ws + WS_MOD); }
    DI float* RKV() const { return (float*)(ws + WS_RKV); }
    DI float* S5E() const { return (float*)(ws + WS_S5E); }
    DI float* S5H() const { return (float*)(ws + WS_S5H); }
};
enum { I_XP = 0, I_XS, I_CK, I_CV, I_SRET, I_S5R, I_S5I, I_CP, I_CS, I_ADAW, I_ADAB, I_NMIX, I_NFFN, I_WG, I_WU, I_WD, I_WIN, I_QG, I_KG, I_SINK, I_RG, I_WOUT,
       I_ARE, I_AIM, I_LDT, I_BRE, I_BIM, I_CRE, I_CIM, I_DSK, I_GLA, I_GLB };

DI void transpose_item(const float* W, int K, int N, bf16* WT, int rs, int ro, LAS float* scr, int item, int lane) {
    const int nblk = N / 32, kb = item / nblk, nb = item % nblk, k0 = 64 * kb, n0 = 32 * nb;
#pragma unroll 8
    for (int i = 0; i < 32; ++i) { const int kk = 2 * i + (lane >> 5); scr[kk * 33 + (lane & 31)] = W[(size_t)(k0 + kk) * N + n0 + (lane & 31)]; }
    asm volatile("s_waitcnt lgkmcnt(0)" ::: "memory");
    const int c = lane & 7;
#pragma unroll
    for (int j = 0; j < 4; ++j) { const int n = (lane >> 3) + 8 * j; const LAS float* s = scr + (8 * c) * 33 + n;
        u32x4 o; o.x = pk2(s[0 * 33], s[1 * 33]); o.y = pk2(s[2 * 33], s[3 * 33]); o.z = pk2(s[4 * 33], s[5 * 33]); o.w = pk2(s[6 * 33], s[7 * 33]);
        const int nn = n0 + n, drow = (nn >> 4) * rs + (nn & 15) + ro;
        *(u32x4*)(WT + (size_t)drow * K + k0 + 8 * c) = o; }
    asm volatile("s_waitcnt lgkmcnt(0)" ::: "memory");
}
DI void p0_prologue(const Args& A, const Frame& F) {
    LAS float* scr = (LAS float*)(F.lds + F.wave * 16384);
    const int gw = F.bid * NWAVES + F.wave, NGW = F.G * NWAVES;
    constexpr int I_A = 16 * 88, I_B = 16 * 32, I_C = 44 * 32, I_E = 16 * 192;
    constexpr int NITEMS = I_A + I_B + 4 * I_A + 2 * I_C + 2 * I_B + 2 * I_E;
    for (int it = gw; it < NITEMS; it += NGW) {
        int r = it;
        if (r < I_A) { transpose_item(A.in[I_WIN], 1024, NIN, F.Win_t(), 16, 0, scr, r, F.lane); continue; } r -= I_A;
        if (r < I_B) { transpose_item(A.in[I_WOUT], 1024, 1024, F.Wout_t(), 16, 0, scr, r, F.lane); continue; } r -= I_B;
        if (r < 4 * I_A) { const int which = r / I_A, rr = r % I_A, l = which >> 1, up = which & 1;
            transpose_item(A.in[up ? I_WU : I_WG] + (size_t)l * 1024 * DFF, 1024, DFF, F.Wgu_t(l), 32, up * 16, scr, rr, F.lane); continue; } r -= 4 * I_A;
        if (r < 2 * I_C) { const int l = r / I_C, rr = r % I_C; transpose_item(A.in[I_WD] + (size_t)l * DFF * 1024, DFF, 1024, F.Wd_t(l), 16, 0, scr, rr, F.lane); continue; } r -= 2 * I_C;
        if (r < 2 * I_B) { const int b = r / I_B, rr = r % I_B; transpose_item(A.in[b ? I_GLB : I_GLA], 1024, 1024, F.Wglu_t(), 32, b * 16, scr, rr, F.lane); continue; } r -= 2 * I_B;
        { const int l = r / I_E, rr = r % I_E; transpose_item(A.in[I_ADAW] + (size_t)l * 1024 * LMOD, 1024, LMOD, F.Wada_t(), 16, l * LMOD, scr, rr, F.lane); }
    }
    const int gt = F.bid * 512 + F.tid, NGT = F.G * 512;
    for (int idx = gt; idx < 256 * 1024; idx += NGT) { const int row = idx >> 10, col = idx & 1023;
        float v = 0.f; if (row == 0) v = A.in[I_CP][col]; else if (row <= NBATCH) v = A.in[I_CS][(row - 1) * 1024 + col];
        F.CA()[idx] = f2bf(v * pg8::sigm(v)); }
    if (gt < 65536) {
        const int gp = gt >> 4, i = gt & 15, g = gp >> 6, p = gp & 63;
        const float are = A.in[I_ARE][gp], aim = A.in[I_AIM][gp], dt = expf(A.in[I_LDT][g]);
        const float a = are * dt, b = aim * dt; const float mag = expf(a), cb = cosf(b), sb = sinf(b), sh = sinf(0.5f * b);
        const float lr = mag * cb, li = mag * sb;
        const float nr = expm1f(a) * cb - 2.f * sh * sh, ni = li;
        const float den = are * are + aim * aim; const float fr = (nr * are + ni * aim) / den, fi = (ni * are - nr * aim) / den;
        bf16* BBt = (bf16*)(F.ws + WS_S5P + S5_BBT); bf16* CCt = (bf16*)(F.ws + WS_S5P + S5_CCT);
        const float br = A.in[I_BRE][gt], bi = A.in[I_BIM][gt];
        BBt[(g * 128 + p) * 16 + i] = f2bf(fr * br - fi * bi); BBt[(g * 128 + 64 + p) * 16 + i] = f2bf(fr * bi + fi * br);
        { const int go = gt >> 6, pp = gt & 63;
          CCt[go * 128 + pp] = f2bf(A.in[I_CRE][go * 64 + pp]); CCt[go * 128 + 64 + pp] = f2bf(-A.in[I_CIM][go * 64 + pp]); }
        if (i == 0) {
            float* P = (float*)(F.ws + WS_S5P);
            P[(S5_LAM >> 2) + 2 * gp] = lr; P[(S5_LAM >> 2) + 2 * gp + 1] = li;
            float pr = lr, pi = li;
#pragma unroll
            for (int k = 0; k < 7; ++k) { const float t = pr * pr - pi * pi; pi = 2.f * pr * pi; pr = t; }
            P[(S5_LAM128 >> 2) + 2 * gp] = pr; P[(S5_LAM128 >> 2) + 2 * gp + 1] = pi;
        }
    }
}

DI void norm_phase(const Args& A, const Frame& F, const float* xp, const float* xs, const float* gamma, const float* mod, int sh_off, int sc_off, const bf16* part = nullptr, int ns = 0, const float* pgate = nullptr, float* xw = nullptr) {
    const int gw = F.bid * NWAVES + F.wave, NGW = F.G * NWAVES;
    for (int m = gw; m < MT; m += NGW) {
        const float* xrow = m < TP ? xp + (size_t)m * DM : xs + (size_t)(m - TP) * DM;
        const float* mrow = mod + (size_t)pg8::seq_of_row(m) * NMOD;
        f32x4 v[4]; float ss = 0.f;
#pragma unroll
        for (int j = 0; j < 4; ++j) { v[j] = *(const f32x4*)(xrow + 4 * (64 * j + F.lane));
            if (part && m >= TP) { const int col = 4 * (64 * j + F.lane); const size_t po = (size_t)(m - TP) * 1024 + col;
                const f32x4 g = *(const f32x4*)(pgate + (size_t)pg8::seq_of_row(m) * NMOD + col); f32x4 ps = (f32x4){0.f, 0.f, 0.f, 0.f};
                for (int sl = 0; sl < ns; ++sl) { const u32x2 w = *(const u32x2*)(part + (size_t)sl * TS * 1024 + po); ps += (f32x4){bflo(w.x), bfhi(w.x), bflo(w.y), bfhi(w.y)}; }
                v[j] = v[j] + g * ps; *(f32x4*)(xw + (size_t)m * DM + col) = v[j]; }
            ss += (v[j].x * v[j].x + v[j].y * v[j].y) + (v[j].z * v[j].z + v[j].w * v[j].w); }
        const float rstd = rsqrtf(wave_sum(ss) * (1.f / DM) + EPSN);
#pragma unroll
        for (int j = 0; j < 4; ++j) { const int col = 4 * (64 * j + F.lane);
            const f32x4 g = *(const f32x4*)(gamma + col), sc = *(const f32x4*)(mrow + sc_off + col), sh = *(const f32x4*)(mrow + sh_off + col);
            const f32x4 y = v[j] * rstd * g * (1.f + sc) + sh;
            u32x2 w; w.x = pk2(y.x, y.y); w.y = pk2(y.z, y.w); *(u32x2*)(F.XN() + (size_t)m * DM + col) = w; }
    }
}

template <bool SAMPLE> DI void attn_unit(const Args& A, const Frame& F, int uidx) {
    LAS unsigned char* Kl = F.lds; LAS unsigned char* Vl = F.lds + 46080;
    int tid = F.tid; asm volatile("" : "+v"(tid)); const int lane = tid & 63, w = F.wave;
    const int q0 = SAMPLE ? 0 : 32 * uidx, b = uidx;
    const float* kgain = A.in[I_KG];
    __syncthreads();
#pragma unroll 1
    for (int it = 0; it < 5; ++it) {
        const int t = tid + 512 * it, ch = t & 7, rr = t >> 3, kv = rr >= 160 ? 1 : 0, kk = rr - 160 * kv;
        float kf[8], vf[8]; bool valid = true, donorm = true; int tok = 0;
        if (SAMPLE) {
            if (kk < 128) { donorm = false; const size_t o = ((size_t)(b * 128 + kk) * 2 + kv) * 64 + 8 * ch;
                const f32x4 k0 = *(const f32x4*)(A.in[I_CK] + o), k1 = *(const f32x4*)(A.in[I_CK] + o + 4), v0 = *(const f32x4*)(A.in[I_CV] + o), v1 = *(const f32x4*)(A.in[I_CV] + o + 4);
                kf[0] = k0.x; kf[1] = k0.y; kf[2] = k0.z; kf[3] = k0.w; kf[4] = k1.x; kf[5] = k1.y; kf[6] = k1.z; kf[7] = k1.w;
                vf[0] = v0.x; vf[1] = v0.y; vf[2] = v0.z; vf[3] = v0.w; vf[4] = v1.x; vf[5] = v1.y; vf[6] = v1.z; vf[7] = v1.w; }
            else { valid = kk < 136; tok = TP + b * 8 + ((kk - 128) & 7); }
        } else { tok = q0 - 128 + kk; valid = tok >= 0; if (!valid) tok = 0; }
        if (!SAMPLE || kk >= 128) {
            const bf16* src = F.PROJ() + (size_t)tok * NIN + 512 + kv * 64 + 8 * ch;
            const u32x4 kw = *(const u32x4*)src, vw = *(const u32x4*)(src + 128);
            unpack8(kw, kf); unpack8(vw, vf);
        }
        float ss = 0.f;
#pragma unroll
        for (int j = 0; j < 8; ++j) ss += kf[j] * kf[j];
        ss += __shfl_xor(ss, 1); ss += __shfl_xor(ss, 2); ss += __shfl_xor(ss, 4);
        const float rstd = rsqrtf(ss * (1.f / 64.f) + EPSN);
#pragma unroll
        for (int j = 0; j < 8; ++j) { if (donorm) kf[j] = kf[j] * rstd * kgain[8 * ch + j]; if (!valid) { kf[j] = 0.f; vf[j] = 0.f; } }
        const int lo = ((kv * 160 + kk) * 72 + 8 * ch) * 2;
        *(LAS u32x4*)(Kl + lo) = (u32x4){pk2(kf[0], kf[1]), pk2(kf[2], kf[3]), pk2(kf[4], kf[5]), pk2(kf[6], kf[7])};
        *(LAS u32x4*)(Vl + lo) = (u32x4){pk2(vf[0], vf[1]), pk2(vf[2], vf[3]), pk2(vf[4], vf[5]), pk2(vf[6], vf[7])};
        float* ok = nullptr; float* ov = nullptr;
        if (SAMPLE) { if (kk >= 8 && kk < 136) { const size_t o = ((size_t)(b * 128 + kk - 8) * 2 + kv) * 64 + 8 * ch; ok = F.out + O_SK + o; ov = F.out + O_SV + o; } }
        else { if (q0 == TP - 32 && kk >= 32) { const size_t o = ((size_t)(kk - 32) * 2 + kv) * 64 + 8 * ch; ok = F.out + O_PK + o; ov = F.out + O_PV + o; } }
        if (ok) { *(f32x4*)ok = (f32x4){kf[0], kf[1], kf[2], kf[3]}; *(f32x4*)(ok + 4) = (f32x4){kf[4], kf[5], kf[6], kf[7]};
                  *(f32x4*)ov = (f32x4){vf[0], vf[1], vf[2], vf[3]}; *(f32x4*)(ov + 4) = (f32x4){vf[4], vf[5], vf[6], vf[7]}; }
    }
    const int n = lane & 31, h = lane >> 5, hh = w, kvh = hh >> 2;
    const int qtok = SAMPLE ? TP + b * 8 + (n & 7) : q0 + n;
    bf16x8 qf[4];
    {
        const bf16* qp = F.PROJ() + (size_t)qtok * NIN + hh * 64 + 8 * h; float qv[4][8]; float ss = 0.f;
#pragma unroll
        for (int s = 0; s < 4; ++s) { const u32x4 raw = *(const u32x4*)(qp + 16 * s); unpack8(raw, qv[s]);
#pragma unroll
            for (int j = 0; j < 8; ++j) ss += qv[s][j] * qv[s][j]; }
        ss += __shfl_xor(ss, 32);
        const float rstd = rsqrtf(ss * (1.f / 64.f) + EPSN) * (0.125f * LOG2E);
        const float* qg = A.in[I_QG];
#pragma unroll
        for (int s = 0; s < 4; ++s) { float t[8];
#pragma unroll
            for (int j = 0; j < 8; ++j) t[j] = qv[s][j] * rstd * qg[16 * s + 8 * h + j];
            qf[s] = pack8(t[0], t[1], t[2], t[3], t[4], t[5], t[6], t[7]); }
    }
    __syncthreads();
    f32x16 S[5];
#pragma unroll
    for (int kt = 0; kt < 5; ++kt) { S[kt] = zero16();
#pragma unroll
        for (int s = 0; s < 4; ++s) { const bf16x8 a = *(const LAS bf16x8*)(Kl + ((kvh * 160 + 32 * kt + n) * 72 + 16 * s + 8 * h) * 2); S[kt] = MFMA32(a, qf[s], S[kt]); } __builtin_amdgcn_sched_barrier(0); }
    const float slope2 = exp2f(-(float)(hh + 1)) * LOG2E, sink2 = A.in[I_SINK][hh] * LOG2E;
    float mx = -1e30f;
#pragma unroll
    for (int kt = 0; kt < 5; ++kt)
#pragma unroll
        for (int r = 0; r < 16; ++r) { const int kidx = 32 * kt + crow(r, h), dist = 128 + n - kidx;
            const bool okk = dist >= 0 && dist < 128 && (SAMPLE || q0 - 128 + kidx >= 0);
            const float v = okk ? S[kt][r] - slope2 * (float)dist : -1e30f; S[kt][r] = v; mx = fmaxf(mx, v); }
    mx = fmaxf(mx, __shfl_xor(mx, 32)); mx = fmaxf(mx, sink2);
    float sum = 0.f;
    bf16x8 pfs[5][2];
#pragma unroll
    for (int kt = 0; kt < 5; ++kt)
#pragma unroll
        for (int s2 = 0; s2 < 2; ++s2) { float p[8];
#pragma unroll
            for (int j = 0; j < 8; ++j) { p[j] = exp2f(S[kt][8 * s2 + j] - mx); sum += p[j]; }
            pfs[kt][s2] = pack8(p[0], p[1], p[2], p[3], p[4], p[5], p[6], p[7]); }
    sum += __shfl_xor(sum, 32);
    const float inv = 1.f / (sum + exp2f(sink2 - mx));
    __builtin_amdgcn_sched_barrier(0);
    f32x16 O[2]; O[0] = zero16(); O[1] = zero16();
    const int i16 = lane & 15, tq = i16 >> 2, tp = i16 & 3, blk = (lane >> 4) & 1;
    const LAS unsigned char* vbase = Vl + ((kvh * 160 + 4 * h + tq) * 72 + 16 * blk + 4 * tp) * 2;
#pragma unroll
    for (int kt = 0; kt < 5; ++kt) {
#pragma unroll
        for (int s2 = 0; s2 < 2; ++s2) {
#pragma unroll
            for (int dt = 0; dt < 2; ++dt) { const bf16x8 vfr = tr_frag(vbase + ((32 * kt + 16 * s2) * 72 + 32 * dt) * 2, 8 * 72 * 2);
                O[dt] = MFMA32(vfr, pfs[kt][s2], O[dt]); } }
        __builtin_amdgcn_sched_barrier(0); }
    if (!SAMPLE || n < 8) {
        bf16* op = F.MIX() + (size_t)qtok * DM + hh * 64;
#pragma unroll
        for (int dt = 0; dt < 2; ++dt)
#pragma unroll
            for (int g4 = 0; g4 < 4; ++g4) { u32x2 wv; wv.x = pk2(O[dt][4 * g4] * inv, O[dt][4 * g4 + 1] * inv); wv.y = pk2(O[dt][4 * g4 + 2] * inv, O[dt][4 * g4 + 3] * inv);
                *(u32x2*)(op + 32 * dt + 8 * g4 + 4 * h) = wv; }
    }
}

DI float ret_log2g(int head) { return log2f(1.0f - exp2f(-5.0f - (float)head)); }
constexpr float KSC = 0.08838834764831845f;
DI void ret_kv_unit(const Args& A, const Frame& F, int uidx) {
    const int c = uidx >> 2, head = uidx & 3; int tid = F.tid; asm volatile("" : "+v"(tid)); const int lane = tid & 63, w = F.wave;
    LAS unsigned char* Kl = F.lds; LAS unsigned char* Vl = F.lds + 34816;
    const float lg = ret_log2g(head);
    __syncthreads();
#pragma unroll 1
    for (int it = 0; it < 8; ++it) { const int t = tid + 512 * it, ch = t & 15, j = (t >> 4) & 127, isv = t >> 11;
        const bf16* src = F.PROJ() + (size_t)(c * 128 + j) * NIN + (isv ? 1792 : 1280) + head * 128 + 8 * ch;
        u32x4 wv = *(const u32x4*)src;
        if (!isv) { float f[8]; unpack8(wv, f); const float sc = KSC * exp2f(lg * (float)(127 - j));
            wv = (u32x4){pk2(f[0] * sc, f[1] * sc), pk2(f[2] * sc, f[3] * sc), pk2(f[4] * sc, f[5] * sc), pk2(f[6] * sc, f[7] * sc)}; }
        *(LAS u32x4*)((isv ? Vl : Kl) + (j * 136 + 8 * ch) * 2) = wv; }
    __syncthreads();
    const int n = lane & 31, h = lane >> 5, i16 = lane & 15, tq = i16 >> 2, tp = i16 & 3, blk = (lane >> 4) & 1;
    const int et = w >> 1, dt0 = 2 * (w & 1);
    f32x16 acc[2]; acc[0] = zero16(); acc[1] = zero16();
#pragma unroll
    for (int s = 0; s < 8; ++s) { const int rowoff = (16 * s + 8 * h + tq) * 136;
        const bf16x8 a = tr_frag(Vl + (rowoff + 32 * et + 16 * blk + 4 * tp) * 2, 4 * 136 * 2);
#pragma unroll
        for (int x = 0; x < 2; ++x) { const bf16x8 bb = tr_frag(Kl + (rowoff + 32 * (dt0 + x) + 16 * blk + 4 * tp) * 2, 4 * 136 * 2); acc[x] = MFMA32(a, bb, acc[x]); } }
    float* dst = F.RKV() + ((size_t)(c * 4 + head) * 128) * 128;
#pragma unroll
    for (int x = 0; x < 2; ++x)
#pragma unroll
        for (int r = 0; r < 16; ++r) dst[(size_t)(32 * et + crow(r, h)) * 128 + 32 * (dt0 + x) + n] = acc[x][r];
}
DI void ret_scan_phase(const Args& A, const Frame& F) {
    const int gt = F.bid * 512 + F.tid;
    if (gt < 65536) { const int head = gt >> 14, e = (gt >> 7) & 127, d = gt & 127;
        const float dc = exp2f(ret_log2g(head) * 128.f); float S = 0.f;
#pragma unroll 8
        for (int c = 0; c < 128; ++c) { F.SIN()[(size_t)c * 65536 + gt] = f2bf(S); S = S * dc + F.RKV()[(size_t)c * 65536 + gt]; }
        ((float*)(F.ws + WS_S5P + MiB))[gt] = S; (void)head; (void)e; (void)d; }
}
DI void pret_transpose_tile(const Args& A, const Frame& F, int tile) {
    const int head = tile >> 4, et = (tile >> 2) & 3, dt = tile & 3; LAS float* T = (LAS float*)F.lds;
    const float* src = (const float*)(F.ws + WS_S5P + MiB) + (size_t)head * 16384; float* dst = F.out + O_PRET + (size_t)head * 16384;
    __syncthreads();
    for (int idx = F.tid; idx < 1024; idx += 512) { const int el = idx >> 5, dl = idx & 31; T[el * 33 + dl] = src[(32 * et + el) * 128 + 32 * dt + dl]; }
    __syncthreads();
    for (int idx = F.tid; idx < 1024; idx += 512) { const int dl = idx >> 5, el = idx & 31; dst[(32 * dt + dl) * 128 + 32 * et + el] = T[el * 33 + dl]; }
    __syncthreads();
}
DI void ret_out_prompt(const Args& A, const Frame& F, int bu) {
    const int c = bu >> 1, hp = bu & 1; int tid = F.tid; asm volatile("" : "+v"(tid)); const int lane = tid & 63, w = F.wave;
    LAS unsigned char* Vl = F.lds;
    __syncthreads();
#pragma unroll 1
    for (int it = 0; it < 8; ++it) { const int t = tid + 512 * it, ch = t & 15, j = (t >> 4) & 127, hl = t >> 11;
        *(LAS u32x4*)(Vl + ((hl * 128 + j) * 136 + 8 * ch) * 2) = *(const u32x4*)(F.PROJ() + (size_t)(c * 128 + j) * NIN + 1792 + (2 * hp + hl) * 128 + 8 * ch); }
    __syncthreads();
    const int hl = w >> 2, it = w & 3, head = 2 * hp + hl, n = lane & 31, h = lane >> 5, i16 = lane & 15, tq = i16 >> 2, tp = i16 & 3, blk = (lane >> 4) & 1;
    const int tok = c * 128 + 32 * it + n; const float lg = ret_log2g(head);
    bf16x8 qf[8];
#pragma unroll
    for (int s = 0; s < 8; ++s) qf[s] = *(const bf16x8*)(F.PROJ() + (size_t)tok * NIN + 768 + head * 128 + 16 * s + 8 * h);
    f32x16 acc[4];
#pragma unroll
    for (int et = 0; et < 4; ++et) { acc[et] = zero16();
#pragma unroll
        for (int s = 0; s < 8; ++s) { const bf16x8 a = *(const bf16x8*)(F.SIN() + ((size_t)(c * 4 + head) * 128 + 32 * et + n) * 128 + 16 * s + 8 * h); acc[et] = MFMA32(a, qf[s], acc[et]); } }
    const float dq = exp2f(lg * (float)(32 * it + n + 1));
#pragma unroll
    for (int et = 0; et < 4; ++et) acc[et] = acc[et] * dq;
#pragma unroll 1
    for (int jt = 0; jt <= it; ++jt) {
        f32x16 X = zero16();
#pragma unroll
        for (int s = 0; s < 8; ++s) { const bf16x8 a = *(const bf16x8*)(F.PROJ() + (size_t)(c * 128 + 32 * jt + n) * NIN + 1280 + head * 128 + 16 * s + 8 * h); X = MFMA32(a, qf[s], X); }
#pragma unroll
        for (int r = 0; r < 16; ++r) { const int dd = 32 * it + n - (32 * jt + crow(r, h)); X[r] = dd >= 0 ? X[r] * (KSC * exp2f(lg * (float)dd)) : 0.f; }
#pragma unroll
        for (int s2 = 0; s2 < 2; ++s2) { const bf16x8 pf = PACK_STEP(X, s2);
#pragma unroll
            for (int et = 0; et < 4; ++et) { const bf16x8 vfr = tr_frag(Vl + ((hl * 128 + 32 * jt + 16 * s2 + 4 * h + tq) * 136 + 32 * et + 16 * blk + 4 * tp) * 2, 8 * 136 * 2);
                acc[et] = MFMA32(vfr, pf, acc[et]); } }
    }
    float sum = 0.f;
#pragma unroll
    for (int et = 0; et < 4; ++et)
#pragma unroll
        for (int r = 0; r < 16; ++r) sum += acc[et][r];
    sum += __shfl_xor(sum, 32); const float mean = sum * (1.f / 128.f); float var = 0.f;
#pragma unroll
    for (int et = 0; et < 4; ++et)
#pragma unroll
        for (int r = 0; r < 16; ++r) { const float dlt = acc[et][r] - mean; var += dlt * dlt; }
    var += __shfl_xor(var, 32); const float rstd = rsqrtf(var * (1.f / 128.f) + EPSN);
    const bf16* gp = F.PROJ() + (size_t)tok * NIN + 2304 + head * 128; bf16* op = F.MIX() + (size_t)tok * DM + 512 + head * 128; const float* rg = A.in[I_RG] + head * 128;
#pragma unroll
    for (int et = 0; et < 4; ++et)
#pragma unroll
        for (int g4 = 0; g4 < 4; ++g4) { const int e0 = 32 * et + 8 * g4 + 4 * h; const u32x2 gw = *(const u32x2*)(gp + e0); const f32x4 rgv = *(const f32x4*)(rg + e0);
            float gv[4] = {bflo(gw.x), bfhi(gw.x), bflo(gw.y), bfhi(gw.y)}; float y[4];
#pragma unroll
            for (int i = 0; i < 4; ++i) y[i] = (acc[et][4 * g4 + i] - mean) * rstd * rgv[i] * (gv[i] * pg8::sigm(gv[i]));
            u32x2 wv; wv.x = pk2(y[0], y[1]); wv.y = pk2(y[2], y[3]); *(u32x2*)(op + e0) = wv; }
}
DI void ret_sample_unit(const Args& A, const Frame& F, int uidx) {
    const int b = uidx >> 2, head = uidx & 3; const int tid = F.tid, lane = F.lane, w = F.wave;
    LAS float* Q = (LAS float*)F.lds; LAS float* Ks = Q + 1024; LAS float* V = Ks + 1024; LAS float* INN = V + 1024; LAS float* OO = INN + 64; LAS float* O2 = OO + 1024;
    const float lg = ret_log2g(head);
    __syncthreads();
    for (int idx = tid; idx < 3072; idx += 512) { const int which = idx >> 10, i = (idx >> 7) & 7, d = idx & 127;
        const float v = bf2f(F.PROJ()[(size_t)(TP + b * 8 + i) * NIN + (which == 0 ? 768 : which == 1 ? 1280 : 1792) + head * 128 + d]);
        (which == 0 ? Q : which == 1 ? Ks : V)[i * 128 + d] = which == 1 ? v * KSC : v; }
    __syncthreads();
    if (tid < 64) { const int i = tid >> 3, j = tid & 7; float dot = 0.f;
        for (int d = 0; d < 128; ++d) dot += Q[i * 128 + d] * Ks[j * 128 + d];
        INN[tid] = j <= i ? dot * exp2f(lg * (float)(i - j)) : 0.f; }
    {
        const int e4 = (tid & 31) * 4, dg = tid >> 5; f32x4 vv[8], o2[8];
#pragma unroll
        for (int j = 0; j < 8; ++j) { vv[j] = *(const LAS f32x4*)(V + j * 128 + e4) * exp2f(lg * (float)(7 - j)); o2[j] = (f32x4){0.f, 0.f, 0.f, 0.f}; }
        const float dc = exp2f(lg * 8.f);
        const float* S0 = A.in[I_SRET] + ((size_t)(b * 4 + head) * 128) * 128; float* S1 = F.out + O_SRET + ((size_t)(b * 4 + head) * 128) * 128;
        f32x4 sv[8];
#pragma unroll
        for (int dd = 0; dd < 8; ++dd) sv[dd] = *(const f32x4*)(S0 + (dg * 8 + dd) * 128 + e4);
#pragma unroll
        for (int dd = 0; dd < 8; ++dd) { const int d = dg * 8 + dd; const f32x4 s = sv[dd]; f32x4 sn = s * dc;
#pragma unroll
            for (int j = 0; j < 8; ++j) { o2[j] += Q[j * 128 + d] * s; sn += Ks[j * 128 + d] * vv[j]; }
            *(f32x4*)(S1 + d * 128 + e4) = sn; }
#pragma unroll
        for (int i = 0; i < 8; ++i) *(LAS f32x4*)(O2 + (dg * 8 + i) * 128 + e4) = o2[i];
    }
    __syncthreads();
    { const int e = tid & 127, ig = tid >> 7;
#pragma unroll
        for (int ii = 0; ii < 2; ++ii) { const int i = 2 * ig + ii; float o = 0.f;
#pragma unroll
            for (int dg = 0; dg < 16; ++dg) o += O2[(dg * 8 + i) * 128 + e];
            o *= exp2f(lg * (float)(i + 1));
            for (int j = 0; j <= i; ++j) o += INN[i * 8 + j] * V[j * 128 + e];
            OO[i * 128 + e] = o; } }
    __syncthreads();
    { const int i = w; const float a0 = OO[i * 128 + lane], a1 = OO[i * 128 + 64 + lane];
        const float mean = wave_sum(a0 + a1) * (1.f / 128.f); const float d0 = a0 - mean, d1 = a1 - mean;
        const float rstd = rsqrtf(wave_sum(d0 * d0 + d1 * d1) * (1.f / 128.f) + EPSN);
        const int tok = TP + b * 8 + i; const bf16* gp = F.PROJ() + (size_t)tok * NIN + 2304 + head * 128; bf16* op = F.MIX() + (size_t)tok * DM + 512 + head * 128; const float* rg = A.in[I_RG] + head * 128;
        const float g0 = bf2f(gp[lane]), g1 = bf2f(gp[64 + lane]);
        op[lane] = f2bf(d0 * rstd * rg[lane] * (g0 * pg8::sigm(g0))); op[64 + lane] = f2bf(d1 * rstd * rg[64 + lane] * (g1 * pg8::sigm(g1))); }
}

template <int PASS> DI void s5_phase(const Args& A, const Frame& F) {
    const int lane = F.lane, w = F.wave; const int gw = F.bid * NWAVES + w, NGW = F.G * NWAVES;
    LAS unsigned char* L = F.lds + w * 16896;
    const float* P = (const float*)(F.ws + WS_S5P); const bf16* BBt = (const bf16*)(F.ws + WS_S5P + S5_BBT); const bf16* CCt = (const bf16*)(F.ws + WS_S5P + S5_CCT);
    const int n = lane & 31, h = lane >> 5;
    const int nunits = PASS == 1 ? 64 * 128 : 2 * 64 * 128;
#pragma unroll 1
    for (int u = gw; u < nunits; u += NGW) {
        const bool sample = u >= 8192; const int uu = sample ? u - 8192 : u; const int g = uu & 63, cb = uu >> 6;
        const int tok0 = sample ? TP + cb * 8 : cb * 128, ntok = sample ? 8 : 128;
        const float lr = P[(S5_LAM >> 2) + 2 * (g * 64 + lane)], li = P[(S5_LAM >> 2) + 2 * (g * 64 + lane) + 1];
        float hr = 0.f, hi = 0.f;
        if (PASS == 2) { if (sample) { hr = A.in[I_S5R][(size_t)(cb * 64 + g) * 64 + lane]; hi = A.in[I_S5I][(size_t)(cb * 64 + g) * 64 + lane]; }
                         else { hr = F.S5H()[(size_t)(cb * 64 + g) * 128 + lane]; hi = F.S5H()[(size_t)(cb * 64 + g) * 128 + 64 + lane]; } }
        bf16x8 bbf[4];
#pragma unroll
        for (int qt = 0; qt < 4; ++qt) bbf[qt] = *(const bf16x8*)(BBt + (size_t)(g * 128 + 32 * qt + n) * 16 + 8 * h);
        bf16x8 cfh[8];
        if (PASS == 2) {
#pragma unroll
            for (int s = 0; s < 8; ++s) cfh[s] = *(const bf16x8*)(CCt + (size_t)(g * 16 + (n & 15)) * 128 + 16 * s + 8 * h); }
#pragma unroll 1
        for (int st = 0; st < ntok; st += 32) {
            const int nv = ntok - st < 32 ? ntok - st : 32;
            bf16x8 a = (bf16x8){0, 0, 0, 0, 0, 0, 0, 0};
            if (n < nv) a = *(const bf16x8*)(F.XN() + (size_t)(tok0 + st + n) * DM + g * 16 + 8 * h);
#pragma unroll
            for (int qt = 0; qt < 4; ++qt) { const f32x16 cc = MFMA32(a, bbf[qt], zero16());
#pragma unroll
                for (int r = 0; r < 16; ++r) *(LAS float*)(L + crow(r, h) * 528 + 4 * (32 * qt + n)) = cc[r]; }
#pragma unroll 4
            for (int t = 0; t < nv; ++t) { const float br = *(LAS float*)(L + t * 528 + 4 * lane), bi = *(LAS float*)(L + t * 528 + 256 + 4 * lane);
                const float nr = lr * hr - li * hi + br, ni = lr * hi + li * hr + bi; hr = nr; hi = ni;
                if (PASS == 2) { *(LAS unsigned short*)(L + t * 528 + 2 * lane) = f2bf(hr); *(LAS unsigned short*)(L + t * 528 + 128 + 2 * lane) = f2bf(hi); } }
            if (PASS == 2) {
                f32x16 y = zero16();
#pragma unroll
                for (int s = 0; s < 8; ++s) { const bf16x8 hs = *(const LAS bf16x8*)(L + n * 528 + 32 * s + 16 * h); y = MFMA32(hs, cfh[s], y); }
                if (n < 16) { const float dsk = A.in[I_DSK][g * 16 + n];
#pragma unroll
                    for (int r = 0; r < 16; ++r) { const int t = crow(r, h);
                        if (t < nv) { const size_t o = (size_t)(tok0 + st + t) * DM + g * 16 + n; const float yy = y[r] + dsk * bf2f(F.XN()[o]);
                            const float z = 0.7978845608028654f * (yy + 0.044715f * yy * yy * yy); F.MIX()[o] = f2bf(yy * pg8::sigm(2.f * z)); } } }
            }
        }
        if (PASS == 1) { F.S5E()[(size_t)(cb * 64 + g) * 128 + lane] = hr; F.S5E()[(size_t)(cb * 64 + g) * 128 + 64 + lane] = hi; }
        else { if (sample) { F.out[O_SS5R + (size_t)(cb * 64 + g) * 64 + lane] = hr; F.out[O_SS5I + (size_t)(cb * 64 + g) * 64 + lane] = hi; }
               else if (cb == 127) { F.out[O_PS5R + g * 64 + lane] = hr; F.out[O_PS5I + g * 64 + lane] = hi; } }
    }
}
DI void s5_carry_phase(const Args& A, const Frame& F) {
    const int gt = F.bid * 512 + F.tid;
    if (gt < 4096) { const int g = gt >> 6, p = gt & 63; const float* P = (const float*)(F.ws + WS_S5P);
        const float ar = P[(S5_LAM128 >> 2) + 2 * gt], ai = P[(S5_LAM128 >> 2) + 2 * gt + 1]; float Hr = 0.f, Hi = 0.f;
#pragma unroll 8
        for (int c = 0; c < 128; ++c) { const size_t o = (size_t)(c * 64 + g) * 128 + p; F.S5H()[o] = Hr; F.S5H()[o + 64] = Hi;
            const float er = F.S5E()[o], ei = F.S5E()[o + 64]; const float nr = ar * Hr - ai * Hi + er, ni = ar * Hi + ai * Hr + ei; Hr = nr; Hi = ni; } }
}

#define XB_TMO      128
#define XB_XCNT(j)  (256  + 64 * (j))
#define XB_XSUB(j)  (1280 + 64 * (j))
#define XB_XGEN(j)  (2304 + 64 * (j))
#define XB_TOP      3328
#define XB_TOPGEN   3392
#define XCD_BAR_WORDS 3456
#define XB_SPIN_CAP (1u << 18)

__device__ __forceinline__ unsigned xb_ld(unsigned* p)              { return __hip_atomic_load(p, __ATOMIC_RELAXED, __HIP_MEMORY_SCOPE_AGENT); }
__device__ __forceinline__ unsigned xb_add(unsigned* p, unsigned v) { return __hip_atomic_fetch_add(p, v, __ATOMIC_RELAXED, __HIP_MEMORY_SCOPE_AGENT); }
__device__ __forceinline__ unsigned xb_xcc_id() { return (unsigned)__builtin_amdgcn_s_getreg((3 << 11) | 20) & 0xFu; }
#define XB_SPIN(cond, bar) do { unsigned _sp = 0; while (cond) { __builtin_amdgcn_s_sleep(1); \
    if ((++_sp & 255u) == 0u) { if (xb_ld(&(bar)[XB_TMO])) break; if (_sp > XB_SPIN_CAP) { atomicAdd(&(bar)[XB_TMO], 1u); break; } } } } while (0)

struct XcdBarrier {
    unsigned* bar; unsigned x;
    volatile LAS unsigned* st;
};

__device__ __forceinline__ XcdBarrier xcd_barrier_post(unsigned* bar, volatile LAS unsigned* st) {
    XcdBarrier b; b.bar = bar; b.x = xb_xcc_id(); b.st = st;
    if (threadIdx.x == 0) (void)xb_add(&bar[XB_XCNT(b.x)], 1u);
    return b;
}
__device__ __forceinline__ void xcd_barrier_complete(unsigned* bar, unsigned x, unsigned& nloc, unsigned& nx) {
    const unsigned G = gridDim.x * gridDim.y * gridDim.z;
    unsigned sum, cnt, mine, sp = 0u;
    for (;;) {
        sum = 0u; cnt = 0u; mine = 0u;
#pragma unroll
        for (unsigned j = 0; j < 16; ++j) { const unsigned c = xb_ld(&bar[XB_XCNT(j)]); sum += c; cnt += (c > 0u) ? 1u : 0u; mine = (j == x) ? c : mine; }
        if (sum == G) break;
        __builtin_amdgcn_s_sleep(1);
        if ((++sp & 255u) == 0u) { if (xb_ld(&bar[XB_TMO])) break; if (sp > XB_SPIN_CAP) { atomicAdd(&bar[XB_TMO], 1u); break; } }
    }
    nloc = mine > 0u ? mine : 1u; nx = cnt > 0u ? cnt : 1u;
}

__device__ __forceinline__ void xcd_barrier(const XcdBarrier& b) {
    asm volatile("s_waitcnt vmcnt(0)" ::: "memory");
    __syncthreads();
    if (threadIdx.x == 0) {
        unsigned* bar = b.bar;
        __builtin_amdgcn_s_waitcnt(0);
        unsigned nloc = b.st[0], nx = b.st[1];
        if (nloc == 0u) { xcd_barrier_complete(bar, b.x, nloc, nx); b.st[0] = nloc; b.st[1] = nx; }
        const unsigned old = xb_add(&bar[XB_XSUB(b.x)], 1u);
        const unsigned gen = old / nloc;
        if (old + 1u == (gen + 1u) * nloc) {
            __builtin_amdgcn_fence(__ATOMIC_RELEASE, "agent");
            asm volatile("s_waitcnt vmcnt(0)" ::: "memory");
            const unsigned og = xb_add(&bar[XB_TOP], 1u);
            const unsigned tg = og / nx;
            if (og + 1u == (tg + 1u) * nx) xb_add(&bar[XB_TOPGEN], 1u);
            else XB_SPIN(xb_ld(&bar[XB_TOPGEN]) == tg, bar);
            __builtin_amdgcn_fence(__ATOMIC_ACQUIRE, "");
            xb_add(&bar[XB_XGEN(b.x)], 1u);
            asm volatile("s_waitcnt vmcnt(0)" ::: "memory");
        } else {
            XB_SPIN(xb_ld(&bar[XB_XGEN(b.x)]) == gen, bar);
            __builtin_amdgcn_fence(__ATOMIC_ACQUIRE, "");
            asm volatile("s_waitcnt vmcnt(0)" ::: "memory");
        }
    }
    __syncthreads();
}

constexpr int NPHASE = 17;
__global__ void __launch_bounds__(NWAVES * 64, 2) mega_fwd(Args args) {
    extern __shared__ __attribute__((aligned(16))) unsigned char lds_raw[];
    cg::grid_group grid = cg::this_grid();
    Frame F;
    F.lds = (LAS unsigned char*)lds_raw; F.tid = threadIdx.x; F.lane = F.tid & 63; F.wave = __builtin_amdgcn_readfirstlane(F.tid >> 6); F.G = gridDim.x; F.bid = blockIdx.x;
    F.out = args.out; F.ws = args.ws;
    const int lo = args.ph_lo, hi = args.ph_hi;
    volatile LAS unsigned* misc_ = (volatile LAS unsigned*)(F.lds + LDS_BYTES - 64);
    if (F.tid < 16) misc_[F.tid] = 0u;
    __syncthreads();
    const XcdBarrier xbar_ = xcd_barrier_post((unsigned*)args.ws, misc_);
    if (lo < 0) grid.sync();
#define GSYNC() xcd_barrier(xbar_)
    float* XR = F.out + O_Y;
#ifndef PHMASK
#define PHMASK 0xfffffu
#endif
#define IN(k) (((PHMASK >> (k)) & 1u) && lo <= (k) && (k) < hi)
#define SEAM(k) do { if (IN(k) && IN((k) + 1)) GSYNC(); } while (0)
#ifndef RPTMASK
#define RPTMASK 0u
#endif
#ifndef XSYNC
#define XSYNC 0
#endif
#define RPT(k) (((RPTMASK >> (k)) & 1u) ? 2 : 1)
#define RB(k) for (int rep_ = 0; rep_ < RPT(k); ++rep_) { if (rep_) GSYNC();
#define RE }
#define GEMM_SPLIT(g, E, nM_, nN_, S__) do { pg8::SplitOrder S_; S_.init(nM_, nN_, S__, F.G, (int)blockIdx.x); pg8::gemm_phase<pg8::EpiPartial, pg8::SplitOrder, true, true>(F.lds, g, S_, E); } while (0)
#define GEMM_PHASE(EPI, g, E) do { pg8::StaticOrder S_; S_.init((g).M, (g).N, F.G, (int)blockIdx.x); pg8::gemm_phase<EPI, pg8::StaticOrder, true, true>(F.lds, g, S_, E); } while (0)

    if (IN(0)) { RB(0)  p0_prologue(args, F);  RE } SEAM(0);
    if (IN(1)) { RB(1)  pg8::Gemm g{F.CA(), F.Wada_t(), 256, NMOD, 1024}; pg8::EpiF32Bias E{F.MOD(), NMOD, args.in[I_ADAB]}; GEMM_PHASE(pg8::EpiF32Bias, g, E);  RE } SEAM(1);
    if (IN(2)) { RB(2)  norm_phase(args, F, args.in[I_XP], args.in[I_XS], args.in[I_NMIX], F.MOD(), 0, 1024);  RE } SEAM(2);
    if (IN(3)) { RB(3)  pg8::Gemm g{F.XN(), F.Win_t(), MT, NIN, 1024}; pg8::EpiBf16<0> E{F.PROJ(), NIN, nullptr, 0, 0, 1.f}; GEMM_PHASE(pg8::EpiBf16<0>, g, E);  RE } SEAM(3);
    if (IN(4)) { RB(4)
#ifndef P4SEL
#define P4SEL 7
#endif
        if (P4SEL & 1) for (int u = F.bid; u < 512; u += F.G) attn_unit<false>(args, F, u);
        if (P4SEL & 2) for (int u = (F.bid + 128) % F.G; u < 128; u += F.G) attn_unit<true>(args, F, u);
        if (P4SEL & 4) for (int u = F.bid; u < 512; u += F.G) ret_kv_unit(args, F, u);
        __syncthreads();
    RE } SEAM(4);
    if (IN(5)) { RB(5)  ret_scan_phase(args, F);  RE } SEAM(5);
    if (IN(6)) { RB(6)  if (F.bid < 64) pret_transpose_tile(args, F, F.bid);
        for (int u = F.bid; u < 768; u += F.G) { if (u < 256) ret_out_prompt(args, F, u); else ret_sample_unit(args, F, u - 256); } __syncthreads();  RE } SEAM(6);
    if (IN(7)) { RB(7)  { pg8::Gemm g{F.MIX(), F.Wout_t(), TP, 1024, 1024, 0}; pg8::EpiResid E{args.in[I_XP], args.in[I_XS], XR, F.MOD() + 2048}; GEMM_PHASE(pg8::EpiResid, g, E); }
        { pg8::Gemm g{F.MIX() + (size_t)TP * DM, F.Wout_t(), TS, 1024, 256, 1024}; pg8::EpiPartial E{(bf16*)(F.ws + WS_PART0), TS}; GEMM_SPLIT(g, E, 4, 4, 4); }  RE } SEAM(7);
    if (IN(8)) { RB(8)  norm_phase(args, F, XR, args.in[I_XS], args.in[I_NFFN], F.MOD(), 3072, 4096, (const bf16*)(F.ws + WS_PART0), 4, F.MOD() + 2048, XR);  RE } SEAM(8);
    if (IN(9)) { RB(9)  pg8::Gemm g{F.XN(), F.Wgu_t(0), MT, 2 * DFF, 1024}; pg8::EpiSwiGLU E{F.PROJ(), DFF}; GEMM_PHASE(pg8::EpiSwiGLU, g, E);  RE } SEAM(9);
    if (IN(10)) { RB(10)  { pg8::Gemm g{F.PROJ(), F.Wd_t(0), TP, 1024, DFF, 0}; pg8::EpiResid E{XR, XR + (size_t)TP * DM, XR, F.MOD() + 5120}; GEMM_PHASE(pg8::EpiResid, g, E); }
        { pg8::Gemm g{F.PROJ() + (size_t)TP * DFF, F.Wd_t(0), TS, 1024, 256, DFF}; pg8::EpiPartial E{F.MIX(), TS}; GEMM_SPLIT(g, E, 4, 4, 11); }  RE } SEAM(10);
    if (IN(11)) { RB(11)  norm_phase(args, F, XR, XR + (size_t)TP * DM, args.in[I_NMIX] + 1024, F.MOD() + LMOD, 0, 1024, F.MIX(), 11, F.MOD() + 5120, XR);  RE } SEAM(11);
    if (IN(12)) { RB(12)  s5_phase<1>(args, F);  RE } SEAM(12);
    if (IN(13)) { RB(13)  s5_carry_phase(args, F);  RE } SEAM(13);
    if (IN(14)) { RB(14)  s5_phase<2>(args, F);  RE } SEAM(14);
    if (IN(15)) { RB(15)  pg8::Gemm g{F.MIX(), F.Wglu_t(), MT, 2048, 1024}; pg8::EpiGLUResid E{XR, F.MOD() + LMOD + 2048}; GEMM_PHASE(pg8::EpiGLUResid, g, E);  RE } SEAM(15);
    if (IN(16)) { RB(16)  norm_phase(args, F, XR, XR + (size_t)TP * DM, args.in[I_NFFN] + 1024, F.MOD() + LMOD, 3072, 4096);  RE } SEAM(16);
    if (IN(17)) { RB(17)  pg8::Gemm g{F.XN(), F.Wgu_t(1), MT, 2 * DFF, 1024}; pg8::EpiSwiGLU E{F.PROJ(), DFF}; GEMM_PHASE(pg8::EpiSwiGLU, g, E);  RE } SEAM(17);
    if (IN(18)) { { pg8::Gemm g{F.PROJ(), F.Wd_t(1), TP, 1024, DFF, 0}; pg8::EpiResid E{XR, XR + (size_t)TP * DM, XR, F.MOD() + LMOD + 5120}; GEMM_PHASE(pg8::EpiResid, g, E); }
        { pg8::Gemm g{F.PROJ() + (size_t)TP * DFF, F.Wd_t(1), TS, 1024, 256, DFF}; pg8::EpiPartial E{F.MIX(), TS}; GEMM_SPLIT(g, E, 4, 4, 11); } } SEAM(18);
    if (IN(19)) {
        const int gw = F.bid * NWAVES + F.wave, NGW = F.G * NWAVES; const bf16* part = F.MIX();
        for (int m = TP + gw; m < MT; m += NGW) { const float* grow = F.MOD() + LMOD + 5120 + (size_t)pg8::seq_of_row(m) * NMOD;
#pragma unroll
            for (int j = 0; j < 4; ++j) { const int col = 4 * (64 * j + F.lane); const size_t po = (size_t)(m - TP) * 1024 + col; f32x4 ps = (f32x4){0.f, 0.f, 0.f, 0.f};
                for (int sl = 0; sl < 11; ++sl) { const u32x2 w = *(const u32x2*)(part + (size_t)sl * TS * 1024 + po); ps += (f32x4){bflo(w.x), bfhi(w.x), bflo(w.y), bfhi(w.y)}; }
                *(f32x4*)(XR + (size_t)m * DM + col) = *(const f32x4*)(XR + (size_t)m * DM + col) + *(const f32x4*)(grow + col) * ps; } }
    }
#undef IN
#undef SEAM
}

extern "C" void kernel_launch(void* const* d_in, const int* in_sizes, int n_in, void* d_out, int out_size, void* d_ws, size_t ws_size, hipStream_t stream) {
    static int grid = 0;
    if (grid == 0) {
        if (n_in != 32 || (size_t)out_size != O_END || ws_size < WS_END) { fprintf(stderr, "kernel_launch: unexpected shapes n_in %d out %d ws %zu\n", n_in, out_size, ws_size); grid = -1; return; }
        int dev = 0, cus = 0, per_cu = 0;
        hipGetDevice(&dev); hipDeviceGetAttribute(&cus, hipDeviceAttributeMultiprocessorCount, dev);
        hipFuncSetAttribute((const void*)mega_fwd, hipFuncAttributeMaxDynamicSharedMemorySize, LDS_BYTES);
        hipOccupancyMaxActiveBlocksPerMultiprocessor(&per_cu, (const void*)mega_fwd, NWAVES * 64, LDS_BYTES);
        if (per_cu < 1) { fprintf(stderr, "kernel_launch: occupancy query says %d blocks/CU\n", per_cu); per_cu = 1; }
        (void)hipGetLastError();
        grid = cus;
    }
    if (grid < 0) return;
    if (hipMemsetAsync(d_ws, 0, 65536, stream) != hipSuccess) { fprintf(stderr, "kernel_launch: memset failed\n"); return; }
    Args a{};
    for (int i = 0; i < 32; ++i) a.in[i] = (const float*)d_in[i];
    a.out = (float*)d_out; a.ws = (unsigned char*)d_ws; a.ph_lo = 0; a.ph_hi = 20;
    void* kargs[] = {&a};
    hipError_t e = hipLaunchCooperativeKernel((const void*)mega_fwd, dim3(grid), dim3(NWAVES * 64), kargs, LDS_BYTES, stream);
    if (e != hipSuccess) fprintf(stderr, "cooperative launch failed: %s (grid %d)\n", hipGetErrorString(e), grid);
}
```

```cpp
#include <hip/hip_runtime.h>
#include <hip/hip_cooperative_groups.h>
#include <cstdio>
#include <cstdint>
namespace cg = cooperative_groups;
namespace pg8 {
#define PG8_LAS __attribute__((address_space(3)))
typedef unsigned short bf16_t;
typedef short bf16x8 __attribute__((ext_vector_type(8)));
typedef float f32x4 __attribute__((ext_vector_type(4)));
typedef unsigned u32x4 __attribute__((ext_vector_type(4)));
constexpr int BM = 256, BK = 64, HALF = 128, HTB = HALF * BK * 2  , STAGE_BYTES = 8 * HTB, NXCD = 8, WGM = 8;

__host__ __device__ __forceinline__ int lds_byte(int r, int c) { const int st = (r >> 4) * 2 + (c >> 5), rr = r & 15, cc = c & 31, ob = rr * 64 + cc * 2; return st * 1024 + (ob ^ (((ob >> 9) & 1) << 5)); }
__host__ __device__ __forceinline__ void stage_rc(int b, int& R, int& C) { const int st = b / 1024, sb = b % 1024, swz = sb ^ (((sb >> 9) & 1) << 5); R = (st >> 1) * 16 + swz / 64; C = (st & 1) * 32 + (swz % 64) / 2; }
__host__ __device__ __forceinline__ int perm32(int rho) { const int n = rho >> 4, i = rho & 15; return 8 * (i >> 2) + 4 * n + (i & 3); }

struct Unit { int pm, pn, ks; };
struct Gemm { const bf16_t* A; const bf16_t* Bt; int M, N, K, ld; };

struct StaticOrder {
    int nM, nN, nwg, G, c;
    __host__ __device__ void init(int M, int N, int G_, int c_) { nM = M / BM; nN = N / BM; nwg = nM * nN; G = G_; c = c_; }
    __host__ __device__ bool next(int i, Unit& u) const {
        const long L = (long)i * G + c; if (L >= nwg) return false;
        int wgid = (int)L; { const int q = nwg / NXCD, r = nwg % NXCD, xcd = wgid % NXCD, off = wgid / NXCD; wgid = (xcd < r ? xcd * (q + 1) : r * (q + 1) + (xcd - r) * q) + off; }
        const int nig = WGM * nN, gid = wgid / nig, fm = gid * WGM, gsz = (nM - fm) < WGM ? (nM - fm) : WGM;
        u.pm = fm + ((wgid % nig) % gsz); u.pn = (wgid % nig) / gsz; u.ks = 0; return true;
    }
    __device__ __forceinline__ void a_ready(const Unit&) const {}
    __device__ __forceinline__ void done(const Unit&) const {}
};

struct SplitOrder {
    int nM, nN, nwg, G, c;
    __host__ __device__ void init(int nM_, int nN_, int S, int G_, int c_) { nM = nM_; nN = nN_; nwg = nM_ * nN_ * S; G = G_; c = c_; }
    __host__ __device__ bool next(int i, Unit& u) const { const int L = i * G + c; if (L >= nwg) return false; const int t = nM * nN, r = L % t; u.ks = L / t; u.pm = r % nM; u.pn = r / nM; return true; }
    __device__ __forceinline__ void a_ready(const Unit&) const {}
    __device__ __forceinline__ void done(const Unit&) const {}
};
__device__ __forceinline__ unsigned cvt_pk_bf16(float lo, float hi) { unsigned r; asm volatile("v_cvt_pk_bf16_f32 %0, %1, %2" : "=v"(r) : "v"(lo), "v"(hi)); return r; }
typedef float f32x2 __attribute__((ext_vector_type(2)));
__device__ __forceinline__ f32x2 gelu_pk(f32x2 v) {
    const f32x2 av = __builtin_elementwise_abs(v), d = av * 0.2316418882f + 1.0f;
    f32x2 t; t.x = __builtin_amdgcn_rcpf(d.x); t.y = __builtin_amdgcn_rcpf(d.y);
    f32x2 q = t * 0.5307027145f + (-0.7265760135f); q = q * t + 0.7107068705f; q = q * t + (-0.142248368f); q = q * t + 0.127414796f; q = q * t;
    const f32x2 s = (v * v) * (-0.72134752044f);
    f32x2 e; e.x = __builtin_amdgcn_exp2f(s.x); e.y = __builtin_amdgcn_exp2f(s.y);
    const f32x2 m = v * (q * e), r = v - m;
    f32x2 o; o.x = v.x < 0.f ? m.x : r.x; o.y = v.y < 0.f ? m.y : r.y; return o;
}

template <int ACT  > struct EpiBf16 {
    static constexpr bool PERM = true, AFTER_DRAIN = false; static_assert(ACT == 0 || ACT == 1, "EpiBf16: ACT is 0 (none) or 1 (gelu_pk)");
    bf16_t* O; int ldc; const float* bias; int split_cols; size_t split_stride; float scale0;
    __device__ __forceinline__ void operator()(const f32x4 (&acc)[2][2][4][2], const Unit& u, int wr, int wc, int fr, int fq) const {
        const int row0 = u.pm * BM + wr * 64 + fr; int colt = u.pn * BM; bf16_t* base = O;
        float sc = 1.f; if (split_cols) { const int t = colt / split_cols; base += (size_t)t * split_stride; colt -= t * split_cols; if (t == 0) sc = scale0; }
        const int col0 = colt + wc * 32 + 8 * fq, bcol0 = u.pn * BM + wc * 32 + 8 * fq;
        f32x4 bv[2][2];
#pragma unroll
        for (int bj = 0; bj < 2; ++bj)
#pragma unroll
            for (int n = 0; n < 2; ++n) bv[bj][n] = bias ? *(const f32x4*)(bias + bcol0 + bj * HALF + 4 * n) : (f32x4){0.f, 0.f, 0.f, 0.f};
#pragma unroll
        for (int ai = 0; ai < 2; ++ai)
#pragma unroll
            for (int m = 0; m < 4; ++m) { bf16_t* rowp = base + (size_t)(row0 + ai * HALF + m * 16) * ldc + col0;
#pragma unroll
                for (int bj = 0; bj < 2; ++bj) { f32x4 v0 = acc[ai][bj][m][0] + bv[bj][0], v1 = acc[ai][bj][m][1] + bv[bj][1];
                    if (ACT == 1) { f32x2 a = gelu_pk((f32x2){v0[0], v0[1]}), b = gelu_pk((f32x2){v0[2], v0[3]}), c = gelu_pk((f32x2){v1[0], v1[1]}), d = gelu_pk((f32x2){v1[2], v1[3]});
                        v0 = (f32x4){a.x, a.y, b.x, b.y}; v1 = (f32x4){c.x, c.y, d.x, d.y}; }
                    v0 = v0 * sc; v1 = v1 * sc; u32x4 w; w.x = cvt_pk_bf16(v0[0], v0[1]); w.y = cvt_pk_bf16(v0[2], v0[3]); w.z = cvt_pk_bf16(v1[0], v1[1]); w.w = cvt_pk_bf16(v1[2], v1[3]);
                    *(u32x4*)(rowp + bj * HALF) = w; } }
    }
};
constexpr int TPROMPT = 16384, NMODC = 12288;
__device__ __forceinline__ int seq_of_row(int row) { return row < TPROMPT ? 0 : 1 + ((row - TPROMPT) >> 3); }
__device__ __forceinline__ float sigm(float x) { return __builtin_amdgcn_rcpf(1.0f + __expf(-x)); }
typedef unsigned u32x2 __attribute__((ext_vector_type(2)));

struct EpiF32Bias {
    static constexpr bool PERM = false, AFTER_DRAIN = false;
    float* O; int ldc; const float* bias;
    __device__ __forceinline__ void operator()(const f32x4 (&acc)[2][2][4][2], const Unit& u, int wr, int wc, int fr, int fq) const {
        const int row0 = u.pm * BM + wr * 64 + fr, col0 = u.pn * BM + wc * 32 + 4 * fq;
#pragma unroll
        for (int bj = 0; bj < 2; ++bj)
#pragma unroll
            for (int n = 0; n < 2; ++n) { const int col = col0 + bj * HALF + n * 16; const f32x4 bv = *(const f32x4*)(bias + col);
#pragma unroll
                for (int ai = 0; ai < 2; ++ai)
#pragma unroll
                    for (int m = 0; m < 4; ++m) *(f32x4*)(O + (size_t)(row0 + ai * HALF + m * 16) * ldc + col) = acc[ai][bj][m][n] + bv; }
    }
};
struct EpiPartial {
    static constexpr bool PERM = false, AFTER_DRAIN = false;
    bf16_t* P; int rows; int ldp;
    __device__ __forceinline__ void operator()(const f32x4 (&acc)[2][2][4][2], const Unit& u, int wr, int wc, int fr, int fq) const {
        const int row0 = u.pm * BM + wr * 64 + fr, col0 = u.pn * BM + wc * 32 + 4 * fq; const int lp = ldp ? ldp : 1024; bf16_t* base = P + (size_t)u.ks * rows * lp;
#pragma unroll
        for (int ai = 0; ai < 2; ++ai)
#pragma unroll
            for (int m = 0; m < 4; ++m) { bf16_t* orow = base + (size_t)(row0 + ai * HALF + m * 16) * lp;
#pragma unroll
                for (int bj = 0; bj < 2; ++bj)
#pragma unroll
                    for (int n = 0; n < 2; ++n) { const f32x4 v = acc[ai][bj][m][n]; u32x2 w; w.x = cvt_pk_bf16(v[0], v[1]); w.y = cvt_pk_bf16(v[2], v[3]); *(u32x2*)(orow + col0 + bj * HALF + n * 16) = w; } }
    }
};
struct EpiResid {
    static constexpr bool PERM = false, AFTER_DRAIN = false;
    const float* bp; const float* bs; float* out; const float* gate;
    __device__ __forceinline__ void operator()(const f32x4 (&acc)[2][2][4][2], const Unit& u, int wr, int wc, int fr, int fq) const {
        const int row0 = u.pm * BM + wr * 64 + fr, col0 = u.pn * BM + wc * 32 + 4 * fq;
#pragma unroll
        for (int ai = 0; ai < 2; ++ai)
#pragma unroll
            for (int m = 0; m < 4; ++m) { const int row = row0 + ai * HALF + m * 16;
                const float* brow = row < TPROMPT ? bp + (size_t)row * 1024 : bs + (size_t)(row - TPROMPT) * 1024;
                const float* grow = gate + (size_t)seq_of_row(row) * NMODC; float* orow = out + (size_t)row * 1024;
#pragma unroll
                for (int bj = 0; bj < 2; ++bj)
#pragma unroll
                    for (int n = 0; n < 2; ++n) { const int col = col0 + bj * HALF + n * 16;
                        const f32x4 b = *(const f32x4*)(brow + col), g = *(const f32x4*)(grow + col);
                        *(f32x4*)(orow + col) = b + g * acc[ai][bj][m][n]; } }
    }
};
struct EpiSwiGLU {
    static constexpr bool PERM = false, AFTER_DRAIN = false;
    bf16_t* H; int ldh;
    __device__ __forceinline__ void operator()(const f32x4 (&acc)[2][2][4][2], const Unit& u, int wr, int wc, int fr, int fq) const {
        const int row0 = u.pm * BM + wr * 64 + fr, col0 = u.pn * 128 + wc * 16 + 4 * fq;
#pragma unroll
        for (int ai = 0; ai < 2; ++ai)
#pragma unroll
            for (int m = 0; m < 4; ++m) { bf16_t* rowp = H + (size_t)(row0 + ai * HALF + m * 16) * ldh + col0;
#pragma unroll
                for (int bj = 0; bj < 2; ++bj) { const f32x4 g = acc[ai][bj][m][0], uu = acc[ai][bj][m][1]; f32x4 hv;
#pragma unroll
                    for (int i = 0; i < 4; ++i) hv[i] = g[i] * sigm(g[i]) * uu[i];
                    u32x2 w; w.x = cvt_pk_bf16(hv[0], hv[1]); w.y = cvt_pk_bf16(hv[2], hv[3]);
                    *(u32x2*)(rowp + bj * 64) = w; } }
    }
};
struct EpiGLUResid {
    static constexpr bool PERM = false, AFTER_DRAIN = false;
    float* out; const float* gate;
    __device__ __forceinline__ void operator()(const f32x4 (&acc)[2][2][4][2], const Unit& u, int wr, int wc, int fr, int fq) const {
        const int row0 = u.pm * BM + wr * 64 + fr, col0 = u.pn * 128 + wc * 16 + 4 * fq;
#pragma unroll
        for (int ai = 0; ai < 2; ++ai)
#pragma unroll
            for (int m = 0; m < 4; ++m) { const int row = row0 + ai * HALF + m * 16;
                const float* grow = gate + (size_t)seq_of_row(row) * NMODC; float* orow = out + (size_t)row * 1024;
#pragma unroll
                for (int bj = 0; bj < 2; ++bj) { const int col = col0 + bj * 64; const f32x4 a = acc[ai][bj][m][0], b = acc[ai][bj][m][1];
                    const f32x4 x = *(const f32x4*)(orow + col), g = *(const f32x4*)(grow + col); f32x4 v;
#pragma unroll
                    for (int i = 0; i < 4; ++i) v[i] = x[i] + g[i] * (a[i] * sigm(b[i]));
                    *(f32x4*)(orow + col) = v; } }
    }
};
template <class Epi, class Sched, bool ALIGN_EPI = false, bool SP2 = false>
__device__ __forceinline__ void gemm_phase(PG8_LAS unsigned char* lds, const Gemm g, const Sched& S, const Epi& E) {
    const int tid = threadIdx.x, wid = __builtin_amdgcn_readfirstlane(tid >> 6), lane = tid & 63, wr = wid >> 2, wc = wid & 3, fr = lane & 15, fq = lane >> 4;
    const int K = g.K, nt = K / BK, ld = g.ld ? g.ld : g.K;
    unsigned voffA[2], voffB[2];
#pragma unroll
    for (int i = 0; i < 2; ++i) { int R, C; stage_rc(tid * 16 + i * 8192, R, C); const int Rb = Epi::PERM ? ((R & ~31) + perm32(R & 31)) : R;
        voffA[i] = (unsigned)(R * ld + C) * 2u; voffB[i] = (unsigned)(Rb * ld + C) * 2u; }
    const size_t kstep = (size_t)(BK * 2);
    const size_t hstep = (size_t)HALF * ld * 2;
    const size_t tstep = 2 * hstep;
    const unsigned ldsw = (unsigned)wid * 1024u;
    const int aoff = lds_byte(wr * 64 + fr, fq * 8), boff = lds_byte(wc * 32 + fr, fq * 8);
#define PG8_SA(b, h) (((b) * 2 + (h)) * HTB)
#define PG8_SB(b, h) ((4 + (b) * 2 + (h)) * HTB)
#define PG8_STAGE(bufoff, gbase, voff) do { _Pragma("unroll") for (int _i = 0; _i < 2; ++_i) \
        __builtin_amdgcn_global_load_lds((const unsigned*)((const char*)(gbase) + (voff)[_i]), (PG8_LAS unsigned*)(lds + (bufoff) + ldsw + _i * 8192), 16, 0, 0); } while (0)
#define PG8_LDA(dst, b, h) do { _Pragma("unroll") for (int m = 0; m < 4; ++m) _Pragma("unroll") for (int k = 0; k < 2; ++k) dst[m][k] = *(const PG8_LAS bf16x8*)(lds + PG8_SA(b, h) + aoff + m * 2048 + k * 1024); } while (0)
#define PG8_LDB(dst, b, h) do { _Pragma("unroll") for (int n = 0; n < 2; ++n) _Pragma("unroll") for (int k = 0; k < 2; ++k) dst[n][k] = *(const PG8_LAS bf16x8*)(lds + PG8_SB(b, h) + boff + n * 2048 + k * 1024); } while (0)
#define PG8_MMA(ai, bj, At, Bt) do { __builtin_amdgcn_s_setprio(1); _Pragma("unroll") for (int m = 0; m < 4; ++m) _Pragma("unroll") for (int n = 0; n < 2; ++n) _Pragma("unroll") for (int k = 0; k < 2; ++k) \
        acc[ai][bj][m][n] = __builtin_amdgcn_mfma_f32_16x16x32_bf16(Bt[n][k], At[m][k], acc[ai][bj][m][n], 0, 0, 0); __builtin_amdgcn_s_setprio(0); } while (0)
#define PG8_WAIT_V(n) asm volatile("s_waitcnt vmcnt(" #n ")" ::: "memory")
#define PG8_WAIT_L(n) asm volatile("s_waitcnt lgkmcnt(" #n ")" ::: "memory")
#define PG8_BAR __builtin_amdgcn_s_barrier()
#define PG8_SCHED __builtin_amdgcn_sched_barrier(0)
    Unit cur, nxt; int ui = 0;
    if (!S.next(0, cur)) return;
    f32x4 acc[2][2][4][2];
#pragma unroll
    for (int a = 0; a < 2; ++a)
#pragma unroll
        for (int b = 0; b < 2; ++b)
#pragma unroll
            for (int m = 0; m < 4; ++m)
#pragma unroll
                for (int n = 0; n < 2; ++n) acc[a][b][m][n] = (f32x4){0.f, 0.f, 0.f, 0.f};
    bf16x8 At[4][2], B0[2][2], B1[2][2];
    const char* cA = (const char*)g.A + (size_t)cur.pm * tstep + (size_t)cur.ks * K * 2; const char* cB = (const char*)g.Bt + (size_t)cur.pn * tstep + (size_t)cur.ks * K * 2;
    S.a_ready(cur);
    if constexpr (SP2) {
        PG8_STAGE(PG8_SB(0, 0), cB, voffB); PG8_STAGE(PG8_SB(0, 1), cB + hstep, voffB); PG8_STAGE(PG8_SA(0, 0), cA, voffA); PG8_STAGE(PG8_SA(0, 1), cA + hstep, voffA);
        if (wr == 1) PG8_BAR;
        PG8_WAIT_V(2); PG8_BAR;
        PG8_STAGE(PG8_SB(1, 0), cB + kstep, voffB); PG8_STAGE(PG8_SA(1, 0), cA + kstep, voffA); PG8_STAGE(PG8_SB(1, 1), cB + hstep + kstep, voffB);
        PG8_WAIT_V(6); PG8_BAR;
    } else {
        PG8_STAGE(PG8_SB(0, 0), cB, voffB); PG8_STAGE(PG8_SA(0, 0), cA, voffA); PG8_STAGE(PG8_SB(0, 1), cB + hstep, voffB); PG8_STAGE(PG8_SA(0, 1), cA + hstep, voffA);
        if (wr == 1) PG8_BAR;
        PG8_WAIT_V(4); PG8_BAR;
        PG8_STAGE(PG8_SB(1, 0), cB + kstep, voffB); PG8_STAGE(PG8_SA(1, 0), cA + kstep, voffA); PG8_STAGE(PG8_SB(1, 1), cB + hstep + kstep, voffB);
        PG8_WAIT_V(6); PG8_BAR;
    }
    for (;;) {
        const bool has_next = S.next(ui + 1, nxt);
        const char* nA = has_next ? (const char*)g.A + (size_t)nxt.pm * tstep + (size_t)nxt.ks * K * 2 : cA; const char* nB = has_next ? (const char*)g.Bt + (size_t)nxt.pn * tstep + (size_t)nxt.ks * K * 2 : cB;
        for (int t = 0; t < nt; t += 2) {
            const bool last = (t == nt - 2);
            const char* a1 = cA + (size_t)(t + 1) * kstep;
            const char* a2 = last ? nA : cA + (size_t)(t + 2) * kstep; const char* b2 = last ? nB : cB + (size_t)(t + 2) * kstep;
            const char* a3 = a2 + kstep; const char* b3 = b2 + kstep;
            if (last && has_next) S.a_ready(nxt);
            if constexpr (SP2) {
            PG8_LDB(B0, 0, 0); PG8_LDB(B1, 0, 1); PG8_SCHED; PG8_LDA(At, 0, 0); PG8_STAGE(PG8_SA(1, 1), a1 + hstep, voffA);
            PG8_WAIT_V(8); PG8_WAIT_L(0); PG8_BAR; PG8_MMA(0, 0, At, B0); PG8_MMA(0, 1, At, B1); PG8_BAR; PG8_SCHED;
            PG8_LDA(At, 0, 1); PG8_STAGE(PG8_SB(0, 0), b2, voffB); PG8_STAGE(PG8_SB(0, 1), b2 + hstep, voffB); PG8_STAGE(PG8_SA(0, 0), a2, voffA);
            PG8_WAIT_V(8); PG8_WAIT_L(0); PG8_BAR; PG8_MMA(1, 0, At, B0); PG8_MMA(1, 1, At, B1); PG8_BAR; PG8_SCHED;
            PG8_LDB(B0, 1, 0); PG8_LDB(B1, 1, 1); PG8_SCHED; PG8_LDA(At, 1, 0); PG8_STAGE(PG8_SA(0, 1), a2 + hstep, voffA);
            PG8_WAIT_V(8); PG8_WAIT_L(0); PG8_BAR; PG8_MMA(0, 0, At, B0); PG8_MMA(0, 1, At, B1); PG8_BAR; PG8_SCHED;
            PG8_LDA(At, 1, 1); PG8_STAGE(PG8_SB(1, 0), b3, voffB); PG8_STAGE(PG8_SB(1, 1), b3 + hstep, voffB); PG8_STAGE(PG8_SA(1, 0), a3, voffA);
            PG8_WAIT_V(8); PG8_WAIT_L(0); PG8_BAR; PG8_MMA(1, 0, At, B0); PG8_MMA(1, 1, At, B1); PG8_BAR; PG8_SCHED;
            } else {
            PG8_LDB(B0, 0, 0); PG8_SCHED; PG8_LDA(At, 0, 0); PG8_STAGE(PG8_SA(1, 1), a1 + hstep, voffA);
            PG8_WAIT_L(8); PG8_BAR; PG8_WAIT_L(0); PG8_MMA(0, 0, At, B0); PG8_BAR; PG8_SCHED;
            PG8_LDB(B1, 0, 1); PG8_STAGE(PG8_SB(0, 0), b2, voffB);
            PG8_BAR; PG8_WAIT_L(0); PG8_MMA(0, 1, At, B1); PG8_BAR;
            PG8_LDA(At, 0, 1); PG8_STAGE(PG8_SA(0, 0), a2, voffA);
            PG8_BAR; PG8_WAIT_L(0); PG8_MMA(1, 0, At, B0); PG8_BAR; PG8_SCHED;
            PG8_STAGE(PG8_SB(0, 1), b2 + hstep, voffB);
            PG8_WAIT_V(6); PG8_BAR; PG8_MMA(1, 1, At, B1); PG8_BAR;
            PG8_LDB(B0, 1, 0); PG8_SCHED; PG8_LDA(At, 1, 0); PG8_STAGE(PG8_SA(0, 1), a2 + hstep, voffA);
            PG8_WAIT_L(8); PG8_BAR; PG8_WAIT_L(0); PG8_MMA(0, 0, At, B0); PG8_BAR; PG8_SCHED;
            PG8_LDB(B1, 1, 1); PG8_STAGE(PG8_SB(1, 0), b3, voffB);
            PG8_BAR; PG8_WAIT_L(0); PG8_MMA(0, 1, At, B1); PG8_BAR;
            PG8_LDA(At, 1, 1); PG8_STAGE(PG8_SA(1, 0), a3, voffA);
            PG8_BAR; PG8_WAIT_L(0); PG8_MMA(1, 0, At, B0); PG8_BAR; PG8_SCHED;
            PG8_STAGE(PG8_SB(1, 1), b3 + hstep, voffB);
            PG8_WAIT_V(6); PG8_BAR; PG8_MMA(1, 1, At, B1); PG8_BAR;
            }
        }
        if constexpr (ALIGN_EPI) { if (wr == 0) PG8_BAR; }
        if constexpr (!Epi::AFTER_DRAIN) { E(acc, cur, wr, wc, fr, fq); S.done(cur); }
        if (!has_next) break;
#pragma unroll
        for (int a = 0; a < 2; ++a)
#pragma unroll
            for (int b = 0; b < 2; ++b)
#pragma unroll
                for (int m = 0; m < 4; ++m)
#pragma unroll
                    for (int n = 0; n < 2; ++n) acc[a][b][m][n] = (f32x4){0.f, 0.f, 0.f, 0.f};
        cur = nxt; cA = nA; cB = nB; ++ui;
        if constexpr (ALIGN_EPI) { if (wr == 1) PG8_BAR; }
    }
    PG8_WAIT_V(0);
    if constexpr (!ALIGN_EPI) { if (wr == 0) PG8_BAR; }
    PG8_BAR;
    if constexpr (Epi::AFTER_DRAIN) { E.fused(acc, cur, wr, wc, fr, fq, lds, wid, lane); S.done(cur); }
#undef PG8_SA
#undef PG8_SB
#undef PG8_STAGE
#undef PG8_LDA
#undef PG8_LDB
#undef PG8_MMA
#undef PG8_WAIT_V
#undef PG8_WAIT_L
#undef PG8_BAR
#undef PG8_SCHED
}
}

constexpr int TP = 16384, TS = 1024, MT = TP + TS, DM = 1024, NBATCH = 128;
constexpr int NIN = 2816, DFF = 2816, NMOD = 12288, LMOD = 6144;
constexpr float EPSN = 1e-6f, LOG2E = 1.4426950408889634f;
constexpr int NWAVES = 8;
constexpr size_t O_Y = 0, O_PK = (size_t)MT * DM, O_PV = O_PK + 16384, O_PRET = O_PV + 16384, O_PS5R = O_PRET + 65536, O_PS5I = O_PS5R + 4096,
                 O_SK = O_PS5I + 4096, O_SV = O_SK + 2097152, O_SRET = O_SV + 2097152, O_SS5R = O_SRET + 8388608, O_SS5I = O_SS5R + 524288, O_END = O_SS5I + 524288;
constexpr size_t MiB = 1u << 20;
constexpr size_t WS_CA = 1 * MiB, WS_MOD = 2 * MiB, WS_S5P = 14 * MiB, WS_WIN = 16 * MiB, WS_WOUT = 22 * MiB, WS_WGU0 = 24 * MiB, WS_WGU1 = 35 * MiB,
                 WS_WD0 = 46 * MiB, WS_WD1 = 52 * MiB, WS_WGLU = 58 * MiB, WS_XN = 62 * MiB, WS_RKV = 62 * MiB, WS_MIX = 96 * MiB, WS_PROJ = 130 * MiB,
                 WS_WADA = 130 * MiB, WS_S5E = 130 * MiB, WS_S5H = 134 * MiB, WS_SIN = 224 * MiB, WS_PART0 = 240 * MiB, WS_PART1 = 248 * MiB, WS_END = 256 * MiB;
constexpr size_t S5_LAM = 0, S5_LAM128 = 32768, S5_BBT = 65536, S5_CCT = 65536 + 262144;
constexpr int LDS_BYTES = 147456;

#define LAS __attribute__((address_space(3)))
typedef unsigned short bf16;
typedef unsigned u32x4 __attribute__((ext_vector_type(4)));
typedef unsigned u32x2 __attribute__((ext_vector_type(2)));
typedef float f32x4 __attribute__((ext_vector_type(4)));
typedef float f32x2 __attribute__((ext_vector_type(2)));
typedef float f32x16 __attribute__((ext_vector_type(16)));
typedef short bf16x8 __attribute__((ext_vector_type(8)));
typedef short s16x4 __attribute__((ext_vector_type(4)));
typedef short v4i16_t __attribute__((ext_vector_type(4)));
typedef __bf16 bf16x2_t __attribute__((ext_vector_type(2)));
#define DI __device__ __forceinline__
#define MFMA32(a, b, c) __builtin_amdgcn_mfma_f32_32x32x16_bf16((a), (b), (c), 0, 0, 0)
DI unsigned pk2(float lo, float hi) { f32x2 v = {lo, hi}; bf16x2_t b = __builtin_convertvector(v, bf16x2_t); return __builtin_bit_cast(unsigned, b); }
DI unsigned short f2bf(float f) { return (unsigned short)(pk2(f, 0.f) & 0xffffu); }
DI float bflo(unsigned w) { return __uint_as_float(w << 16); }
DI float bfhi(unsigned w) { return __uint_as_float(w & 0xffff0000u); }
DI float bf2f(unsigned short b) { return __uint_as_float((unsigned)b << 16); }
DI int crow(int r, int h) { return (r & 3) + 8 * (r >> 2) + 4 * h; }
DI float wave_sum(float v) {
#pragma unroll
    for (int o = 1; o < 64; o <<= 1) v += __shfl_xor(v, o);
    return v;
}
DI s16x4 tr_read(const LAS unsigned char* p) { return __builtin_bit_cast(s16x4, __builtin_amdgcn_ds_read_tr16_b64_v4i16((LAS v4i16_t*)p)); }
DI bf16x8 tr_frag(const LAS unsigned char* lo, int hi_off) { const s16x4 a = tr_read(lo), b = tr_read(lo + hi_off); return __builtin_shufflevector(a, b, 0, 1, 2, 3, 4, 5, 6, 7); }
DI bf16x8 pack8(float a0, float a1, float a2, float a3, float a4, float a5, float a6, float a7) {
    u32x4 p; p.x = pk2(a0, a1); p.y = pk2(a2, a3); p.z = pk2(a4, a5); p.w = pk2(a6, a7); return __builtin_bit_cast(bf16x8, p);
}
#define PACK_STEP(x, s) pack8((x)[8 * (s)], (x)[8 * (s) + 1], (x)[8 * (s) + 2], (x)[8 * (s) + 3], (x)[8 * (s) + 4], (x)[8 * (s) + 5], (x)[8 * (s) + 6], (x)[8 * (s) + 7])
DI f32x16 zero16() { f32x16 z;
#pragma unroll
    for (int i = 0; i < 16; ++i) z[i] = 0.f; return z; }
DI void unpack8(const u32x4 w, float* f) { f[0] = bflo(w.x); f[1] = bfhi(w.x); f[2] = bflo(w.y); f[3] = bfhi(w.y); f[4] = bflo(w.z); f[5] = bfhi(w.z); f[6] = bflo(w.w); f[7] = bfhi(w.w); }

struct Args { const float* in[32]; float* out; unsigned char* ws; int ph_lo, ph_hi; };
struct Frame {
    LAS unsigned char* lds; int tid, lane, wave, G, bid;
    float* out; unsigned char* ws;
    DI bf16* CA() const { return (bf16*)(ws + WS_CA); }
    DI bf16* Win_t() const { return (bf16*)(ws + WS_WIN); }
    DI bf16* Wout_t() const { return (bf16*)(ws + WS_WOUT); }
    DI bf16* Wgu_t(int l) const { return (bf16*)(ws + (l ? WS_WGU1 : WS_WGU0)); }
    DI bf16* Wd_t(int l) const { return (bf16*)(ws + (l ? WS_WD1 : WS_WD0)); }
    DI bf16* Wglu_t() const { return (bf16*)(ws + WS_WGLU); }
    DI bf16* Wada_t() const { return (bf16*)(ws + WS_WADA); }
    DI bf16* XN() const { return (bf16*)(ws + WS_XN); }
    DI bf16* MIX() const { return (bf16*)(ws + WS_MIX); }
    DI bf16* PROJ() const { return (bf16*)(ws + WS_PROJ); }
    DI bf16* SIN() const { return (bf16*)(ws + WS_SIN); }
    DI float* MOD() const { return (float*)(ws + WS_MOD); }
    DI float* RKV() const { return (float*)(ws + WS_RKV); }
    DI float* S5E() const { return (float*)(ws + WS_S5E); }
    DI float* S5H() const { return (float*)(ws + WS_S5H); }
};
enum { I_XP = 0, I_XS, I_CK, I_CV, I_SRET, I_S5R, I_S5I, I_CP, I_CS, I_ADAW, I_ADAB, I_NMIX, I_NFFN, I_WG, I_WU, I_WD, I_WIN, I_QG, I_KG, I_SINK, I_RG, I_WOUT,
       I_ARE, I_AIM, I_LDT, I_BRE, I_BIM, I_CRE, I_CIM, I_DSK, I_GLA, I_GLB };

DI void transpose_item(const float* W, int K, int N, bf16* WT, int rs, int ro, LAS float* scr, int item, int lane) {
    const int nblk = N / 32, kb = item / nblk, nb = item % nblk, k0 = 64 * kb, n0 = 32 * nb;
#pragma unroll 8
    for (int i = 0; i < 32; ++i) { const int kk = 2 * i + (lane >> 5); scr[kk * 33 + (lane & 31)] = W[(size_t)(k0 + kk) * N + n0 + (lane & 31)]; }
    asm volatile("s_waitcnt lgkmcnt(0)" ::: "memory");
    const int c = lane & 7;
#pragma unroll
    for (int j = 0; j < 4; ++j) { const int n = (lane >> 3) + 8 * j; const LAS float* s = scr + (8 * c) * 33 + n;
        u32x4 o; o.x = pk2(s[0 * 33], s[1 * 33]); o.y = pk2(s[2 * 33], s[3 * 33]); o.z = pk2(s[4 * 33], s[5 * 33]); o.w = pk2(s[6 * 33], s[7 * 33]);
        const int nn = n0 + n, drow = (nn >> 4) * rs + (nn & 15) + ro;
        *(u32x4*)(WT + (size_t)drow * K + k0 + 8 * c) = o; }
    asm volatile("s_waitcnt lgkmcnt(0)" ::: "memory");
}
DI void p0_prologue(const Args& A, const Frame& F) {
    LAS float* scr = (LAS float*)(F.lds + F.wave * 16384);
    const int gw = F.bid * NWAVES + F.wave, NGW = F.G * NWAVES;
    constexpr int I_A = 16 * 88, I_B = 16 * 32, I_C = 44 * 32, I_E = 16 * 192;
    constexpr int NITEMS = I_A + I_B + 4 * I_A + 2 * I_C + 2 * I_B + 2 * I_E;
    for (int it = gw; it < NITEMS; it += NGW) {
        int r = it;
        if (r < I_A) { transpose_item(A.in[I_WIN], 1024, NIN, F.Win_t(), 16, 0, scr, r, F.lane); continue; } r -= I_A;
        if (r < I_B) { transpose_item(A.in[I_WOUT], 1024, 1024, F.Wout_t(), 16, 0, scr, r, F.lane); continue; } r -= I_B;
        if (r < 4 * I_A) { const int which = r / I_A, rr = r % I_A, l = which >> 1, up = which & 1;
            transpose_item(A.in[up ? I_WU : I_WG] + (size_t)l * 1024 * DFF, 1024, DFF, F.Wgu_t(l), 32, up * 16, scr, rr, F.lane); continue; } r -= 4 * I_A;
        if (r < 2 * I_C) { const int l = r / I_C, rr = r % I_C; transpose_item(A.in[I_WD] + (size_t)l * DFF * 1024, DFF, 1024, F.Wd_t(l), 16, 0, scr, rr, F.lane); continue; } r -= 2 * I_C;
        if (r < 2 * I_B) { const int b = r / I_B, rr = r % I_B; transpose_item(A.in[b ? I_GLB : I_GLA], 1024, 1024, F.Wglu_t(), 32, b * 16, scr, rr, F.lane); continue; } r -= 2 * I_B;
        { const int l = r / I_E, rr = r % I_E; transpose_item(A.in[I_ADAW] + (size_t)l * 1024 * LMOD, 1024, LMOD, F.Wada_t(), 16, l * LMOD, scr, rr, F.lane); }
    }
    const int gt = F.bid * 512 + F.tid, NGT = F.G * 512;
    for (int idx = gt; idx < 256 * 1024; idx += NGT) { const int row = idx >> 10, col = idx & 1023;
        float v = 0.f; if (row == 0) v = A.in[I_CP][col]; else if (row <= NBATCH) v = A.in[I_CS][(row - 1) * 1024 + col];
        F.CA()[idx] = f2bf(v * pg8::sigm(v)); }
    if (gt < 65536) {
        const int gp = gt >> 4, i = gt & 15, g = gp >> 6, p = gp & 63;
        const float are = A.in[I_ARE][gp], aim = A.in[I_AIM][gp], dt = expf(A.in[I_LDT][g]);
        const float a = are * dt, b = aim * dt; const float mag = expf(a), cb = cosf(b), sb = sinf(b), sh = sinf(0.5f * b);
        const float lr = mag * cb, li = mag * sb;
        const float nr = expm1f(a) * cb - 2.f * sh * sh, ni = li;
        const float den = are * are + aim * aim; const float fr = (nr * are + ni * aim) / den, fi = (ni * are - nr * aim) / den;
        bf16* BBt = (bf16*)(F.ws + WS_S5P + S5_BBT); bf16* CCt = (bf16*)(F.ws + WS_S5P + S5_CCT);
        const float br = A.in[I_BRE][gt], bi = A.in[I_BIM][gt];
        BBt[(g * 128 + p) * 16 + i] = f2bf(fr * br - fi * bi); BBt[(g * 128 + 64 + p) * 16 + i] = f2bf(fr * bi + fi * br);
        { const int go = gt >> 6, pp = gt & 63;
          CCt[go * 128 + pp] = f2bf(A.in[I_CRE][go * 64 + pp]); CCt[go * 128 + 64 + pp] = f2bf(-A.in[I_CIM][go * 64 + pp]); }
        if (i == 0) {
            float* P = (float*)(F.ws + WS_S5P);
            P[(S5_LAM >> 2) + 2 * gp] = lr; P[(S5_LAM >> 2) + 2 * gp + 1] = li;
            float pr = lr, pi = li;
#pragma unroll
            for (int k = 0; k < 7; ++k) { const float t = pr * pr - pi * pi; pi = 2.f * pr * pi; pr = t; }
            P[(S5_LAM128 >> 2) + 2 * gp] = pr; P[(S5_LAM128 >> 2) + 2 * gp + 1] = pi;
        }
    }
}

DI void norm_phase(const Args& A, const Frame& F, const float* xp, const float* xs, const float* gamma, const float* mod, int sh_off, int sc_off, const bf16* part = nullptr, int ns = 0, const float* pgate = nullptr, float* xw = nullptr, const bf16* gpart = nullptr) {
    const int gw = F.bid * NWAVES + F.wave, NGW = F.G * NWAVES;
    for (int m = gw; m < MT; m += NGW) {
        const float* xrow = m < TP ? xp + (size_t)m * DM : xs + (size_t)(m - TP) * DM;
        const float* mrow = mod + (size_t)pg8::seq_of_row(m) * NMOD;
        f32x4 v[4]; float ss = 0.f;
#pragma unroll
        for (int j = 0; j < 4; ++j) { v[j] = *(const f32x4*)(xrow + 4 * (64 * j + F.lane));
            if (part && m >= TP) { const int col = 4 * (64 * j + F.lane); const size_t po = (size_t)(m - TP) * 1024 + col;
                const f32x4 g = *(const f32x4*)(pgate + (size_t)pg8::seq_of_row(m) * NMOD + col); f32x4 ps = (f32x4){0.f, 0.f, 0.f, 0.f};
                for (int sl = 0; sl < ns; ++sl) { const u32x2 w = *(const u32x2*)(part + (size_t)sl * TS * 1024 + po); ps += (f32x4){bflo(w.x), bfhi(w.x), bflo(w.y), bfhi(w.y)}; }
                v[j] = v[j] + g * ps; *(f32x4*)(xw + (size_t)m * DM + col) = v[j]; }
            if (gpart && m >= TP) { const int col = 4 * (64 * j + F.lane); const size_t po = (size_t)(m - TP) * 2048 + (col >> 4) * 32 + (col & 15);
                const f32x4 g = *(const f32x4*)(pgate + (size_t)pg8::seq_of_row(m) * NMOD + col); f32x4 pa = (f32x4){0.f, 0.f, 0.f, 0.f}, pb = pa;
                for (int sl = 0; sl < ns; ++sl) { const u32x2 wa = *(const u32x2*)(gpart + (size_t)sl * TS * 2048 + po), wb = *(const u32x2*)(gpart + (size_t)sl * TS * 2048 + po + 16);
                    pa += (f32x4){bflo(wa.x), bfhi(wa.x), bflo(wa.y), bfhi(wa.y)}; pb += (f32x4){bflo(wb.x), bfhi(wb.x), bflo(wb.y), bfhi(wb.y)}; }
                f32x4 gl; gl.x = pa.x * pg8::sigm(pb.x); gl.y = pa.y * pg8::sigm(pb.y); gl.z = pa.z * pg8::sigm(pb.z); gl.w = pa.w * pg8::sigm(pb.w);
                v[j] = v[j] + g * gl; *(f32x4*)(xw + (size_t)m * DM + col) = v[j]; }
            ss += (v[j].x * v[j].x + v[j].y * v[j].y) + (v[j].z * v[j].z + v[j].w * v[j].w); }
        const float rstd = rsqrtf(wave_sum(ss) * (1.f / DM) + EPSN);
#pragma unroll
        for (int j = 0; j < 4; ++j) { const int col = 4 * (64 * j + F.lane);
            const f32x4 g = *(const f32x4*)(gamma + col), sc = *(const f32x4*)(mrow + sc_off + col), sh = *(const f32x4*)(mrow + sh_off + col);
            const f32x4 y = v[j] * rstd * g * (1.f + sc) + sh;
            u32x2 w; w.x = pk2(y.x, y.y); w.y = pk2(y.z, y.w); *(u32x2*)(F.XN() + (size_t)m * DM + col) = w; }
    }
}

template <bool SAMPLE> DI void attn_unit(const Args& A, const Frame& F, int uidx) {
    LAS unsigned char* Kl = F.lds; LAS unsigned char* Vl = F.lds + 46080;
    int tid = F.tid; asm volatile("" : "+v"(tid)); const int lane = tid & 63, w = F.wave;
    const int q0 = SAMPLE ? 0 : 32 * uidx, b = uidx;
    const float* kgain = A.in[I_KG];
    __syncthreads();
#pragma unroll 1
    for (int it = 0; it < 5; ++it) {
        const int t = tid + 512 * it, ch = t & 7, rr = t >> 3, kv = rr >= 160 ? 1 : 0, kk = rr - 160 * kv;
        float kf[8], vf[8]; bool valid = true, donorm = true; int tok = 0;
        if (SAMPLE) {
            if (kk < 128) { donorm = false; const size_t o = ((size_t)(b * 128 + kk) * 2 + kv) * 64 + 8 * ch;
                const f32x4 k0 = *(const f32x4*)(A.in[I_CK] + o), k1 = *(const f32x4*)(A.in[I_CK] + o + 4), v0 = *(const f32x4*)(A.in[I_CV] + o), v1 = *(const f32x4*)(A.in[I_CV] + o + 4);
                kf[0] = k0.x; kf[1] = k0.y; kf[2] = k0.z; kf[3] = k0.w; kf[4] = k1.x; kf[5] = k1.y; kf[6] = k1.z; kf[7] = k1.w;
                vf[0] = v0.x; vf[1] = v0.y; vf[2] = v0.z; vf[3] = v0.w; vf[4] = v1.x; vf[5] = v1.y; vf[6] = v1.z; vf[7] = v1.w; }
            else { valid = kk < 136; tok = TP + b * 8 + ((kk - 128) & 7); }
        } else { tok = q0 - 128 + kk; valid = tok >= 0; if (!valid) tok = 0; }
        if (!SAMPLE || kk >= 128) {
            const bf16* src = F.PROJ() + (size_t)tok * NIN + 512 + kv * 64 + 8 * ch;
            const u32x4 kw = *(const u32x4*)src, vw = *(const u32x4*)(src + 128);
            unpack8(kw, kf); unpack8(vw, vf);
        }
        float ss = 0.f;
#pragma unroll
        for (int j = 0; j < 8; ++j) ss += kf[j] * kf[j];
        ss += __shfl_xor(ss, 1); ss += __shfl_xor(ss, 2); ss += __shfl_xor(ss, 4);
        const float rstd = rsqrtf(ss * (1.f / 64.f) + EPSN);
#pragma unroll
        for (int j = 0; j < 8; ++j) { if (donorm) kf[j] = kf[j] * rstd * kgain[8 * ch + j]; if (!valid) { kf[j] = 0.f; vf[j] = 0.f; } }
        const int lo = ((kv * 160 + kk) * 72 + 8 * ch) * 2;
        *(LAS u32x4*)(Kl + lo) = (u32x4){pk2(kf[0], kf[1]), pk2(kf[2], kf[3]), pk2(kf[4], kf[5]), pk2(kf[6], kf[7])};
        *(LAS u32x4*)(Vl + lo) = (u32x4){pk2(vf[0], vf[1]), pk2(vf[2], vf[3]), pk2(vf[4], vf[5]), pk2(vf[6], vf[7])};
        float* ok = nullptr; float* ov = nullptr;
        if (SAMPLE) { if (kk >= 8 && kk < 136) { const size_t o = ((size_t)(b * 128 + kk - 8) * 2 + kv) * 64 + 8 * ch; ok = F.out + O_SK + o; ov = F.out + O_SV + o; } }
        else { if (q0 == TP - 32 && kk >= 32) { const size_t o = ((size_t)(kk - 32) * 2 + kv) * 64 + 8 * ch; ok = F.out + O_PK + o; ov = F.out + O_PV + o; } }
        if (ok) { *(f32x4*)ok = (f32x4){kf[0], kf[1], kf[2], kf[3]}; *(f32x4*)(ok + 4) = (f32x4){kf[4], kf[5], kf[6], kf[7]};
                  *(f32x4*)ov = (f32x4){vf[0], vf[1], vf[2], vf[3]}; *(f32x4*)(ov + 4) = (f32x4){vf[4], vf[5], vf[6], vf[7]}; }
    }
    const int n = lane & 31, h = lane >> 5, hh = w, kvh = hh >> 2;
    const int qtok = SAMPLE ? TP + b * 8 + (n & 7) : q0 + n;
    bf16x8 qf[4];
    {
        const bf16* qp = F.PROJ() + (size_t)qtok * NIN + hh * 64 + 8 * h; float qv[4][8]; float ss = 0.f;
#pragma unroll
        for (int s = 0; s < 4; ++s) { const u32x4 raw = *(const u32x4*)(qp + 16 * s); unpack8(raw, qv[s]);
#pragma unroll
            for (int j = 0; j < 8; ++j) ss += qv[s][j] * qv[s][j]; }
        ss += __shfl_xor(ss, 32);
        const float rstd = rsqrtf(ss * (1.f / 64.f) + EPSN) * (0.125f * LOG2E);
        const float* qg = A.in[I_QG];
#pragma unroll
        for (int s = 0; s < 4; ++s) { float t[8];
#pragma unroll
            for (int j = 0; j < 8; ++j) t[j] = qv[s][j] * rstd * qg[16 * s + 8 * h + j];
            qf[s] = pack8(t[0], t[1], t[2], t[3], t[4], t[5], t[6], t[7]); }
    }
    __syncthreads();
    f32x16 S[5];
#pragma unroll
    for (int kt = 0; kt < 5; ++kt) { S[kt] = zero16();
#pragma unroll
        for (int s = 0; s < 4; ++s) { const bf16x8 a = *(const LAS bf16x8*)(Kl + ((kvh * 160 + 32 * kt + n) * 72 + 16 * s + 8 * h) * 2); S[kt] = MFMA32(a, qf[s], S[kt]); } __builtin_amdgcn_sched_barrier(0); }
    const float slope2 = exp2f(-(float)(hh + 1)) * LOG2E, sink2 = A.in[I_SINK][hh] * LOG2E;
    float mx = -1e30f;
#pragma unroll
    for (int kt = 0; kt < 5; ++kt)
#pragma unroll
        for (int r = 0; r < 16; ++r) { const int kidx = 32 * kt + crow(r, h), dist = 128 + n - kidx;
            const bool okk = dist >= 0 && dist < 128 && (SAMPLE || q0 - 128 + kidx >= 0);
            const float v = okk ? S[kt][r] - slope2 * (float)dist : -1e30f; S[kt][r] = v; mx = fmaxf(mx, v); }
    mx = fmaxf(mx, __shfl_xor(mx, 32)); mx = fmaxf(mx, sink2);
    float sum = 0.f;
    bf16x8 pfs[5][2];
#pragma unroll
    for (int kt = 0; kt < 5; ++kt)
#pragma unroll
        for (int s2 = 0; s2 < 2; ++s2) { float p[8];
#pragma unroll
            for (int j = 0; j < 8; ++j) { p[j] = exp2f(S[kt][8 * s2 + j] - mx); sum += p[j]; }
            pfs[kt][s2] = pack8(p[0], p[1], p[2], p[3], p[4], p[5], p[6], p[7]); }
    sum += __shfl_xor(sum, 32);
    const float inv = 1.f / (sum + exp2f(sink2 - mx));
    __builtin_amdgcn_sched_barrier(0);
    f32x16 O[2]; O[0] = zero16(); O[1] = zero16();
    const int i16 = lane & 15, tq = i16 >> 2, tp = i16 & 3, blk = (lane >> 4) & 1;
    const LAS unsigned char* vbase = Vl + ((kvh * 160 + 4 * h + tq) * 72 + 16 * blk + 4 * tp) * 2;
#pragma unroll
    for (int kt = 0; kt < 5; ++kt) {
#pragma unroll
        for (int s2 = 0; s2 < 2; ++s2) {
#pragma unroll
            for (int dt = 0; dt < 2; ++dt) { const bf16x8 vfr = tr_frag(vbase + ((32 * kt + 16 * s2) * 72 + 32 * dt) * 2, 8 * 72 * 2);
                O[dt] = MFMA32(vfr, pfs[kt][s2], O[dt]); } }
        __builtin_amdgcn_sched_barrier(0); }
    if (!SAMPLE || n < 8) {
        bf16* op = F.MIX() + (size_t)qtok * DM + hh * 64;
#pragma unroll
        for (int dt = 0; dt < 2; ++dt)
#pragma unroll
            for (int g4 = 0; g4 < 4; ++g4) { u32x2 wv; wv.x = pk2(O[dt][4 * g4] * inv, O[dt][4 * g4 + 1] * inv); wv.y = pk2(O[dt][4 * g4 + 2] * inv, O[dt][4 * g4 + 3] * inv);
                *(u32x2*)(op + 32 * dt + 8 * g4 + 4 * h) = wv; }
    }
}

DI float ret_log2g(int head) { return log2f(1.0f - exp2f(-5.0f - (float)head)); }
constexpr float KSC = 0.08838834764831845f;
DI void ret_kv_unit(const Args& A, const Frame& F, int uidx) {
    const int c = uidx >> 2, head = uidx & 3; int tid = F.tid; asm volatile("" : "+v"(tid)); const int lane = tid & 63, w = F.wave;
    LAS unsigned char* Kl = F.lds; LAS unsigned char* Vl = F.lds + 34816;
    const float lg = ret_log2g(head);
    __syncthreads();
#pragma unroll 1
    for (int it = 0; it < 8; ++it) { const int t = tid + 512 * it, ch = t & 15, j = (t >> 4) & 127, isv = t >> 11;
        const bf16* src = F.PROJ() + (size_t)(c * 128 + j) * NIN + (isv ? 1792 : 1280) + head * 128 + 8 * ch;
        u32x4 wv = *(const u32x4*)src;
        if (!isv) { float f[8]; unpack8(wv, f); const float sc = KSC * exp2f(lg * (float)(127 - j));
            wv = (u32x4){pk2(f[0] * sc, f[1] * sc), pk2(f[2] * sc, f[3] * sc), pk2(f[4] * sc, f[5] * sc), pk2(f[6] * sc, f[7] * sc)}; }
        *(LAS u32x4*)((isv ? Vl : Kl) + (j * 136 + 8 * ch) * 2) = wv; }
    __syncthreads();
    const int n = lane & 31, h = lane >> 5, i16 = lane & 15, tq = i16 >> 2, tp = i16 & 3, blk = (lane >> 4) & 1;
    const int et = w >> 1, dt0 = 2 * (w & 1);
    f32x16 acc[2]; acc[0] = zero16(); acc[1] = zero16();
#pragma unroll
    for (int s = 0; s < 8; ++s) { const int rowoff = (16 * s + 8 * h + tq) * 136;
        const bf16x8 a = tr_frag(Vl + (rowoff + 32 * et + 16 * blk + 4 * tp) * 2, 4 * 136 * 2);
#pragma unroll
        for (int x = 0; x < 2; ++x) { const bf16x8 bb = tr_frag(Kl + (rowoff + 32 * (dt0 + x) + 16 * blk + 4 * tp) * 2, 4 * 136 * 2); acc[x] = MFMA32(a, bb, acc[x]); } }
    float* dst = F.RKV() + ((size_t)(c * 4 + head) * 128) * 128;
#pragma unroll
    for (int x = 0; x < 2; ++x)
#pragma unroll
        for (int r = 0; r < 16; ++r) dst[(size_t)(32 * et + crow(r, h)) * 128 + 32 * (dt0 + x) + n] = acc[x][r];
}
DI void ret_scan_phase(const Args& A, const Frame& F) {
    const int gt = F.bid * 512 + F.tid;
    if (gt < 65536) { const int head = gt >> 14, e = (gt >> 7) & 127, d = gt & 127;
        const float dc = exp2f(ret_log2g(head) * 128.f); float S = 0.f;
#pragma unroll 8
        for (int c = 0; c < 128; ++c) { F.SIN()[(size_t)c * 65536 + gt] = f2bf(S); S = S * dc + F.RKV()[(size_t)c * 65536 + gt]; }
        ((float*)(F.ws + WS_S5P + MiB))[gt] = S; (void)head; (void)e; (void)d; }
}
DI void pret_transpose_tile(const Args& A, const Frame& F, int tile) {
    const int head = tile >> 4, et = (tile >> 2) & 3, dt = tile & 3; LAS float* T = (LAS float*)F.lds;
    const float* src = (const float*)(F.ws + WS_S5P + MiB) + (size_t)head * 16384; float* dst = F.out + O_PRET + (size_t)head * 16384;
    __syncthreads();
    for (int idx = F.tid; idx < 1024; idx += 512) { const int el = idx >> 5, dl = idx & 31; T[el * 33 + dl] = src[(32 * et + el) * 128 + 32 * dt + dl]; }
    __syncthreads();
    for (int idx = F.tid; idx < 1024; idx += 512) { const int dl = idx >> 5, el = idx & 31; dst[(32 * dt + dl) * 128 + 32 * et + el] = T[el * 33 + dl]; }
    __syncthreads();
}
DI void ret_out_prompt(const Args& A, const Frame& F, int bu) {
    const int c = bu >> 1, hp = bu & 1; int tid = F.tid; asm volatile("" : "+v"(tid)); const int lane = tid & 63, w = F.wave;
    LAS unsigned char* Vl = F.lds;
    __syncthreads();
#pragma unroll 1
    for (int it = 0; it < 8; ++it) { const int t = tid + 512 * it, ch = t & 15, j = (t >> 4) & 127, hl = t >> 11;
        *(LAS u32x4*)(Vl + ((hl * 128 + j) * 136 + 8 * ch) * 2) = *(const u32x4*)(F.PROJ() + (size_t)(c * 128 + j) * NIN + 1792 + (2 * hp + hl) * 128 + 8 * ch); }
    __syncthreads();
    const int hl = w >> 2, it = w & 3, head = 2 * hp + hl, n = lane & 31, h = lane >> 5, i16 = lane & 15, tq = i16 >> 2, tp = i16 & 3, blk = (lane >> 4) & 1;
    const int tok = c * 128 + 32 * it + n; const float lg = ret_log2g(head);
    bf16x8 qf[8];
#pragma unroll
    for (int s = 0; s < 8; ++s) qf[s] = *(const bf16x8*)(F.PROJ() + (size_t)tok * NIN + 768 + head * 128 + 16 * s + 8 * h);
    f32x16 acc[4];
#pragma unroll
    for (int et = 0; et < 4; ++et) { acc[et] = zero16();
#pragma unroll
        for (int s = 0; s < 8; ++s) { const bf16x8 a = *(const bf16x8*)(F.SIN() + ((size_t)(c * 4 + head) * 128 + 32 * et + n) * 128 + 16 * s + 8 * h); acc[et] = MFMA32(a, qf[s], acc[et]); } }
    const float dq = exp2f(lg * (float)(32 * it + n + 1));
#pragma unroll
    for (int et = 0; et < 4; ++et) acc[et] = acc[et] * dq;
#pragma unroll 1
    for (int jt = 0; jt <= it; ++jt) {
        f32x16 X = zero16();
#pragma unroll
        for (int s = 0; s < 8; ++s) { const bf16x8 a = *(const bf16x8*)(F.PROJ() + (size_t)(c * 128 + 32 * jt + n) * NIN + 1280 + head * 128 + 16 * s + 8 * h); X = MFMA32(a, qf[s], X); }
#pragma unroll
        for (int r = 0; r < 16; ++r) { const int dd = 32 * it + n - (32 * jt + crow(r, h)); X[r] = dd >= 0 ? X[r] * (KSC * exp2f(lg * (float)dd)) : 0.f; }
#pragma unroll
        for (int s2 = 0; s2 < 2; ++s2) { const bf16x8 pf = PACK_STEP(X, s2);
#pragma unroll
            for (int et = 0; et < 4; ++et) { const bf16x8 vfr = tr_frag(Vl + ((hl * 128 + 32 * jt + 16 * s2 + 4 * h + tq) * 136 + 32 * et + 16 * blk + 4 * tp) * 2, 8 * 136 * 2);
                acc[et] = MFMA32(vfr, pf, acc[et]); } }
    }
    float sum = 0.f;
#pragma unroll
    for (int et = 0; et < 4; ++et)
#pragma unroll
        for (int r = 0; r < 16; ++r) sum += acc[et][r];
    sum += __shfl_xor(sum, 32); const float mean = sum * (1.f / 128.f); float var = 0.f;
#pragma unroll
    for (int et = 0; et < 4; ++et)
#pragma unroll
        for (int r = 0; r < 16; ++r) { const float dlt = acc[et][r] - mean; var += dlt * dlt; }
    var += __shfl_xor(var, 32); const float rstd = rsqrtf(var * (1.f / 128.f) + EPSN);
    const bf16* gp = F.PROJ() + (size_t)tok * NIN + 2304 + head * 128; bf16* op = F.MIX() + (size_t)tok * DM + 512 + head * 128; const float* rg = A.in[I_RG] + head * 128;
#pragma unroll
    for (int et = 0; et < 4; ++et)
#pragma unroll
        for (int g4 = 0; g4 < 4; ++g4) { const int e0 = 32 * et + 8 * g4 + 4 * h; const u32x2 gw = *(const u32x2*)(gp + e0); const f32x4 rgv = *(const f32x4*)(rg + e0);
            float gv[4] = {bflo(gw.x), bfhi(gw.x), bflo(gw.y), bfhi(gw.y)}; float y[4];
#pragma unroll
            for (int i = 0; i < 4; ++i) y[i] = (acc[et][4 * g4 + i] - mean) * rstd * rgv[i] * (gv[i] * pg8::sigm(gv[i]));
            u32x2 wv; wv.x = pk2(y[0], y[1]); wv.y = pk2(y[2], y[3]); *(u32x2*)(op + e0) = wv; }
}
DI void ret_sample_unit(const Args& A, const Frame& F, int uidx) {
    const int b = uidx >> 2, head = uidx & 3; const int tid = F.tid, lane = F.lane, w = F.wave;
    LAS float* Q = (LAS float*)F.lds; LAS float* Ks = Q + 1024; LAS float* V = Ks + 1024; LAS float* INN = V + 1024; LAS float* OO = INN + 64; LAS float* O2 = OO + 1024;
    const float lg = ret_log2g(head);
    __syncthreads();
    for (int idx = tid; idx < 3072; idx += 512) { const int which = idx >> 10, i = (idx >> 7) & 7, d = idx & 127;
        const float v = bf2f(F.PROJ()[(size_t)(TP + b * 8 + i) * NIN + (which == 0 ? 768 : which == 1 ? 1280 : 1792) + head * 128 + d]);
        (which == 0 ? Q : which == 1 ? Ks : V)[i * 128 + d] = which == 1 ? v * KSC : v; }
    __syncthreads();
    if (tid < 64) { const int i = tid >> 3, j = tid & 7; float dot = 0.f;
        for (int d = 0; d < 128; ++d) dot += Q[i * 128 + d] * Ks[j * 128 + d];
        INN[tid] = j <= i ? dot * exp2f(lg * (float)(i - j)) : 0.f; }
    {
        const int e4 = (tid & 31) * 4, dg = tid >> 5; f32x4 vv[8], o2[8];
#pragma unroll
        for (int j = 0; j < 8; ++j) { vv[j] = *(const LAS f32x4*)(V + j * 128 + e4) * exp2f(lg * (float)(7 - j)); o2[j] = (f32x4){0.f, 0.f, 0.f, 0.f}; }
        const float dc = exp2f(lg * 8.f);
        const float* S0 = A.in[I_SRET] + ((size_t)(b * 4 + head) * 128) * 128; float* S1 = F.out + O_SRET + ((size_t)(b * 4 + head) * 128) * 128;
        f32x4 sv[8];
#pragma unroll
        for (int dd = 0; dd < 8; ++dd) sv[dd] = *(const f32x4*)(S0 + (dg * 8 + dd) * 128 + e4);
#pragma unroll
        for (int dd = 0; dd < 8; ++dd) { const int d = dg * 8 + dd; const f32x4 s = sv[dd]; f32x4 sn = s * dc;
#pragma unroll
            for (int j = 0; j < 8; ++j) { o2[j] += Q[j * 128 + d] * s; sn += Ks[j * 128 + d] * vv[j]; }
            *(f32x4*)(S1 + d * 128 + e4) = sn; }
#pragma unroll
        for (int i = 0; i < 8; ++i) *(LAS f32x4*)(O2 + (dg * 8 + i) * 128 + e4) = o2[i];
    }
    __syncthreads();
    { const int e = tid & 127, ig = tid >> 7;
#pragma unroll
        for (int ii = 0; ii < 2; ++ii) { const int i = 2 * ig + ii; float o = 0.f;
#pragma unroll
            for (int dg = 0; dg < 16; ++dg) o += O2[(dg * 8 + i) * 128 + e];
            o *= exp2f(lg * (float)(i + 1));
            for (int j = 0; j <= i; ++j) o += INN[i * 8 + j] * V[j * 128 + e];
            OO[i * 128 + e] = o; } }
    __syncthreads();
    { const int i = w; const float a0 = OO[i * 128 + lane], a1 = OO[i * 128 + 64 + lane];
        const float mean = wave_sum(a0 + a1) * (1.f / 128.f); const float d0 = a0 - mean, d1 = a1 - mean;
        const float rstd = rsqrtf(wave_sum(d0 * d0 + d1 * d1) * (1.f / 128.f) + EPSN);
        const int tok = TP + b * 8 + i; const bf16* gp = F.PROJ() + (size_t)tok * NIN + 2304 + head * 128; bf16* op = F.MIX() + (size_t)tok * DM + 512 + head * 128; const float* rg = A.in[I_RG] + head * 128;
        const float g0 = bf2f(gp[lane]), g1 = bf2f(gp[64 + lane]);
        op[lane] = f2bf(d0 * rstd * rg[lane] * (g0 * pg8::sigm(g0))); op[64 + lane] = f2bf(d1 * rstd * rg[64 + lane] * (g1 * pg8::sigm(g1))); }
}

template <int PASS> DI void s5_phase(const Args& A, const Frame& F) {
    const int lane = F.lane, w = F.wave; const int gw = F.bid * NWAVES + w, NGW = F.G * NWAVES;
    LAS unsigned char* L = F.lds + w * 16896;
    const float* P = (const float*)(F.ws + WS_S5P); const bf16* BBt = (const bf16*)(F.ws + WS_S5P + S5_BBT); const bf16* CCt = (const bf16*)(F.ws + WS_S5P + S5_CCT);
    const int n = lane & 31, h = lane >> 5;
    const int nunits = PASS == 1 ? 64 * 128 : 2 * 64 * 128;
#pragma unroll 1
    for (int u = gw; u < nunits; u += NGW) {
        const bool sample = u >= 8192; const int uu = sample ? u - 8192 : u; const int g = uu & 63, cb = uu >> 6;
        const int tok0 = sample ? TP + cb * 8 : cb * 128, ntok = sample ? 8 : 128;
        const float lr = P[(S5_LAM >> 2) + 2 * (g * 64 + lane)], li = P[(S5_LAM >> 2) + 2 * (g * 64 + lane) + 1];
        float hr = 0.f, hi = 0.f;
        if (PASS == 2) { if (sample) { hr = A.in[I_S5R][(size_t)(cb * 64 + g) * 64 + lane]; hi = A.in[I_S5I][(size_t)(cb * 64 + g) * 64 + lane]; }
                         else { hr = F.S5H()[(size_t)(cb * 64 + g) * 128 + lane]; hi = F.S5H()[(size_t)(cb * 64 + g) * 128 + 64 + lane]; } }
        bf16x8 bbf[4];
#pragma unroll
        for (int qt = 0; qt < 4; ++qt) bbf[qt] = *(const bf16x8*)(BBt + (size_t)(g * 128 + 32 * qt + n) * 16 + 8 * h);
        bf16x8 cfh[8];
        if (PASS == 2) {
#pragma unroll
            for (int s = 0; s < 8; ++s) cfh[s] = *(const bf16x8*)(CCt + (size_t)(g * 16 + (n & 15)) * 128 + 16 * s + 8 * h); }
#pragma unroll 1
        for (int st = 0; st < ntok; st += 32) {
            const int nv = ntok - st < 32 ? ntok - st : 32;
            bf16x8 a = (bf16x8){0, 0, 0, 0, 0, 0, 0, 0};
            if (n < nv) a = *(const bf16x8*)(F.XN() + (size_t)(tok0 + st + n) * DM + g * 16 + 8 * h);
#pragma unroll
            for (int qt = 0; qt < 4; ++qt) { const f32x16 cc = MFMA32(a, bbf[qt], zero16());
#pragma unroll
                for (int r = 0; r < 16; ++r) *(LAS float*)(L + crow(r, h) * 528 + 4 * (32 * qt + n)) = cc[r]; }
#pragma unroll 4
            for (int t = 0; t < nv; ++t) { const float br = *(LAS float*)(L + t * 528 + 4 * lane), bi = *(LAS float*)(L + t * 528 + 256 + 4 * lane);
                const float nr = lr * hr - li * hi + br, ni = lr * hi + li * hr + bi; hr = nr; hi = ni;
                if (PASS == 2) { *(LAS unsigned short*)(L + t * 528 + 2 * lane) = f2bf(hr); *(LAS unsigned short*)(L + t * 528 + 128 + 2 * lane) = f2bf(hi); } }
            if (PASS == 2) {
                f32x16 y = zero16();
#pragma unroll
                for (int s = 0; s < 8; ++s) { const bf16x8 hs = *(const LAS bf16x8*)(L + n * 528 + 32 * s + 16 * h); y = MFMA32(hs, cfh[s], y); }
                if (n < 16) { const float dsk = A.in[I_DSK][g * 16 + n];
#pragma unroll
                    for (int r = 0; r < 16; ++r) { const int t = crow(r, h);
                        if (t < nv) { const size_t o = (size_t)(tok0 + st + t) * DM + g * 16 + n; const float yy = y[r] + dsk * bf2f(F.XN()[o]);
                            const float z = 0.7978845608028654f * (yy + 0.044715f * yy * yy * yy); F.MIX()[o] = f2bf(yy * pg8::sigm(2.f * z)); } } }
            }
        }
        if (PASS == 1) { F.S5E()[(size_t)(cb * 64 + g) * 128 + lane] = hr; F.S5E()[(size_t)(cb * 64 + g) * 128 + 64 + lane] = hi; }
        else { if (sample) { F.out[O_SS5R + (size_t)(cb * 64 + g) * 64 + lane] = hr; F.out[O_SS5I + (size_t)(cb * 64 + g) * 64 + lane] = hi; }
               else if (cb == 127) { F.out[O_PS5R + g * 64 + lane] = hr; F.out[O_PS5I + g * 64 + lane] = hi; } }
    }
}
DI void s5_carry_phase(const Args& A, const Frame& F) {
    const int gt = F.bid * 512 + F.tid;
    if (gt < 4096) { const int g = gt >> 6, p = gt & 63; const float* P = (const float*)(F.ws + WS_S5P);
        const float ar = P[(S5_LAM128 >> 2) + 2 * gt], ai = P[(S5_LAM128 >> 2) + 2 * gt + 1]; float Hr = 0.f, Hi = 0.f;
#pragma unroll 8
        for (int c = 0; c < 128; ++c) { const size_t o = (size_t)(c * 64 + g) * 128 + p; F.S5H()[o] = Hr; F.S5H()[o + 64] = Hi;
            const float er = F.S5E()[o], ei = F.S5E()[o + 64]; const float nr = ar * Hr - ai * Hi + er, ni = ar * Hi + ai * Hr + ei; Hr = nr; Hi = ni; } }
}

#define XB_TMO      128
#define XB_XCNT(j)  (256  + 64 * (j))
#define XB_XSUB(j)  (1280 + 64 * (j))
#define XB_XGEN(j)  (2304 + 64 * (j))
#define XB_TOP      3328
#define XB_TOPGEN   3392
#define XCD_BAR_WORDS 3456
#define XB_SPIN_CAP (1u << 18)

__device__ __forceinline__ unsigned xb_ld(unsigned* p)              { return __hip_atomic_load(p, __ATOMIC_RELAXED, __HIP_MEMORY_SCOPE_AGENT); }
__device__ __forceinline__ unsigned xb_add(unsigned* p, unsigned v) { return __hip_atomic_fetch_add(p, v, __ATOMIC_RELAXED, __HIP_MEMORY_SCOPE_AGENT); }
__device__ __forceinline__ unsigned xb_xcc_id() { return (unsigned)__builtin_amdgcn_s_getreg((3 << 11) | 20) & 0xFu; }
#define XB_SPIN(cond, bar) do { unsigned _sp = 0; while (cond) { __builtin_amdgcn_s_sleep(1); \
    if ((++_sp & 255u) == 0u) { if (xb_ld(&(bar)[XB_TMO])) break; if (_sp > XB_SPIN_CAP) { atomicAdd(&(bar)[XB_TMO], 1u); break; } } } } while (0)

struct XcdBarrier {
    unsigned* bar; unsigned x;
    volatile LAS unsigned* st;
};

__device__ __forceinline__ XcdBarrier xcd_barrier_post(unsigned* bar, volatile LAS unsigned* st) {
    XcdBarrier b; b.bar = bar; b.x = xb_xcc_id(); b.st = st;
    if (threadIdx.x == 0) (void)xb_add(&bar[XB_XCNT(b.x)], 1u);
    return b;
}
__device__ __forceinline__ void xcd_barrier_complete(unsigned* bar, unsigned x, unsigned& nloc, unsigned& nx) {
    const unsigned G = gridDim.x * gridDim.y * gridDim.z;
    unsigned sum, cnt, mine, sp = 0u;
    for (;;) {
        sum = 0u; cnt = 0u; mine = 0u;
#pragma unroll
        for (unsigned j = 0; j < 16; ++j) { const unsigned c = xb_ld(&bar[XB_XCNT(j)]); sum += c; cnt += (c > 0u) ? 1u : 0u; mine = (j == x) ? c : mine; }
        if (sum == G) break;
        __builtin_amdgcn_s_sleep(1);
        if ((++sp & 255u) == 0u) { if (xb_ld(&bar[XB_TMO])) break; if (sp > XB_SPIN_CAP) { atomicAdd(&bar[XB_TMO], 1u); break; } }
    }
    nloc = mine > 0u ? mine : 1u; nx = cnt > 0u ? cnt : 1u;
}

__device__ __forceinline__ void xcd_barrier(const XcdBarrier& b) {
    asm volatile("s_waitcnt vmcnt(0)" ::: "memory");
    __syncthreads();
    if (threadIdx.x == 0) {
        unsigned* bar = b.bar;
        __builtin_amdgcn_s_waitcnt(0);
        unsigned nloc = b.st[0], nx = b.st[1];
        if (nloc == 0u) { xcd_barrier_complete(bar, b.x, nloc, nx); b.st[0] = nloc; b.st[1] = nx; }
        const unsigned old = xb_add(&bar[XB_XSUB(b.x)], 1u);
        const unsigned gen = old / nloc;
        if (old + 1u == (gen + 1u) * nloc) {
            __builtin_amdgcn_fence(__ATOMIC_RELEASE, "agent");
            asm volatile("s_waitcnt vmcnt(0)" ::: "memory");
            const unsigned og = xb_add(&bar[XB_TOP], 1u);
            const unsigned tg = og / nx;
            if (og + 1u == (tg + 1u) * nx) xb_add(&bar[XB_TOPGEN], 1u);
            else XB_SPIN(xb_ld(&bar[XB_TOPGEN]) == tg, bar);
            __builtin_amdgcn_fence(__ATOMIC_ACQUIRE, "");
            xb_add(&bar[XB_XGEN(b.x)], 1u);
            asm volatile("s_waitcnt vmcnt(0)" ::: "memory");
        } else {
            XB_SPIN(xb_ld(&bar[XB_XGEN(b.x)]) == gen, bar);
            __builtin_amdgcn_fence(__ATOMIC_ACQUIRE, "");
            asm volatile("s_waitcnt vmcnt(0)" ::: "memory");
        }
    }
    __syncthreads();
}

constexpr int NPHASE = 17;
__global__ void __launch_bounds__(NWAVES * 64, 2) mega_fwd(Args args) {
    extern __shared__ __attribute__((aligned(16))) unsigned char lds_raw[];
    cg::grid_group grid = cg::this_grid();
    Frame F;
    F.lds = (LAS unsigned char*)lds_raw; F.tid = threadIdx.x; F.lane = F.tid & 63; F.wave = __builtin_amdgcn_readfirstlane(F.tid >> 6); F.G = gridDim.x; F.bid = blockIdx.x;
    F.out = args.out; F.ws = args.ws;
    const int lo = args.ph_lo, hi = args.ph_hi;
    volatile LAS unsigned* misc_ = (volatile LAS unsigned*)(F.lds + LDS_BYTES - 64);
    if (F.tid < 16) misc_[F.tid] = 0u;
    __syncthreads();
    const XcdBarrier xbar_ = xcd_barrier_post((unsigned*)args.ws, misc_);
    if (lo < 0) grid.sync();
#define GSYNC() xcd_barrier(xbar_)
    float* XR = F.out + O_Y;
#ifndef PHMASK
#define PHMASK 0xfffffu
#endif
#define IN(k) (((PHMASK >> (k)) & 1u) && lo <= (k) && (k) < hi)
#define SEAM(k) do { if (IN(k) && IN((k) + 1)) GSYNC(); } while (0)
#ifndef RPTMASK
#define RPTMASK 0u
#endif
#ifndef XSYNC
#define XSYNC 0
#endif
#define RPT(k) (((RPTMASK >> (k)) & 1u) ? 2 : 1)
#define RB(k) for (int rep_ = 0; rep_ < RPT(k); ++rep_) { if (rep_) GSYNC();
#define RE }
#define GEMM_SPLIT(g, E, nM_, nN_, S__) do { pg8::SplitOrder S_; S_.init(nM_, nN_, S__, F.G, (int)blockIdx.x); pg8::gemm_phase<pg8::EpiPartial, pg8::SplitOrder, true, true>(F.lds, g, S_, E); } while (0)
#define GEMM_PHASE(EPI, g, E) do { pg8::StaticOrder S_; S_.init((g).M, (g).N, F.G, (int)blockIdx.x); pg8::gemm_phase<EPI, pg8::StaticOrder, true, true>(F.lds, g, S_, E); } while (0)

    if (IN(0)) { RB(0)  p0_prologue(args, F);  RE } SEAM(0);
    if (IN(1)) { RB(1)  pg8::Gemm g{F.CA(), F.Wada_t(), 256, NMOD, 1024}; pg8::EpiF32Bias E{F.MOD(), NMOD, args.in[I_ADAB]}; GEMM_PHASE(pg8::EpiF32Bias, g, E);  RE } SEAM(1);
    if (IN(2)) { RB(2)  norm_phase(args, F, args.in[I_XP], args.in[I_XS], args.in[I_NMIX], F.MOD(), 0, 1024);  RE } SEAM(2);
    if (IN(3)) { RB(3)  pg8::Gemm g{F.XN(), F.Win_t(), MT, NIN, 1024}; pg8::EpiBf16<0> E{F.PROJ(), NIN, nullptr, 0, 0, 1.f}; GEMM_PHASE(pg8::EpiBf16<0>, g, E);  RE } SEAM(3);
    if (IN(4)) { RB(4)
#ifndef P4SEL
#define P4SEL 7
#endif
        if (P4SEL & 1) for (int u = F.bid; u < 512; u += F.G) attn_unit<false>(args, F, u);
        if (P4SEL & 2) for (int u = (F.bid + 128) % F.G; u < 128; u += F.G) attn_unit<true>(args, F, u);
        if (P4SEL & 4) for (int u = F.bid; u < 512; u += F.G) ret_kv_unit(args, F, u);
        __syncthreads();
    RE } SEAM(4);
    if (IN(5)) { RB(5)  ret_scan_phase(args, F);  RE } SEAM(5);
    if (IN(6)) { RB(6)  if (F.bid < 64) pret_transpose_tile(args, F, F.bid);
        for (int u = F.bid; u < 768; u += F.G) { if (u < 256) ret_out_prompt(args, F, u); else ret_sample_unit(args, F, u - 256); } __syncthreads();  RE } SEAM(6);
    if (IN(7)) { RB(7)  { pg8::Gemm g{F.MIX(), F.Wout_t(), TP, 1024, 1024, 0}; pg8::EpiResid E{args.in[I_XP], args.in[I_XS], XR, F.MOD() + 2048}; GEMM_PHASE(pg8::EpiResid, g, E); }
        { pg8::Gemm g{F.MIX() + (size_t)TP * DM, F.Wout_t(), TS, 1024, 256, 1024}; pg8::EpiPartial E{(bf16*)(F.ws + WS_PART0), TS, 0}; GEMM_SPLIT(g, E, 4, 4, 4); }  RE } SEAM(7);
    if (IN(8)) { RB(8)  norm_phase(args, F, XR, args.in[I_XS], args.in[I_NFFN], F.MOD(), 3072, 4096, (const bf16*)(F.ws + WS_PART0), 4, F.MOD() + 2048, XR);  RE } SEAM(8);
    if (IN(9)) { RB(9)  pg8::Gemm g{F.XN(), F.Wgu_t(0), MT, 2 * DFF, 1024}; pg8::EpiSwiGLU E{F.PROJ(), DFF}; GEMM_PHASE(pg8::EpiSwiGLU, g, E);  RE } SEAM(9);
    if (IN(10)) { RB(10)  { pg8::Gemm g{F.PROJ(), F.Wd_t(0), TP, 1024, DFF, 0}; pg8::EpiResid E{XR, XR + (size_t)TP * DM, XR, F.MOD() + 5120}; GEMM_PHASE(pg8::EpiResid, g, E); }
        { pg8::Gemm g{F.PROJ() + (size_t)TP * DFF, F.Wd_t(0), TS, 1024, 256, DFF}; pg8::EpiPartial E{F.MIX(), TS, 0}; GEMM_SPLIT(g, E, 4, 4, 11); }  RE } SEAM(10);
    if (IN(11)) { RB(11)  norm_phase(args, F, XR, XR + (size_t)TP * DM, args.in[I_NMIX] + 1024, F.MOD() + LMOD, 0, 1024, F.MIX(), 11, F.MOD() + 5120, XR);  RE } SEAM(11);
    if (IN(12)) { RB(12)  s5_phase<1>(args, F);  RE } SEAM(12);
    if (IN(13)) { RB(13)  s5_carry_phase(args, F);  RE } SEAM(13);
    if (IN(14)) { RB(14)  s5_phase<2>(args, F);  RE } SEAM(14);
    if (IN(15)) { RB(15)  { pg8::Gemm g{F.MIX(), F.Wglu_t(), TP, 2048, 1024, 0}; pg8::EpiGLUResid E{XR, F.MOD() + LMOD + 2048}; GEMM_PHASE(pg8::EpiGLUResid, g, E); }
        { pg8::Gemm g{F.MIX() + (size_t)TP * DM, F.Wglu_t(), TS, 2048, 256, 1024}; pg8::EpiPartial E{(bf16*)(F.ws + WS_PART0), TS, 2048}; GEMM_SPLIT(g, E, 4, 8, 4); }  RE } SEAM(15);
    if (IN(16)) { RB(16)  norm_phase(args, F, XR, XR + (size_t)TP * DM, args.in[I_NFFN] + 1024, F.MOD() + LMOD, 3072, 4096, nullptr, 4, F.MOD() + LMOD + 2048, XR, (const bf16*)(F.ws + WS_PART0));  RE } SEAM(16);
    if (IN(17)) { RB(17)  pg8::Gemm g{F.XN(), F.Wgu_t(1), MT, 2 * DFF, 1024}; pg8::EpiSwiGLU E{F.PROJ(), DFF}; GEMM_PHASE(pg8::EpiSwiGLU, g, E);  RE } SEAM(17);
    if (IN(18)) { { pg8::Gemm g{F.PROJ(), F.Wd_t(1), TP, 1024, DFF, 0}; pg8::EpiResid E{XR, XR + (size_t)TP * DM, XR, F.MOD() + LMOD + 5120}; GEMM_PHASE(pg8::EpiResid, g, E); }
        { pg8::Gemm g{F.PROJ() + (size_t)TP * DFF, F.Wd_t(1), TS, 1024, 256, DFF}; pg8::EpiPartial E{F.MIX(), TS, 0}; GEMM_SPLIT(g, E, 4, 4, 11); } } SEAM(18);
    if (IN(19)) {
        const int gw = F.bid * NWAVES + F.wave, NGW = F.G * NWAVES; const bf16* part = F.MIX();
        for (int m = TP + gw; m < MT; m += NGW) { const float* grow = F.MOD() + LMOD + 5120 + (size_t)pg8::seq_of_row(m) * NMOD;
#pragma unroll
            for (int j = 0; j < 4; ++j) { const int col = 4 * (64 * j + F.lane); const size_t po = (size_t)(m - TP) * 1024 + col; f32x4 ps = (f32x4){0.f, 0.f, 0.f, 0.f};
                for (int sl = 0; sl < 11; ++sl) { const u32x2 w = *(const u32x2*)(part + (size_t)sl * TS * 1024 + po); ps += (f32x4){bflo(w.x), bfhi(w.x), bflo(w.y), bfhi(w.y)}; }
                *(f32x4*)(XR + (size_t)m * DM + col) = *(const f32x4*)(XR + (size_t)m * DM + col) + *(const f32x4*)(grow + col) * ps; } }
    }
#undef IN
#undef SEAM
}

extern "C" void kernel_launch(void* const* d_in, const int* in_sizes, int n_in, void* d_out, int out_size, void* d_ws, size_t ws_size, hipStream_t stream) {
    static int grid = 0;
    if (grid == 0) {
        if (n_in != 32 || (size_t)out_size != O_END || ws_size < WS_END) { fprintf(stderr, "kernel_launch: unexpected shapes n_in %d out %d ws %zu\n", n_in, out_size, ws_size); grid = -1; return; }
        int dev = 0, cus = 0, per_cu = 0;
        hipGetDevice(&dev); hipDeviceGetAttribute(&cus, hipDeviceAttributeMultiprocessorCount, dev);
        hipFuncSetAttribute((const void*)mega_fwd, hipFuncAttributeMaxDynamicSharedMemorySize, LDS_BYTES);
        hipOccupancyMaxActiveBlocksPerMultiprocessor(&per_cu, (const void*)mega_fwd, NWAVES * 64, LDS_BYTES);
        if (per_cu < 1) { fprintf(stderr, "kernel_launch: occupancy query says %d blocks/CU\n", per_cu); per_cu = 1; }
        (void)hipGetLastError();
        grid = cus;
    }
    if (grid < 0) return;
    if (hipMemsetAsync(d_ws, 0, 65536, stream) != hipSuccess) { fprintf(stderr, "kernel_launch: memset failed\n"); return; }
    Args a{};
    for (int i = 0; i < 32; ++i) a.in[i] = (const float*)d_in[i];
    a.out = (float*)d_out; a.ws = (unsigned char*)d_ws; a.ph_lo = 0; a.ph_hi = 20;
    void* kargs[] = {&a};
    hipError_t e = hipLaunchCooperativeKernel((const void*)mega_fwd, dim3(grid), dim3(NWAVES * 64), kargs, LDS_BYTES, stream);
    if (e != hipSuccess) fprintf(stderr, "cooperative launch failed: %s (grid %d)\n", hipGetErrorString(e), grid);
}
```

```cpp
#include <hip/hip_runtime.h>
#include <hip/hip_cooperative_groups.h>
#include <cstdio>
#include <cstdint>
namespace cg = cooperative_groups;
namespace pg8 {
#define PG8_LAS __attribute__((address_space(3)))
typedef unsigned short bf16_t;
typedef short bf16x8 __attribute__((ext_vector_type(8)));
typedef float f32x4 __attribute__((ext_vector_type(4)));
typedef unsigned u32x4 __attribute__((ext_vector_type(4)));
constexpr int BM = 256, BK = 64, HALF = 128, HTB = HALF * BK * 2  , STAGE_BYTES = 8 * HTB, NXCD = 8, WGM = 8;

__host__ __device__ __forceinline__ int lds_byte(int r, int c) { const int st = (r >> 4) * 2 + (c >> 5), rr = r & 15, cc = c & 31, ob = rr * 64 + cc * 2; return st * 1024 + (ob ^ (((ob >> 9) & 1) << 5)); }
__host__ __device__ __forceinline__ void stage_rc(int b, int& R, int& C) { const int st = b / 1024, sb = b % 1024, swz = sb ^ (((sb >> 9) & 1) << 5); R = (st >> 1) * 16 + swz / 64; C = (st & 1) * 32 + (swz % 64) / 2; }
__host__ __device__ __forceinline__ int perm32(int rho) { const int n = rho >> 4, i = rho & 15; return 8 * (i >> 2) + 4 * n + (i & 3); }

struct Unit { int pm, pn, ks; };
struct Gemm { const bf16_t* A; const bf16_t* Bt; int M, N, K, ld; };

struct StaticOrder {
    int nM, nN, nwg, G, c;
    __host__ __device__ void init(int M, int N, int G_, int c_) { nM = M / BM; nN = N / BM; nwg = nM * nN; G = G_; c = c_; }
    __host__ __device__ bool next(int i, Unit& u) const {
        const long L = (long)i * G + c; if (L >= nwg) return false;
        int wgid = (int)L; { const int q = nwg / NXCD, r = nwg % NXCD, xcd = wgid % NXCD, off = wgid / NXCD; wgid = (xcd < r ? xcd * (q + 1) : r * (q + 1) + (xcd - r) * q) + off; }
        const int nig = WGM * nN, gid = wgid / nig, fm = gid * WGM, gsz = (nM - fm) < WGM ? (nM - fm) : WGM;
        u.pm = fm + ((wgid % nig) % gsz); u.pn = (wgid % nig) / gsz; u.ks = 0; return true;
    }
    __device__ __forceinline__ void a_ready(const Unit&) const {}
    __device__ __forceinline__ void done(const Unit&) const {}
};

struct SplitOrder {
    int nM, nN, nwg, G, c;
    __host__ __device__ void init(int nM_, int nN_, int S, int G_, int c_) { nM = nM_; nN = nN_; nwg = nM_ * nN_ * S; G = G_; c = c_; }
    __host__ __device__ bool next(int i, Unit& u) const { const int L = i * G + c; if (L >= nwg) return false; const int t = nM * nN, r = L % t; u.ks = L / t; u.pm = r % nM; u.pn = r / nM; return true; }
    __device__ __forceinline__ void a_ready(const Unit&) const {}
    __device__ __forceinline__ void done(const Unit&) const {}
};
__device__ __forceinline__ unsigned cvt_pk_bf16(float lo, float hi) { unsigned r; asm volatile("v_cvt_pk_bf16_f32 %0, %1, %2" : "=v"(r) : "v"(lo), "v"(hi)); return r; }
typedef float f32x2 __attribute__((ext_vector_type(2)));
__device__ __forceinline__ f32x2 gelu_pk(f32x2 v) {
    const f32x2 av = __builtin_elementwise_abs(v), d = av * 0.2316418882f + 1.0f;
    f32x2 t; t.x = __builtin_amdgcn_rcpf(d.x); t.y = __builtin_amdgcn_rcpf(d.y);
    f32x2 q = t * 0.5307027145f + (-0.7265760135f); q = q * t + 0.7107068705f; q = q * t + (-0.142248368f); q = q * t + 0.127414796f; q = q * t;
    const f32x2 s = (v * v) * (-0.72134752044f);
    f32x2 e; e.x = __builtin_amdgcn_exp2f(s.x); e.y = __builtin_amdgcn_exp2f(s.y);
    const f32x2 m = v * (q * e), r = v - m;
    f32x2 o; o.x = v.x < 0.f ? m.x : r.x; o.y = v.y < 0.f ? m.y : r.y; return o;
}

template <int ACT  > struct EpiBf16 {
    static constexpr bool PERM = true, AFTER_DRAIN = false; static_assert(ACT == 0 || ACT == 1, "EpiBf16: ACT is 0 (none) or 1 (gelu_pk)");
    bf16_t* O; int ldc; const float* bias; int split_cols; size_t split_stride; float scale0;
    __device__ __forceinline__ void operator()(const f32x4 (&acc)[2][2][4][2], const Unit& u, int wr, int wc, int fr, int fq) const {
        const int row0 = u.pm * BM + wr * 64 + fr; int colt = u.pn * BM; bf16_t* base = O;
        float sc = 1.f; if (split_cols) { const int t = colt / split_cols; base += (size_t)t * split_stride; colt -= t * split_cols; if (t == 0) sc = scale0; }
        const int col0 = colt + wc * 32 + 8 * fq, bcol0 = u.pn * BM + wc * 32 + 8 * fq;
        f32x4 bv[2][2];
#pragma unroll
        for (int bj = 0; bj < 2; ++bj)
#pragma unroll
            for (int n = 0; n < 2; ++n) bv[bj][n] = bias ? *(const f32x4*)(bias + bcol0 + bj * HALF + 4 * n) : (f32x4){0.f, 0.f, 0.f, 0.f};
#pragma unroll
        for (int ai = 0; ai < 2; ++ai)
#pragma unroll
            for (int m = 0; m < 4; ++m) { bf16_t* rowp = base + (size_t)(row0 + ai * HALF + m * 16) * ldc + col0;
#pragma unroll
                for (int bj = 0; bj < 2; ++bj) { f32x4 v0 = acc[ai][bj][m][0] + bv[bj][0], v1 = acc[ai][bj][m][1] + bv[bj][1];
                    if (ACT == 1) { f32x2 a = gelu_pk((f32x2){v0[0], v0[1]}), b = gelu_pk((f32x2){v0[2], v0[3]}), c = gelu_pk((f32x2){v1[0], v1[1]}), d = gelu_pk((f32x2){v1[2], v1[3]});
                        v0 = (f32x4){a.x, a.y, b.x, b.y}; v1 = (f32x4){c.x, c.y, d.x, d.y}; }
                    v0 = v0 * sc; v1 = v1 * sc; u32x4 w; w.x = cvt_pk_bf16(v0[0], v0[1]); w.y = cvt_pk_bf16(v0[2], v0[3]); w.z = cvt_pk_bf16(v1[0], v1[1]); w.w = cvt_pk_bf16(v1[2], v1[3]);
                    *(u32x4*)(rowp + bj * HALF) = w; } }
    }
};
constexpr int TPROMPT = 16384, NMODC = 12288;
__device__ __forceinline__ int seq_of_row(int row) { return row < TPROMPT ? 0 : 1 + ((row - TPROMPT) >> 3); }
__device__ __forceinline__ float sigm(float x) { return __builtin_amdgcn_rcpf(1.0f + __expf(-x)); }
typedef unsigned u32x2 __attribute__((ext_vector_type(2)));

struct EpiF32Bias {
    static constexpr bool PERM = false, AFTER_DRAIN = false;
    float* O; int ldc; const float* bias;
    __device__ __forceinline__ void operator()(const f32x4 (&acc)[2][2][4][2], const Unit& u, int wr, int wc, int fr, int fq) const {
        const int row0 = u.pm * BM + wr * 64 + fr, col0 = u.pn * BM + wc * 32 + 4 * fq;
#pragma unroll
        for (int bj = 0; bj < 2; ++bj)
#pragma unroll
            for (int n = 0; n < 2; ++n) { const int col = col0 + bj * HALF + n * 16; const f32x4 bv = *(const f32x4*)(bias + col);
#pragma unroll
                for (int ai = 0; ai < 2; ++ai)
#pragma unroll
                    for (int m = 0; m < 4; ++m) *(f32x4*)(O + (size_t)(row0 + ai * HALF + m * 16) * ldc + col) = acc[ai][bj][m][n] + bv; }
    }
};
struct EpiPartial {
    static constexpr bool PERM = false, AFTER_DRAIN = false;
    bf16_t* P; int rows; int ldp;
    __device__ __forceinline__ void operator()(const f32x4 (&acc)[2][2][4][2], const Unit& u, int wr, int wc, int fr, int fq) const {
        const int row0 = u.pm * BM + wr * 64 + fr, col0 = u.pn * BM + wc * 32 + 4 * fq; const int lp = ldp ? ldp : 1024; bf16_t* base = P + (size_t)u.ks * rows * lp;
#pragma unroll
        for (int ai = 0; ai < 2; ++ai)
#pragma unroll
            for (int m = 0; m < 4; ++m) { bf16_t* orow = base + (size_t)(row0 + ai * HALF + m * 16) * lp;
#pragma unroll
                for (int bj = 0; bj < 2; ++bj)
#pragma unroll
                    for (int n = 0; n < 2; ++n) { const f32x4 v = acc[ai][bj][m][n]; u32x2 w; w.x = cvt_pk_bf16(v[0], v[1]); w.y = cvt_pk_bf16(v[2], v[3]); *(u32x2*)(orow + col0 + bj * HALF + n * 16) = w; } }
    }
};
struct EpiResid {
    static constexpr bool PERM = false, AFTER_DRAIN = false;
    const float* bp; const float* bs; float* out; const float* gate;
    __device__ __forceinline__ void operator()(const f32x4 (&acc)[2][2][4][2], const Unit& u, int wr, int wc, int fr, int fq) const {
        const int row0 = u.pm * BM + wr * 64 + fr, col0 = u.pn * BM + wc * 32 + 4 * fq;
#pragma unroll
        for (int ai = 0; ai < 2; ++ai)
#pragma unroll
            for (int m = 0; m < 4; ++m) { const int row = row0 + ai * HALF + m * 16;
                const float* brow = row < TPROMPT ? bp + (size_t)row * 1024 : bs + (size_t)(row - TPROMPT) * 1024;
                const float* grow = gate + (size_t)seq_of_row(row) * NMODC; float* orow = out + (size_t)row * 1024;
#pragma unroll
                for (int bj = 0; bj < 2; ++bj)
#pragma unroll
                    for (int n = 0; n < 2; ++n) { const int col = col0 + bj * HALF + n * 16;
                        const f32x4 b = *(const f32x4*)(brow + col), g = *(const f32x4*)(grow + col);
                        *(f32x4*)(orow + col) = b + g * acc[ai][bj][m][n]; } }
    }
};
struct EpiSwiGLU {
    static constexpr bool PERM = false, AFTER_DRAIN = false;
    bf16_t* H; int ldh;
    __device__ __forceinline__ void operator()(const f32x4 (&acc)[2][2][4][2], const Unit& u, int wr, int wc, int fr, int fq) const {
        const int row0 = u.pm * BM + wr * 64 + fr, col0 = u.pn * 128 + wc * 16 + 4 * fq;
#pragma unroll
        for (int ai = 0; ai < 2; ++ai)
#pragma unroll
            for (int m = 0; m < 4; ++m) { bf16_t* rowp = H + (size_t)(row0 + ai * HALF + m * 16) * ldh + col0;
#pragma unroll
                for (int bj = 0; bj < 2; ++bj) { const f32x4 g = acc[ai][bj][m][0], uu = acc[ai][bj][m][1]; f32x4 hv;
#pragma unroll
                    for (int i = 0; i < 4; ++i) hv[i] = g[i] * sigm(g[i]) * uu[i];
                    u32x2 w; w.x = cvt_pk_bf16(hv[0], hv[1]); w.y = cvt_pk_bf16(hv[2], hv[3]);
                    *(u32x2*)(rowp + bj * 64) = w; } }
    }
};
struct EpiGLUResid {
    static constexpr bool PERM = false, AFTER_DRAIN = false;
    float* out; const float* gate;
    __device__ __forceinline__ void operator()(const f32x4 (&acc)[2][2][4][2], const Unit& u, int wr, int wc, int fr, int fq) const {
        const int row0 = u.pm * BM + wr * 64 + fr, col0 = u.pn * 128 + wc * 16 + 4 * fq;
#pragma unroll
        for (int ai = 0; ai < 2; ++ai)
#pragma unroll
            for (int m = 0; m < 4; ++m) { const int row = row0 + ai * HALF + m * 16;
                const float* grow = gate + (size_t)seq_of_row(row) * NMODC; float* orow = out + (size_t)row * 1024;
#pragma unroll
                for (int bj = 0; bj < 2; ++bj) { const int col = col0 + bj * 64; const f32x4 a = acc[ai][bj][m][0], b = acc[ai][bj][m][1];
                    const f32x4 x = *(const f32x4*)(orow + col), g = *(const f32x4*)(grow + col); f32x4 v;
#pragma unroll
                    for (int i = 0; i < 4; ++i) v[i] = x[i] + g[i] * (a[i] * sigm(b[i]));
                    *(f32x4*)(orow + col) = v; } }
    }
};
template <class Epi, class Sched, bool ALIGN_EPI = false, bool SP2 = false>
__device__ __forceinline__ void gemm_phase(PG8_LAS unsigned char* lds, const Gemm g, const Sched& S, const Epi& E) {
    const int tid = threadIdx.x, wid = __builtin_amdgcn_readfirstlane(tid >> 6), lane = tid & 63, wr = wid >> 2, wc = wid & 3, fr = lane & 15, fq = lane >> 4;
    const int K = g.K, nt = K / BK, ld = g.ld ? g.ld : g.K;
    unsigned voffA[2], voffB[2];
#pragma unroll
    for (int i = 0; i < 2; ++i) { int R, C; stage_rc(tid * 16 + i * 8192, R, C); const int Rb = Epi::PERM ? ((R & ~31) + perm32(R & 31)) : R;
        voffA[i] = (unsigned)(R * ld + C) * 2u; voffB[i] = (unsigned)(Rb * ld + C) * 2u; }
    const size_t kstep = (size_t)(BK * 2);
    const size_t hstep = (size_t)HALF * ld * 2;
    const size_t tstep = 2 * hstep;
    const unsigned ldsw = (unsigned)wid * 1024u;
    const int aoff = lds_byte(wr * 64 + fr, fq * 8), boff = lds_byte(wc * 32 + fr, fq * 8);
#define PG8_SA(b, h) (((b) * 2 + (h)) * HTB)
#define PG8_SB(b, h) ((4 + (b) * 2 + (h)) * HTB)
#define PG8_STAGE(bufoff, gbase, voff) do { _Pragma("unroll") for (int _i = 0; _i < 2; ++_i) \
        __builtin_amdgcn_global_load_lds((const unsigned*)((const char*)(gbase) + (voff)[_i]), (PG8_LAS unsigned*)(lds + (bufoff) + ldsw + _i * 8192), 16, 0, 0); } while (0)
#define PG8_LDA(dst, b, h) do { _Pragma("unroll") for (int m = 0; m < 4; ++m) _Pragma("unroll") for (int k = 0; k < 2; ++k) dst[m][k] = *(const PG8_LAS bf16x8*)(lds + PG8_SA(b, h) + aoff + m * 2048 + k * 1024); } while (0)
#define PG8_LDB(dst, b, h) do { _Pragma("unroll") for (int n = 0; n < 2; ++n) _Pragma("unroll") for (int k = 0; k < 2; ++k) dst[n][k] = *(const PG8_LAS bf16x8*)(lds + PG8_SB(b, h) + boff + n * 2048 + k * 1024); } while (0)
#define PG8_MMA(ai, bj, At, Bt) do { __builtin_amdgcn_s_setprio(1); _Pragma("unroll") for (int m = 0; m < 4; ++m) _Pragma("unroll") for (int n = 0; n < 2; ++n) _Pragma("unroll") for (int k = 0; k < 2; ++k) \
        acc[ai][bj][m][n] = __builtin_amdgcn_mfma_f32_16x16x32_bf16(Bt[n][k], At[m][k], acc[ai][bj][m][n], 0, 0, 0); __builtin_amdgcn_s_setprio(0); } while (0)
#define PG8_WAIT_V(n) asm volatile("s_waitcnt vmcnt(" #n ")" ::: "memory")
#define PG8_WAIT_L(n) asm volatile("s_waitcnt lgkmcnt(" #n ")" ::: "memory")
#define PG8_BAR __builtin_amdgcn_s_barrier()
#define PG8_SCHED __builtin_amdgcn_sched_barrier(0)
    Unit cur, nxt; int ui = 0;
    if (!S.next(0, cur)) return;
    f32x4 acc[2][2][4][2];
#pragma unroll
    for (int a = 0; a < 2; ++a)
#pragma unroll
        for (int b = 0; b < 2; ++b)
#pragma unroll
            for (int m = 0; m < 4; ++m)
#pragma unroll
                for (int n = 0; n < 2; ++n) acc[a][b][m][n] = (f32x4){0.f, 0.f, 0.f, 0.f};
    bf16x8 At[4][2], B0[2][2], B1[2][2];
    const char* cA = (const char*)g.A + (size_t)cur.pm * tstep + (size_t)cur.ks * K * 2; const char* cB = (const char*)g.Bt + (size_t)cur.pn * tstep + (size_t)cur.ks * K * 2;
    S.a_ready(cur);
    if constexpr (SP2) {
        PG8_STAGE(PG8_SB(0, 0), cB, voffB); PG8_STAGE(PG8_SB(0, 1), cB + hstep, voffB); PG8_STAGE(PG8_SA(0, 0), cA, voffA); PG8_STAGE(PG8_SA(0, 1), cA + hstep, voffA);
        if (wr == 1) PG8_BAR;
        PG8_WAIT_V(2); PG8_BAR;
        PG8_STAGE(PG8_SB(1, 0), cB + kstep, voffB); PG8_STAGE(PG8_SA(1, 0), cA + kstep, voffA); PG8_STAGE(PG8_SB(1, 1), cB + hstep + kstep, voffB);
        PG8_WAIT_V(6); PG8_BAR;
    } else {
        PG8_STAGE(PG8_SB(0, 0), cB, voffB); PG8_STAGE(PG8_SA(0, 0), cA, voffA); PG8_STAGE(PG8_SB(0, 1), cB + hstep, voffB); PG8_STAGE(PG8_SA(0, 1), cA + hstep, voffA);
        if (wr == 1) PG8_BAR;
        PG8_WAIT_V(4); PG8_BAR;
        PG8_STAGE(PG8_SB(1, 0), cB + kstep, voffB); PG8_STAGE(PG8_SA(1, 0), cA + kstep, voffA); PG8_STAGE(PG8_SB(1, 1), cB + hstep + kstep, voffB);
        PG8_WAIT_V(6); PG8_BAR;
    }
    for (;;) {
        const bool has_next = S.next(ui + 1, nxt);
        const char* nA = has_next ? (const char*)g.A + (size_t)nxt.pm * tstep + (size_t)nxt.ks * K * 2 : cA; const char* nB = has_next ? (const char*)g.Bt + (size_t)nxt.pn * tstep + (size_t)nxt.ks * K * 2 : cB;
        for (int t = 0; t < nt; t += 2) {
            const bool last = (t == nt - 2);
            const char* a1 = cA + (size_t)(t + 1) * kstep;
            const char* a2 = last ? nA : cA + (size_t)(t + 2) * kstep; const char* b2 = last ? nB : cB + (size_t)(t + 2) * kstep;
            const char* a3 = a2 + kstep; const char* b3 = b2 + kstep;
            if (last && has_next) S.a_ready(nxt);
            if constexpr (SP2) {
            PG8_LDB(B0, 0, 0); PG8_LDB(B1, 0, 1); PG8_SCHED; PG8_LDA(At, 0, 0); PG8_STAGE(PG8_SA(1, 1), a1 + hstep, voffA);
            PG8_WAIT_V(8); PG8_WAIT_L(0); PG8_BAR; PG8_MMA(0, 0, At, B0); PG8_MMA(0, 1, At, B1); PG8_BAR; PG8_SCHED;
            PG8_LDA(At, 0, 1); PG8_STAGE(PG8_SB(0, 0), b2, voffB); PG8_STAGE(PG8_SB(0, 1), b2 + hstep, voffB); PG8_STAGE(PG8_SA(0, 0), a2, voffA);
            PG8_WAIT_V(8); PG8_WAIT_L(0); PG8_BAR; PG8_MMA(1, 0, At, B0); PG8_MMA(1, 1, At, B1); PG8_BAR; PG8_SCHED;
            PG8_LDB(B0, 1, 0); PG8_LDB(B1, 1, 1); PG8_SCHED; PG8_LDA(At, 1, 0); PG8_STAGE(PG8_SA(0, 1), a2 + hstep, voffA);
            PG8_WAIT_V(8); PG8_WAIT_L(0); PG8_BAR; PG8_MMA(0, 0, At, B0); PG8_MMA(0, 1, At, B1); PG8_BAR; PG8_SCHED;
            PG8_LDA(At, 1, 1); PG8_STAGE(PG8_SB(1, 0), b3, voffB); PG8_STAGE(PG8_SB(1, 1), b3 + hstep, voffB); PG8_STAGE(PG8_SA(1, 0), a3, voffA);
            PG8_WAIT_V(8); PG8_WAIT_L(0); PG8_BAR; PG8_MMA(1, 0, At, B0); PG8_MMA(1, 1, At, B1); PG8_BAR; PG8_SCHED;
            } else {
            PG8_LDB(B0, 0, 0); PG8_SCHED; PG8_LDA(At, 0, 0); PG8_STAGE(PG8_SA(1, 1), a1 + hstep, voffA);
            PG8_WAIT_L(8); PG8_BAR; PG8_WAIT_L(0); PG8_MMA(0, 0, At, B0); PG8_BAR; PG8_SCHED;
            PG8_LDB(B1, 0, 1); PG8_STAGE(PG8_SB(0, 0), b2, voffB);
            PG8_BAR; PG8_WAIT_L(0); PG8_MMA(0, 1, At, B1); PG8_BAR;
            PG8_LDA(At, 0, 1); PG8_STAGE(PG8_SA(0, 0), a2, voffA);
            PG8_BAR; PG8_WAIT_L(0); PG8_MMA(1, 0, At, B0); PG8_BAR; PG8_SCHED;
            PG8_STAGE(PG8_SB(0, 1), b2 + hstep, voffB);
            PG8_WAIT_V(6); PG8_BAR; PG8_MMA(1, 1, At, B1); PG8_BAR;
            PG8_LDB(B0, 1, 0); PG8_SCHED; PG8_LDA(At, 1, 0); PG8_STAGE(PG8_SA(0, 1), a2 + hstep, voffA);
            PG8_WAIT_L(8); PG8_BAR; PG8_WAIT_L(0); PG8_MMA(0, 0, At, B0); PG8_BAR; PG8_SCHED;
            PG8_LDB(B1, 1, 1); PG8_STAGE(PG8_SB(1, 0), b3, voffB);
            PG8_BAR; PG8_WAIT_L(0); PG8_MMA(0, 1, At, B1); PG8_BAR;
            PG8_LDA(At, 1, 1); PG8_STAGE(PG8_SA(1, 0), a3, voffA);
            PG8_BAR; PG8_WAIT_L(0); PG8_MMA(1, 0, At, B0); PG8_BAR; PG8_SCHED;
            PG8_STAGE(PG8_SB(1, 1), b3 + hstep, voffB);
            PG8_WAIT_V(6); PG8_BAR; PG8_MMA(1, 1, At, B1); PG8_BAR;
            }
        }
        if constexpr (ALIGN_EPI) { if (wr == 0) PG8_BAR; }
        if constexpr (!Epi::AFTER_DRAIN) { E(acc, cur, wr, wc, fr, fq); S.done(cur); }
        if (!has_next) break;
#pragma unroll
        for (int a = 0; a < 2; ++a)
#pragma unroll
            for (int b = 0; b < 2; ++b)
#pragma unroll
                for (int m = 0; m < 4; ++m)
#pragma unroll
                    for (int n = 0; n < 2; ++n) acc[a][b][m][n] = (f32x4){0.f, 0.f, 0.f, 0.f};
        cur = nxt; cA = nA; cB = nB; ++ui;
        if constexpr (ALIGN_EPI) { if (wr == 1) PG8_BAR; }
    }
    PG8_WAIT_V(0);
    if constexpr (!ALIGN_EPI) { if (wr == 0) PG8_BAR; }
    PG8_BAR;
    if constexpr (Epi::AFTER_DRAIN) { E.fused(acc, cur, wr, wc, fr, fq, lds, wid, lane); S.done(cur); }
#undef PG8_SA
#undef PG8_SB
#undef PG8_STAGE
#undef PG8_LDA
#undef PG8_LDB
#undef PG8_MMA
#undef PG8_WAIT_V
#undef PG8_WAIT_L
#undef PG8_BAR
#undef PG8_SCHED
}
}

constexpr int TP = 16384, TS = 1024, MT = TP + TS, DM = 1024, NBATCH = 128;
constexpr int NIN = 2816, DFF = 2816, NMOD = 12288, LMOD = 6144;
constexpr float EPSN = 1e-6f, LOG2E = 1.4426950408889634f;
constexpr int NWAVES = 8;
constexpr size_t O_Y = 0, O_PK = (size_t)MT * DM, O_PV = O_PK + 16384, O_PRET = O_PV + 16384, O_PS5R = O_PRET + 65536, O_PS5I = O_PS5R + 4096,
                 O_SK = O_PS5I + 4096, O_SV = O_SK + 2097152, O_SRET = O_SV + 2097152, O_SS5R = O_SRET + 8388608, O_SS5I = O_SS5R + 524288, O_END = O_SS5I + 524288;
constexpr size_t MiB = 1u << 20;
constexpr size_t WS_CA = 1 * MiB, WS_MOD = 2 * MiB, WS_S5P = 14 * MiB, WS_WIN = 16 * MiB, WS_WOUT = 22 * MiB, WS_WGU0 = 24 * MiB, WS_WGU1 = 35 * MiB,
                 WS_WD0 = 46 * MiB, WS_WD1 = 52 * MiB, WS_WGLU = 58 * MiB, WS_XN = 62 * MiB, WS_RKV = 62 * MiB, WS_MIX = 96 * MiB, WS_PROJ = 130 * MiB,
                 WS_WADA = 130 * MiB, WS_S5E = 130 * MiB, WS_S5H = 134 * MiB, WS_SIN = 224 * MiB, WS_PART0 = 240 * MiB, WS_PART1 = 248 * MiB, WS_END = 256 * MiB;
constexpr size_t S5_LAM = 0, S5_LAM128 = 32768, S5_BBT = 65536, S5_CCT = 65536 + 262144;
constexpr int LDS_BYTES = 147456;

#define LAS __attribute__((address_space(3)))
typedef unsigned short bf16;
typedef unsigned u32x4 __attribute__((ext_vector_type(4)));
typedef unsigned u32x2 __attribute__((ext_vector_type(2)));
typedef float f32x4 __attribute__((ext_vector_type(4)));
typedef float f32x2 __attribute__((ext_vector_type(2)));
typedef float f32x16 __attribute__((ext_vector_type(16)));
typedef short bf16x8 __attribute__((ext_vector_type(8)));
typedef short s16x4 __attribute__((ext_vector_type(4)));
typedef short v4i16_t __attribute__((ext_vector_type(4)));
typedef __bf16 bf16x2_t __attribute__((ext_vector_type(2)));
#define DI __device__ __forceinline__
#define MFMA32(a, b, c) __builtin_amdgcn_mfma_f32_32x32x16_bf16((a), (b), (c), 0, 0, 0)
DI unsigned pk2(float lo, float hi) { f32x2 v = {lo, hi}; bf16x2_t b = __builtin_convertvector(v, bf16x2_t); return __builtin_bit_cast(unsigned, b); }
DI unsigned short f2bf(float f) { return (unsigned short)(pk2(f, 0.f) & 0xffffu); }
DI float bflo(unsigned w) { return __uint_as_float(w << 16); }
DI float bfhi(unsigned w) { return __uint_as_float(w & 0xffff0000u); }
DI float bf2f(unsigned short b) { return __uint_as_float((unsigned)b << 16); }
DI int crow(int r, int h) { return (r & 3) + 8 * (r >> 2) + 4 * h; }
DI float wave_sum(float v) {
#pragma unroll
    for (int o = 1; o < 64; o <<= 1) v += __shfl_xor(v, o);
    return v;
}
DI s16x4 tr_read(const LAS unsigned char* p) { return __builtin_bit_cast(s16x4, __builtin_amdgcn_ds_read_tr16_b64_v4i16((LAS v4i16_t*)p)); }
DI bf16x8 tr_frag(const LAS unsigned char* lo, int hi_off) { const s16x4 a = tr_read(lo), b = tr_read(lo + hi_off); return __builtin_shufflevector(a, b, 0, 1, 2, 3, 4, 5, 6, 7); }
DI bf16x8 pack8(float a0, float a1, float a2, float a3, float a4, float a5, float a6, float a7) {
    u32x4 p; p.x = pk2(a0, a1); p.y = pk2(a2, a3); p.z = pk2(a4, a5); p.w = pk2(a6, a7); return __builtin_bit_cast(bf16x8, p);
}
#define PACK_STEP(x, s) pack8((x)[8 * (s)], (x)[8 * (s) + 1], (x)[8 * (s) + 2], (x)[8 * (s) + 3], (x)[8 * (s) + 4], (x)[8 * (s) + 5], (x)[8 * (s) + 6], (x)[8 * (s) + 7])
DI f32x16 zero16() { f32x16 z;
#pragma unroll
    for (int i = 0; i < 16; ++i) z[i] = 0.f; return z; }
DI void unpack8(const u32x4 w, float* f) { f[0] = bflo(w.x); f[1] = bfhi(w.x); f[2] = bflo(w.y); f[3] = bfhi(w.y); f[4] = bflo(w.z); f[5] = bfhi(w.z); f[6] = bflo(w.w); f[7] = bfhi(w.w); }

struct Args { const float* in[32]; float* out; unsigned char* ws; int ph_lo, ph_hi; };
struct Frame {
    LAS unsigned char* lds; int tid, lane, wave, G, bid;
    float* out; unsigned char* ws;
    DI bf16* CA() const { return (bf16*)(ws + WS_CA); }
    DI bf16* Win_t() const { return (bf16*)(ws + WS_WIN); }
    DI bf16* Wout_t() const { return (bf16*)(ws + WS_WOUT); }
    DI bf16* Wgu_t(int l) const { return (bf16*)(ws + (l ? WS_WGU1 : WS_WGU0)); }
    DI bf16* Wd_t(int l) const { return (bf16*)(ws + (l ? WS_WD1 : WS_WD0)); }
    DI bf16* Wglu_t() const { return (bf16*)(ws + WS_WGLU); }
    DI bf16* Wada_t() const { return (bf16*)(ws + WS_WADA); }
    DI bf16* XN() const { return (bf16*)(ws + WS_XN); }
    DI bf16* MIX() const { return (bf16*)(ws + WS_MIX); }
    DI bf16* PROJ() const { return (bf16*)(ws + WS_PROJ); }
    DI bf16* SIN() const { return (bf16*)(ws + WS_SIN); }
    DI float* MOD() const { return (float*)(ws + WS_MOD); }
    DI float* RKV() const { return (float*)(ws + WS_RKV); }
    DI float* S5E() const { return (float*)(ws + WS_S5E); }
    DI float* S5H() const { return (float*)(ws + WS_S5H); }
};
enum { I_XP = 0, I_XS, I_CK, I_CV, I_SRET, I_S5R, I_S5I, I_CP, I_CS, I_ADAW, I_ADAB, I_NMIX, I_NFFN, I_WG, I_WU, I_WD, I_WIN, I_QG, I_KG, I_SINK, I_RG, I_WOUT,
       I_ARE, I_AIM, I_LDT, I_BRE, I_BIM, I_CRE, I_CIM, I_DSK, I_GLA, I_GLB };

DI void transpose_item(const float* W, int K, int N, bf16* WT, int rs, int ro, LAS float* scr, int item, int lane) {
    const int nblk = N / 32, kb = item / nblk, nb = item % nblk, k0 = 64 * kb, n0 = 32 * nb;
#pragma unroll 8
    for (int i = 0; i < 32; ++i) { const int kk = 2 * i + (lane >> 5); scr[kk * 33 + (lane & 31)] = W[(size_t)(k0 + kk) * N + n0 + (lane & 31)]; }
    asm volatile("s_waitcnt lgkmcnt(0)" ::: "memory");
    const int c = lane & 7;
#pragma unroll
    for (int j = 0; j < 4; ++j) { const int n = (lane >> 3) + 8 * j; const LAS float* s = scr + (8 * c) * 33 + n;
        u32x4 o; o.x = pk2(s[0 * 33], s[1 * 33]); o.y = pk2(s[2 * 33], s[3 * 33]); o.z = pk2(s[4 * 33], s[5 * 33]); o.w = pk2(s[6 * 33], s[7 * 33]);
        const int nn = n0 + n, drow = (nn >> 4) * rs + (nn & 15) + ro;
        *(u32x4*)(WT + (size_t)drow * K + k0 + 8 * c) = o; }
    asm volatile("s_waitcnt lgkmcnt(0)" ::: "memory");
}
DI void p0_prologue(const Args& A, const Frame& F) {
    LAS float* scr = (LAS float*)(F.lds + F.wave * 16384);
    const int gw = F.bid * NWAVES + F.wave, NGW = F.G * NWAVES;
    constexpr int I_A = 16 * 88, I_B = 16 * 32, I_C = 44 * 32, I_E = 16 * 192;
    constexpr int NITEMS = I_A + I_B + 4 * I_A + 2 * I_C + 2 * I_B + 2 * I_E;
    for (int it = gw; it < NITEMS; it += NGW) {
        int r = it;
        if (r < I_A) { transpose_item(A.in[I_WIN], 1024, NIN, F.Win_t(), 16, 0, scr, r, F.lane); continue; } r -= I_A;
        if (r < I_B) { transpose_item(A.in[I_WOUT], 1024, 1024, F.Wout_t(), 16, 0, scr, r, F.lane); continue; } r -= I_B;
        if (r < 4 * I_A) { const int which = r / I_A, rr = r % I_A, l = which >> 1, up = which & 1;
            transpose_item(A.in[up ? I_WU : I_WG] + (size_t)l * 1024 * DFF, 1024, DFF, F.Wgu_t(l), 32, up * 16, scr, rr, F.lane); continue; } r -= 4 * I_A;
        if (r < 2 * I_C) { const int l = r / I_C, rr = r % I_C; transpose_item(A.in[I_WD] + (size_t)l * DFF * 1024, DFF, 1024, F.Wd_t(l), 16, 0, scr, rr, F.lane); continue; } r -= 2 * I_C;
        if (r < 2 * I_B) { const int b = r / I_B, rr = r % I_B; transpose_item(A.in[b ? I_GLB : I_GLA], 1024, 1024, F.Wglu_t(), 32, b * 16, scr, rr, F.lane); continue; } r -= 2 * I_B;
        { const int l = r / I_E, rr = r % I_E; transpose_item(A.in[I_ADAW] + (size_t)l * 1024 * LMOD, 1024, LMOD, F.Wada_t(), 16, l * LMOD, scr, rr, F.lane); }
    }
    const int gt = F.bid * 512 + F.tid, NGT = F.G * 512;
    for (int idx = gt; idx < 256 * 1024; idx += NGT) { const int row = idx >> 10, col = idx & 1023;
        float v = 0.f; if (row == 0) v = A.in[I_CP][col]; else if (row <= NBATCH) v = A.in[I_CS][(row - 1) * 1024 + col];
        F.CA()[idx] = f2bf(v * pg8::sigm(v)); }
    if (gt < 65536) {
        const int gp = gt >> 4, i = gt & 15, g = gp >> 6, p = gp & 63;
        const float are = A.in[I_ARE][gp], aim = A.in[I_AIM][gp], dt = expf(A.in[I_LDT][g]);
        const float a = are * dt, b = aim * dt; const float mag = expf(a), cb = cosf(b), sb = sinf(b), sh = sinf(0.5f * b);
        const float lr = mag * cb, li = mag * sb;
        const float nr = expm1f(a) * cb - 2.f * sh * sh, ni = li;
        const float den = are * are + aim * aim; const float fr = (nr * are + ni * aim) / den, fi = (ni * are - nr * aim) / den;
        bf16* BBt = (bf16*)(F.ws + WS_S5P + S5_BBT); bf16* CCt = (bf16*)(F.ws + WS_S5P + S5_CCT);
        const float br = A.in[I_BRE][gt], bi = A.in[I_BIM][gt];
        BBt[(g * 128 + p) * 16 + i] = f2bf(fr * br - fi * bi); BBt[(g * 128 + 64 + p) * 16 + i] = f2bf(fr * bi + fi * br);
        { const int go = gt >> 6, pp = gt & 63;
          CCt[go * 128 + pp] = f2bf(A.in[I_CRE][go * 64 + pp]); CCt[go * 128 + 64 + pp] = f2bf(-A.in[I_CIM][go * 64 + pp]); }
        if (i == 0) {
            float* P = (float*)(F.ws + WS_S5P);
            P[(S5_LAM >> 2) + 2 * gp] = lr; P[(S5_LAM >> 2) + 2 * gp + 1] = li;
            float pr = lr, pi = li;
#pragma unroll
            for (int k = 0; k < 7; ++k) { const float t = pr * pr - pi * pi; pi = 2.f * pr * pi; pr = t; }
            P[(S5_LAM128 >> 2) + 2 * gp] = pr; P[(S5_LAM128 >> 2) + 2 * gp + 1] = pi;
        }
    }
}

DI void norm_phase(const Args& A, const Frame& F, const float* xp, const float* xs, const float* gamma, const float* mod, int sh_off, int sc_off, const bf16* part = nullptr, int ns = 0, const float* pgate = nullptr, float* xw = nullptr, const bf16* gpart = nullptr) {
    const int gw = F.bid * NWAVES + F.wave, NGW = F.G * NWAVES;
    for (int m = gw; m < MT; m += NGW) {
        const float* xrow = m < TP ? xp + (size_t)m * DM : xs + (size_t)(m - TP) * DM;
        const float* mrow = mod + (size_t)pg8::seq_of_row(m) * NMOD;
        f32x4 v[4]; float ss = 0.f;
#pragma unroll
        for (int j = 0; j < 4; ++j) { v[j] = *(const f32x4*)(xrow + 4 * (64 * j + F.lane));
            if (part && m >= TP) { const int col = 4 * (64 * j + F.lane); const size_t po = (size_t)(m - TP) * 1024 + col;
                const f32x4 g = *(const f32x4*)(pgate + (size_t)pg8::seq_of_row(m) * NMOD + col); f32x4 ps = (f32x4){0.f, 0.f, 0.f, 0.f};
                for (int sl = 0; sl < ns; ++sl) { const u32x2 w = *(const u32x2*)(part + (size_t)sl * TS * 1024 + po); ps += (f32x4){bflo(w.x), bfhi(w.x), bflo(w.y), bfhi(w.y)}; }
                v[j] = v[j] + g * ps; *(f32x4*)(xw + (size_t)m * DM + col) = v[j]; }
            if (gpart && m >= TP) { const int col = 4 * (64 * j + F.lane); const size_t po = (size_t)(m - TP) * 2048 + (col >> 4) * 32 + (col & 15);
                const f32x4 g = *(const f32x4*)(pgate + (size_t)pg8::seq_of_row(m) * NMOD + col); f32x4 pa = (f32x4){0.f, 0.f, 0.f, 0.f}, pb = pa;
                for (int sl = 0; sl < ns; ++sl) { const u32x2 wa = *(const u32x2*)(gpart + (size_t)sl * TS * 2048 + po), wb = *(const u32x2*)(gpart + (size_t)sl * TS * 2048 + po + 16);
                    pa += (f32x4){bflo(wa.x), bfhi(wa.x), bflo(wa.y), bfhi(wa.y)}; pb += (f32x4){bflo(wb.x), bfhi(wb.x), bflo(wb.y), bfhi(wb.y)}; }
                f32x4 gl; gl.x = pa.x * pg8::sigm(pb.x); gl.y = pa.y * pg8::sigm(pb.y); gl.z = pa.z * pg8::sigm(pb.z); gl.w = pa.w * pg8::sigm(pb.w);
                v[j] = v[j] + g * gl; *(f32x4*)(xw + (size_t)m * DM + col) = v[j]; }
            ss += (v[j].x * v[j].x + v[j].y * v[j].y) + (v[j].z * v[j].z + v[j].w * v[j].w); }
        const float rstd = rsqrtf(wave_sum(ss) * (1.f / DM) + EPSN);
#pragma unroll
        for (int j = 0; j < 4; ++j) { const int col = 4 * (64 * j + F.lane);
            const f32x4 g = *(const f32x4*)(gamma + col), sc = *(const f32x4*)(mrow + sc_off + col), sh = *(const f32x4*)(mrow + sh_off + col);
            const f32x4 y = v[j] * rstd * g * (1.f + sc) + sh;
            u32x2 w; w.x = pk2(y.x, y.y); w.y = pk2(y.z, y.w); *(u32x2*)(F.XN() + (size_t)m * DM + col) = w; }
    }
}

template <bool SAMPLE> DI void attn_unit(const Args& A, const Frame& F, int uidx) {
    LAS unsigned char* Kl = F.lds; LAS unsigned char* Vl = F.lds + 46080;
    int tid = F.tid; asm volatile("" : "+v"(tid)); const int lane = tid & 63, w = F.wave;
    const int q0 = SAMPLE ? 0 : 32 * uidx, b = uidx;
    const float* kgain = A.in[I_KG];
    __syncthreads();
#pragma unroll 1
    for (int it = 0; it < 5; ++it) {
        const int t = tid + 512 * it, ch = t & 7, rr = t >> 3, kv = rr >= 160 ? 1 : 0, kk = rr - 160 * kv;
        float kf[8], vf[8]; bool valid = true, donorm = true; int tok = 0;
        if (SAMPLE) {
            if (kk < 128) { donorm = false; const size_t o = ((size_t)(b * 128 + kk) * 2 + kv) * 64 + 8 * ch;
                const f32x4 k0 = *(const f32x4*)(A.in[I_CK] + o), k1 = *(const f32x4*)(A.in[I_CK] + o + 4), v0 = *(const f32x4*)(A.in[I_CV] + o), v1 = *(const f32x4*)(A.in[I_CV] + o + 4);
                kf[0] = k0.x; kf[1] = k0.y; kf[2] = k0.z; kf[3] = k0.w; kf[4] = k1.x; kf[5] = k1.y; kf[6] = k1.z; kf[7] = k1.w;
                vf[0] = v0.x; vf[1] = v0.y; vf[2] = v0.z; vf[3] = v0.w; vf[4] = v1.x; vf[5] = v1.y; vf[6] = v1.z; vf[7] = v1.w; }
            else { valid = kk < 136; tok = TP + b * 8 + ((kk - 128) & 7); }
        } else { tok = q0 - 128 + kk; valid = tok >= 0; if (!valid) tok = 0; }
        if (!SAMPLE || kk >= 128) {
            const bf16* src = F.PROJ() + (size_t)tok * NIN + 512 + kv * 64 + 8 * ch;
            const u32x4 kw = *(const u32x4*)src, vw = *(const u32x4*)(src + 128);
            unpack8(kw, kf); unpack8(vw, vf);
        }
        float ss = 0.f;
#pragma unroll
        for (int j = 0; j < 8; ++j) ss += kf[j] * kf[j];
        ss += __shfl_xor(ss, 1); ss += __shfl_xor(ss, 2); ss += __shfl_xor(ss, 4);
        const float rstd = rsqrtf(ss * (1.f / 64.f) + EPSN);
#pragma unroll
        for (int j = 0; j < 8; ++j) { if (donorm) kf[j] = kf[j] * rstd * kgain[8 * ch + j]; if (!valid) { kf[j] = 0.f; vf[j] = 0.f; } }
        const int lo = ((kv * 160 + kk) * 72 + 8 * ch) * 2;
        *(LAS u32x4*)(Kl + lo) = (u32x4){pk2(kf[0], kf[1]), pk2(kf[2], kf[3]), pk2(kf[4], kf[5]), pk2(kf[6], kf[7])};
        *(LAS u32x4*)(Vl + lo) = (u32x4){pk2(vf[0], vf[1]), pk2(vf[2], vf[3]), pk2(vf[4], vf[5]), pk2(vf[6], vf[7])};
        float* ok = nullptr; float* ov = nullptr;
        if (SAMPLE) { if (kk >= 8 && kk < 136) { const size_t o = ((size_t)(b * 128 + kk - 8) * 2 + kv) * 64 + 8 * ch; ok = F.out + O_SK + o; ov = F.out + O_SV + o; } }
        else { if (q0 == TP - 32 && kk >= 32) { const size_t o = ((size_t)(kk - 32) * 2 + kv) * 64 + 8 * ch; ok = F.out + O_PK + o; ov = F.out + O_PV + o; } }
        if (ok) { *(f32x4*)ok = (f32x4){kf[0], kf[1], kf[2], kf[3]}; *(f32x4*)(ok + 4) = (f32x4){kf[4], kf[5], kf[6], kf[7]};
                  *(f32x4*)ov = (f32x4){vf[0], vf[1], vf[2], vf[3]}; *(f32x4*)(ov + 4) = (f32x4){vf[4], vf[5], vf[6], vf[7]}; }
    }
    const int n = lane & 31, h = lane >> 5, hh = w, kvh = hh >> 2;
    const int qtok = SAMPLE ? TP + b * 8 + (n & 7) : q0 + n;
    bf16x8 qf[4];
    {
        const bf16* qp = F.PROJ() + (size_t)qtok * NIN + hh * 64 + 8 * h; float qv[4][8]; float ss = 0.f;
#pragma unroll
        for (int s = 0; s < 4; ++s) { const u32x4 raw = *(const u32x4*)(qp + 16 * s); unpack8(raw, qv[s]);
#pragma unroll
            for (int j = 0; j < 8; ++j) ss += qv[s][j] * qv[s][j]; }
        ss += __shfl_xor(ss, 32);
        const float rstd = rsqrtf(ss * (1.f / 64.f) + EPSN) * (0.125f * LOG2E);
        const float* qg = A.in[I_QG];
#pragma unroll
        for (int s = 0; s < 4; ++s) { float t[8];
#pragma unroll
            for (int j = 0; j < 8; ++j) t[j] = qv[s][j] * rstd * qg[16 * s + 8 * h + j];
            qf[s] = pack8(t[0], t[1], t[2], t[3], t[4], t[5], t[6], t[7]); }
    }
    __syncthreads();
    f32x16 S[5];
#pragma unroll
    for (int kt = 0; kt < 5; ++kt) { S[kt] = zero16();
#pragma unroll
        for (int s = 0; s < 4; ++s) { const bf16x8 a = *(const LAS bf16x8*)(Kl + ((kvh * 160 + 32 * kt + n) * 72 + 16 * s + 8 * h) * 2); S[kt] = MFMA32(a, qf[s], S[kt]); } __builtin_amdgcn_sched_barrier(0); }
    const float slope2 = exp2f(-(float)(hh + 1)) * LOG2E, sink2 = A.in[I_SINK][hh] * LOG2E;
    float mx = -1e30f;
#pragma unroll
    for (int kt = 0; kt < 5; ++kt)
#pragma unroll
        for (int r = 0; r < 16; ++r) { const int kidx = 32 * kt + crow(r, h), dist = 128 + n - kidx;
            const bool okk = dist >= 0 && dist < 128 && (SAMPLE || q0 - 128 + kidx >= 0);
            const float v = okk ? S[kt][r] - slope2 * (float)dist : -1e30f; S[kt][r] = v; mx = fmaxf(mx, v); }
    mx = fmaxf(mx, __shfl_xor(mx, 32)); mx = fmaxf(mx, sink2);
    float sum = 0.f;
    bf16x8 pfs[5][2];
#pragma unroll
    for (int kt = 0; kt < 5; ++kt)
#pragma unroll
        for (int s2 = 0; s2 < 2; ++s2) { float p[8];
#pragma unroll
            for (int j = 0; j < 8; ++j) { p[j] = exp2f(S[kt][8 * s2 + j] - mx); sum += p[j]; }
            pfs[kt][s2] = pack8(p[0], p[1], p[2], p[3], p[4], p[5], p[6], p[7]); }
    sum += __shfl_xor(sum, 32);
    const float inv = 1.f / (sum + exp2f(sink2 - mx));
    __builtin_amdgcn_sched_barrier(0);
    f32x16 O[2]; O[0] = zero16(); O[1] = zero16();
    const int i16 = lane & 15, tq = i16 >> 2, tp = i16 & 3, blk = (lane >> 4) & 1;
    const LAS unsigned char* vbase = Vl + ((kvh * 160 + 4 * h + tq) * 72 + 16 * blk + 4 * tp) * 2;
#pragma unroll
    for (int kt = 0; kt < 5; ++kt) {
#pragma unroll
        for (int s2 = 0; s2 < 2; ++s2) {
#pragma unroll
            for (int dt = 0; dt < 2; ++dt) { const bf16x8 vfr = tr_frag(vbase + ((32 * kt + 16 * s2) * 72 + 32 * dt) * 2, 8 * 72 * 2);
                O[dt] = MFMA32(vfr, pfs[kt][s2], O[dt]); } }
        __builtin_amdgcn_sched_barrier(0); }
    if (!SAMPLE || n < 8) {
        bf16* op = F.MIX() + (size_t)qtok * DM + hh * 64;
#pragma unroll
        for (int dt = 0; dt < 2; ++dt)
#pragma unroll
            for (int g4 = 0; g4 < 4; ++g4) { u32x2 wv; wv.x = pk2(O[dt][4 * g4] * inv, O[dt][4 * g4 + 1] * inv); wv.y = pk2(O[dt][4 * g4 + 2] * inv, O[dt][4 * g4 + 3] * inv);
                *(u32x2*)(op + 32 * dt + 8 * g4 + 4 * h) = wv; }
    }
}

DI float ret_log2g(int head) { return log2f(1.0f - exp2f(-5.0f - (float)head)); }
constexpr float KSC = 0.08838834764831845f;
DI void ret_kv_unit(const Args& A, const Frame& F, int uidx) {
    const int c = uidx >> 2, head = uidx & 3; int tid = F.tid; asm volatile("" : "+v"(tid)); const int lane = tid & 63, w = F.wave;
    LAS unsigned char* Kl = F.lds; LAS unsigned char* Vl = F.lds + 34816;
    const float lg = ret_log2g(head);
    __syncthreads();
#pragma unroll 1
    for (int it = 0; it < 8; ++it) { const int t = tid + 512 * it, ch = t & 15, j = (t >> 4) & 127, isv = t >> 11;
        const bf16* src = F.PROJ() + (size_t)(c * 128 + j) * NIN + (isv ? 1792 : 1280) + head * 128 + 8 * ch;
        u32x4 wv = *(const u32x4*)src;
        if (!isv) { float f[8]; unpack8(wv, f); const float sc = KSC * exp2f(lg * (float)(127 - j));
            wv = (u32x4){pk2(f[0] * sc, f[1] * sc), pk2(f[2] * sc, f[3] * sc), pk2(f[4] * sc, f[5] * sc), pk2(f[6] * sc, f[7] * sc)}; }
        *(LAS u32x4*)((isv ? Vl : Kl) + (j * 136 + 8 * ch) * 2) = wv; }
    __syncthreads();
    const int n = lane & 31, h = lane >> 5, i16 = lane & 15, tq = i16 >> 2, tp = i16 & 3, blk = (lane >> 4) & 1;
    const int et = w >> 1, dt0 = 2 * (w & 1);
    f32x16 acc[2]; acc[0] = zero16(); acc[1] = zero16();
#pragma unroll
    for (int s = 0; s < 8; ++s) { const int rowoff = (16 * s + 8 * h + tq) * 136;
        const bf16x8 a = tr_frag(Vl + (rowoff + 32 * et + 16 * blk + 4 * tp) * 2, 4 * 136 * 2);
#pragma unroll
        for (int x = 0; x < 2; ++x) { const bf16x8 bb = tr_frag(Kl + (rowoff + 32 * (dt0 + x) + 16 * blk + 4 * tp) * 2, 4 * 136 * 2); acc[x] = MFMA32(a, bb, acc[x]); } }
    float* dst = F.RKV() + ((size_t)(c * 4 + head) * 128) * 128;
#pragma unroll
    for (int x = 0; x < 2; ++x)
#pragma unroll
        for (int r = 0; r < 16; ++r) dst[(size_t)(32 * et + crow(r, h)) * 128 + 32 * (dt0 + x) + n] = acc[x][r];
}
DI void ret_scan_phase(const Args& A, const Frame& F) {
    const int gt = F.bid * 512 + F.tid;
    if (gt < 65536) { const int head = gt >> 14, e = (gt >> 7) & 127, d = gt & 127;
        const float dc = exp2f(ret_log2g(head) * 128.f); float S = 0.f;
#pragma unroll 8
        for (int c = 0; c < 128; ++c) { F.SIN()[(size_t)c * 65536 + gt] = f2bf(S); S = S * dc + F.RKV()[(size_t)c * 65536 + gt]; }
        ((float*)(F.ws + WS_S5P + MiB))[gt] = S; (void)head; (void)e; (void)d; }
}
DI void pret_transpose_tile(const Args& A, const Frame& F, int tile) {
    const int head = tile >> 4, et = (tile >> 2) & 3, dt = tile & 3; LAS float* T = (LAS float*)F.lds;
    const float* src = (const float*)(F.ws + WS_S5P + MiB) + (size_t)head * 16384; float* dst = F.out + O_PRET + (size_t)head * 16384;
    __syncthreads();
    for (int idx = F.tid; idx < 1024; idx += 512) { const int el = idx >> 5, dl = idx & 31; T[el * 33 + dl] = src[(32 * et + el) * 128 + 32 * dt + dl]; }
    __syncthreads();
    for (int idx = F.tid; idx < 1024; idx += 512) { const int dl = idx >> 5, el = idx & 31; dst[(32 * dt + dl) * 128 + 32 * et + el] = T[el * 33 + dl]; }
    __syncthreads();
}
DI void ret_out_prompt(const Args& A, const Frame& F, int bu) {
    const int c = bu >> 1, hp = bu & 1; int tid = F.tid; asm volatile("" : "+v"(tid)); const int lane = tid & 63, w = F.wave;
    LAS unsigned char* Vl = F.lds;
    __syncthreads();
#pragma unroll 1
    for (int it = 0; it < 8; ++it) { const int t = tid + 512 * it, ch = t & 15, j = (t >> 4) & 127, hl = t >> 11;
        *(LAS u32x4*)(Vl + ((hl * 128 + j) * 136 + 8 * ch) * 2) = *(const u32x4*)(F.PROJ() + (size_t)(c * 128 + j) * NIN + 1792 + (2 * hp + hl) * 128 + 8 * ch); }
    __syncthreads();
    const int hl = w >> 2, it = w & 3, head = 2 * hp + hl, n = lane & 31, h = lane >> 5, i16 = lane & 15, tq = i16 >> 2, tp = i16 & 3, blk = (lane >> 4) & 1;
    const int tok = c * 128 + 32 * it + n; const float lg = ret_log2g(head);
    bf16x8 qf[8];
#pragma unroll
    for (int s = 0; s < 8; ++s) qf[s] = *(const bf16x8*)(F.PROJ() + (size_t)tok * NIN + 768 + head * 128 + 16 * s + 8 * h);
    f32x16 acc[4];
#pragma unroll
    for (int et = 0; et < 4; ++et) { acc[et] = zero16();
#pragma unroll
        for (int s = 0; s < 8; ++s) { const bf16x8 a = *(const bf16x8*)(F.SIN() + ((size_t)(c * 4 + head) * 128 + 32 * et + n) * 128 + 16 * s + 8 * h); acc[et] = MFMA32(a, qf[s], acc[et]); } }
    const float dq = exp2f(lg * (float)(32 * it + n + 1));
#pragma unroll
    for (int et = 0; et < 4; ++et) acc[et] = acc[et] * dq;
#pragma unroll 1
    for (int jt = 0; jt <= it; ++jt) {
        f32x16 X = zero16();
#pragma unroll
        for (int s = 0; s < 8; ++s) { const bf16x8 a = *(const bf16x8*)(F.PROJ() + (size_t)(c * 128 + 32 * jt + n) * NIN + 1280 + head * 128 + 16 * s + 8 * h); X = MFMA32(a, qf[s], X); }
#pragma unroll
        for (int r = 0; r < 16; ++r) { const int dd = 32 * it + n - (32 * jt + crow(r, h)); X[r] = dd >= 0 ? X[r] * (KSC * exp2f(lg * (float)dd)) : 0.f; }
#pragma unroll
        for (int s2 = 0; s2 < 2; ++s2) { const bf16x8 pf = PACK_STEP(X, s2);
#pragma unroll
            for (int et = 0; et < 4; ++et) { const bf16x8 vfr = tr_frag(Vl + ((hl * 128 + 32 * jt + 16 * s2 + 4 * h + tq) * 136 + 32 * et + 16 * blk + 4 * tp) * 2, 8 * 136 * 2);
                acc[et] = MFMA32(vfr, pf, acc[et]); } }
    }
    float sum = 0.f;
#pragma unroll
    for (int et = 0; et < 4; ++et)
#pragma unroll
        for (int r = 0; r < 16; ++r) sum += acc[et][r];
    sum += __shfl_xor(sum, 32); const float mean = sum * (1.f / 128.f); float var = 0.f;
#pragma unroll
    for (int et = 0; et < 4; ++et)
#pragma unroll
        for (int r = 0; r < 16; ++r) { const float dlt = acc[et][r] - mean; var += dlt * dlt; }
    var += __shfl_xor(var, 32); const float rstd = rsqrtf(var * (1.f / 128.f) + EPSN);
    const bf16* gp = F.PROJ() + (size_t)tok * NIN + 2304 + head * 128; bf16* op = F.MIX() + (size_t)tok * DM + 512 + head * 128; const float* rg = A.in[I_RG] + head * 128;
#pragma unroll
    for (int et = 0; et < 4; ++et)
#pragma unroll
        for (int g4 = 0; g4 < 4; ++g4) { const int e0 = 32 * et + 8 * g4 + 4 * h; const u32x2 gw = *(const u32x2*)(gp + e0); const f32x4 rgv = *(const f32x4*)(rg + e0);
            float gv[4] = {bflo(gw.x), bfhi(gw.x), bflo(gw.y), bfhi(gw.y)}; float y[4];
#pragma unroll
            for (int i = 0; i < 4; ++i) y[i] = (acc[et][4 * g4 + i] - mean) * rstd * rgv[i] * (gv[i] * pg8::sigm(gv[i]));
            u32x2 wv; wv.x = pk2(y[0], y[1]); wv.y = pk2(y[2], y[3]); *(u32x2*)(op + e0) = wv; }
}
DI void ret_sample_unit(const Args& A, const Frame& F, int uidx) {
    const int b = uidx >> 2, head = uidx & 3; const int tid = F.tid, lane = F.lane, w = F.wave;
    LAS float* Q = (LAS float*)F.lds; LAS float* Ks = Q + 1024; LAS float* V = Ks + 1024; LAS float* INN = V + 1024; LAS float* OO = INN + 64; LAS float* O2 = OO + 1024;
    const float lg = ret_log2g(head);
    __syncthreads();
    for (int idx = tid; idx < 3072; idx += 512) { const int which = idx >> 10, i = (idx >> 7) & 7, d = idx & 127;
        const float v = bf2f(F.PROJ()[(size_t)(TP + b * 8 + i) * NIN + (which == 0 ? 768 : which == 1 ? 1280 : 1792) + head * 128 + d]);
        (which == 0 ? Q : which == 1 ? Ks : V)[i * 128 + d] = which == 1 ? v * KSC : v; }
    __syncthreads();
    if (tid < 64) { const int i = tid >> 3, j = tid & 7; float dot = 0.f;
        for (int d = 0; d < 128; ++d) dot += Q[i * 128 + d] * Ks[j * 128 + d];
        INN[tid] = j <= i ? dot * exp2f(lg * (float)(i - j)) : 0.f; }
    {
        const int e4 = (tid & 31) * 4, dg = tid >> 5; f32x4 vv[8], o2[8];
#pragma unroll
        for (int j = 0; j < 8; ++j) { vv[j] = *(const LAS f32x4*)(V + j * 128 + e4) * exp2f(lg * (float)(7 - j)); o2[j] = (f32x4){0.f, 0.f, 0.f, 0.f}; }
        const float dc = exp2f(lg * 8.f);
        const float* S0 = A.in[I_SRET] + ((size_t)(b * 4 + head) * 128) * 128; float* S1 = F.out + O_SRET + ((size_t)(b * 4 + head) * 128) * 128;
        f32x4 sv[8];
#pragma unroll
        for (int dd = 0; dd < 8; ++dd) sv[dd] = *(const f32x4*)(S0 + (dg * 8 + dd) * 128 + e4);
#pragma unroll
        for (int dd = 0; dd < 8; ++dd) { const int d = dg * 8 + dd; const f32x4 s = sv[dd]; f32x4 sn = s * dc;
#pragma unroll
            for (int j = 0; j < 8; ++j) { o2[j] += Q[j * 128 + d] * s; sn += Ks[j * 128 + d] * vv[j]; }
            *(f32x4*)(S1 + d * 128 + e4) = sn; }
#pragma unroll
        for (int i = 0; i < 8; ++i) *(LAS f32x4*)(O2 + (dg * 8 + i) * 128 + e4) = o2[i];
    }
    __syncthreads();
    { const int e = tid & 127, ig = tid >> 7;
#pragma unroll
        for (int ii = 0; ii < 2; ++ii) { const int i = 2 * ig + ii; float o = 0.f;
#pragma unroll
            for (int dg = 0; dg < 16; ++dg) o += O2[(dg * 8 + i) * 128 + e];
            o *= exp2f(lg * (float)(i + 1));
            for (int j = 0; j <= i; ++j) o += INN[i * 8 + j] * V[j * 128 + e];
            OO[i * 128 + e] = o; } }
    __syncthreads();
    { const int i = w; const float a0 = OO[i * 128 + lane], a1 = OO[i * 128 + 64 + lane];
        const float mean = wave_sum(a0 + a1) * (1.f / 128.f); const float d0 = a0 - mean, d1 = a1 - mean;
        const float rstd = rsqrtf(wave_sum(d0 * d0 + d1 * d1) * (1.f / 128.f) + EPSN);
        const int tok = TP + b * 8 + i; const bf16* gp = F.PROJ() + (size_t)tok * NIN + 2304 + head * 128; bf16* op = F.MIX() + (size_t)tok * DM + 512 + head * 128; const float* rg = A.in[I_RG] + head * 128;
        const float g0 = bf2f(gp[lane]), g1 = bf2f(gp[64 + lane]);
        op[lane] = f2bf(d0 * rstd * rg[lane] * (g0 * pg8::sigm(g0))); op[64 + lane] = f2bf(d1 * rstd * rg[64 + lane] * (g1 * pg8::sigm(g1))); }
}

template <int PASS> DI void s5_phase(const Args& A, const Frame& F) {
    const int lane = F.lane, w = F.wave; const int gw = F.bid * NWAVES + w, NGW = F.G * NWAVES;
    LAS unsigned char* L = F.lds + w * 16896;
    const float* P = (const float*)(F.ws + WS_S5P); const bf16* BBt = (const bf16*)(F.ws + WS_S5P + S5_BBT); const bf16* CCt = (const bf16*)(F.ws + WS_S5P + S5_CCT);
    const int n = lane & 31, h = lane >> 5;
    const int nunits = PASS == 1 ? 64 * 128 : 2 * 64 * 128;
#pragma unroll 1
    for (int u = gw; u < nunits; u += NGW) {
        const bool sample = u >= 8192; const int uu = sample ? u - 8192 : u; const int g = uu & 63, cb = uu >> 6;
        const int tok0 = sample ? TP + cb * 8 : cb * 128, ntok = sample ? 8 : 128;
        const float lr = P[(S5_LAM >> 2) + 2 * (g * 64 + lane)], li = P[(S5_LAM >> 2) + 2 * (g * 64 + lane) + 1];
        float hr = 0.f, hi = 0.f;
        if (PASS == 2) { if (sample) { hr = A.in[I_S5R][(size_t)(cb * 64 + g) * 64 + lane]; hi = A.in[I_S5I][(size_t)(cb * 64 + g) * 64 + lane]; }
                         else { hr = F.S5H()[(size_t)(cb * 64 + g) * 128 + lane]; hi = F.S5H()[(size_t)(cb * 64 + g) * 128 + 64 + lane]; } }
        bf16x8 bbf[4];
#pragma unroll
        for (int qt = 0; qt < 4; ++qt) bbf[qt] = *(const bf16x8*)(BBt + (size_t)(g * 128 + 32 * qt + n) * 16 + 8 * h);
        bf16x8 cfh[8];
        if (PASS == 2) {
#pragma unroll
            for (int s = 0; s < 8; ++s) cfh[s] = *(const bf16x8*)(CCt + (size_t)(g * 16 + (n & 15)) * 128 + 16 * s + 8 * h); }
        bf16x8 dfr = (bf16x8){0, 0, 0, 0, 0, 0, 0, 0};
        if (PASS == 2) { const unsigned dbf = (unsigned)f2bf(A.in[I_DSK][g * 16 + (n & 15)]); const int jd = n < 16 ? (n & 15) - 8 * h : -100;
            u32x4 dw; dw.x = (jd == 0 ? dbf : 0u) | (jd == 1 ? dbf << 16 : 0u); dw.y = (jd == 2 ? dbf : 0u) | (jd == 3 ? dbf << 16 : 0u);
            dw.z = (jd == 4 ? dbf : 0u) | (jd == 5 ? dbf << 16 : 0u); dw.w = (jd == 6 ? dbf : 0u) | (jd == 7 ? dbf << 16 : 0u);
            dfr = __builtin_bit_cast(bf16x8, dw); }
#pragma unroll 1
        for (int st = 0; st < ntok; st += 32) {
            const int nv = ntok - st < 32 ? ntok - st : 32;
            bf16x8 a = (bf16x8){0, 0, 0, 0, 0, 0, 0, 0};
            if (n < nv) a = *(const bf16x8*)(F.XN() + (size_t)(tok0 + st + n) * DM + g * 16 + 8 * h);
#pragma unroll
            for (int qt = 0; qt < 4; ++qt) { const f32x16 cc = MFMA32(a, bbf[qt], zero16());
#pragma unroll
                for (int r = 0; r < 16; ++r) *(LAS float*)(L + crow(r, h) * 528 + 4 * (32 * qt + n)) = cc[r]; }
#pragma unroll 4
            for (int t = 0; t < nv; ++t) { const float br = *(LAS float*)(L + t * 528 + 4 * lane), bi = *(LAS float*)(L + t * 528 + 256 + 4 * lane);
                const float nr = lr * hr - li * hi + br, ni = lr * hi + li * hr + bi; hr = nr; hi = ni;
                if (PASS == 2) { *(LAS unsigned short*)(L + t * 528 + 2 * lane) = f2bf(hr); *(LAS unsigned short*)(L + t * 528 + 128 + 2 * lane) = f2bf(hi); } }
            if (PASS == 2) {
                f32x16 y = MFMA32(a, dfr, zero16());
#pragma unroll
                for (int s = 0; s < 8; ++s) { const bf16x8 hs = *(const LAS bf16x8*)(L + n * 528 + 32 * s + 16 * h); y = MFMA32(hs, cfh[s], y); }
                if (n < 16) {
#pragma unroll
                    for (int r = 0; r < 16; ++r) { const int t = crow(r, h);
                        if (t < nv) { const size_t o = (size_t)(tok0 + st + t) * DM + g * 16 + n; const float yy = y[r];
                            const float z = 0.7978845608028654f * (yy + 0.044715f * yy * yy * yy); F.MIX()[o] = f2bf(yy * pg8::sigm(2.f * z)); } } }
            }
        }
        if (PASS == 1) { F.S5E()[(size_t)(cb * 64 + g) * 128 + lane] = hr; F.S5E()[(size_t)(cb * 64 + g) * 128 + 64 + lane] = hi; }
        else { if (sample) { F.out[O_SS5R + (size_t)(cb * 64 + g) * 64 + lane] = hr; F.out[O_SS5I + (size_t)(cb * 64 + g) * 64 + lane] = hi; }
               else if (cb == 127) { F.out[O_PS5R + g * 64 + lane] = hr; F.out[O_PS5I + g * 64 + lane] = hi; } }
    }
}
DI void s5_carry_phase(const Args& A, const Frame& F) {
    const int gt = F.bid * 512 + F.tid;
    if (gt < 4096) { const int g = gt >> 6, p = gt & 63; const float* P = (const float*)(F.ws + WS_S5P);
        const float ar = P[(S5_LAM128 >> 2) + 2 * gt], ai = P[(S5_LAM128 >> 2) + 2 * gt + 1]; float Hr = 0.f, Hi = 0.f;
#pragma unroll 8
        for (int c = 0; c < 128; ++c) { const size_t o = (size_t)(c * 64 + g) * 128 + p; F.S5H()[o] = Hr; F.S5H()[o + 64] = Hi;
            const float er = F.S5E()[o], ei = F.S5E()[o + 64]; const float nr = ar * Hr - ai * Hi + er, ni = ar * Hi + ai * Hr + ei; Hr = nr; Hi = ni; } }
}

#define XB_TMO      128
#define XB_XCNT(j)  (256  + 64 * (j))
#define XB_XSUB(j)  (1280 + 64 * (j))
#define XB_XGEN(j)  (2304 + 64 * (j))
#define XB_TOP      3328
#define XB_TOPGEN   3392
#define XCD_BAR_WORDS 3456
#define XB_SPIN_CAP (1u << 18)

__device__ __forceinline__ unsigned xb_ld(unsigned* p)              { return __hip_atomic_load(p, __ATOMIC_RELAXED, __HIP_MEMORY_SCOPE_AGENT); }
__device__ __forceinline__ unsigned xb_add(unsigned* p, unsigned v) { return __hip_atomic_fetch_add(p, v, __ATOMIC_RELAXED, __HIP_MEMORY_SCOPE_AGENT); }
__device__ __forceinline__ unsigned xb_xcc_id() { return (unsigned)__builtin_amdgcn_s_getreg((3 << 11) | 20) & 0xFu; }
#define XB_SPIN(cond, bar) do { unsigned _sp = 0; while (cond) { __builtin_amdgcn_s_sleep(1); \
    if ((++_sp & 255u) == 0u) { if (xb_ld(&(bar)[XB_TMO])) break; if (_sp > XB_SPIN_CAP) { atomicAdd(&(bar)[XB_TMO], 1u); break; } } } } while (0)

struct XcdBarrier {
    unsigned* bar; unsigned x;
    volatile LAS unsigned* st;
};

__device__ __forceinline__ XcdBarrier xcd_barrier_post(unsigned* bar, volatile LAS unsigned* st) {
    XcdBarrier b; b.bar = bar; b.x = xb_xcc_id(); b.st = st;
    if (threadIdx.x == 0) (void)xb_add(&bar[XB_XCNT(b.x)], 1u);
    return b;
}
__device__ __forceinline__ void xcd_barrier_complete(unsigned* bar, unsigned x, unsigned& nloc, unsigned& nx) {
    const unsigned G = gridDim.x * gridDim.y * gridDim.z;
    unsigned sum, cnt, mine, sp = 0u;
    for (;;) {
        sum = 0u; cnt = 0u; mine = 0u;
#pragma unroll
        for (unsigned j = 0; j < 16; ++j) { const unsigned c = xb_ld(&bar[XB_XCNT(j)]); sum += c; cnt += (c > 0u) ? 1u : 0u; mine = (j == x) ? c : mine; }
        if (sum == G) break;
        __builtin_amdgcn_s_sleep(1);
        if ((++sp & 255u) == 0u) { if (xb_ld(&bar[XB_TMO])) break; if (sp > XB_SPIN_CAP) { atomicAdd(&bar[XB_TMO], 1u); break; } }
    }
    nloc = mine > 0u ? mine : 1u; nx = cnt > 0u ? cnt : 1u;
}

__device__ __forceinline__ void xcd_barrier(const XcdBarrier& b) {
    asm volatile("s_waitcnt vmcnt(0)" ::: "memory");
    __syncthreads();
    if (threadIdx.x == 0) {
        unsigned* bar = b.bar;
        __builtin_amdgcn_s_waitcnt(0);
        unsigned nloc = b.st[0], nx = b.st[1];
        if (nloc == 0u) { xcd_barrier_complete(bar, b.x, nloc, nx); b.st[0] = nloc; b.st[1] = nx; }
        const unsigned old = xb_add(&bar[XB_XSUB(b.x)], 1u);
        const unsigned gen = old / nloc;
        if (old + 1u == (gen + 1u) * nloc) {
            __builtin_amdgcn_fence(__ATOMIC_RELEASE, "agent");
            asm volatile("s_waitcnt vmcnt(0)" ::: "memory");
            const unsigned og = xb_add(&bar[XB_TOP], 1u);
            const unsigned tg = og / nx;
            if (og + 1u == (tg + 1u) * nx) xb_add(&bar[XB_TOPGEN], 1u);
            else XB_SPIN(xb_ld(&bar[XB_TOPGEN]) == tg, bar);
            __builtin_amdgcn_fence(__ATOMIC_ACQUIRE, "");
            xb_add(&bar[XB_XGEN(b.x)], 1u);
            asm volatile("s_waitcnt vmcnt(0)" ::: "memory");
        } else {
            XB_SPIN(xb_ld(&bar[XB_XGEN(b.x)]) == gen, bar);
            __builtin_amdgcn_fence(__ATOMIC_ACQUIRE, "");
            asm volatile("s_waitcnt vmcnt(0)" ::: "memory");
        }
    }
    __syncthreads();
}

constexpr int NPHASE = 17;
__global__ void __launch_bounds__(NWAVES * 64, 2) mega_fwd(Args args) {
    extern __shared__ __attribute__((aligned(16))) unsigned char lds_raw[];
    cg::grid_group grid = cg::this_grid();
    Frame F;
    F.lds = (LAS unsigned char*)lds_raw; F.tid = threadIdx.x; F.lane = F.tid & 63; F.wave = __builtin_amdgcn_readfirstlane(F.tid >> 6); F.G = gridDim.x; F.bid = blockIdx.x;
    F.out = args.out; F.ws = args.ws;
    const int lo = args.ph_lo, hi = args.ph_hi;
    volatile LAS unsigned* misc_ = (volatile LAS unsigned*)(F.lds + LDS_BYTES - 64);
    if (F.tid < 16) misc_[F.tid] = 0u;
    __syncthreads();
    const XcdBarrier xbar_ = xcd_barrier_post((unsigned*)args.ws, misc_);
    if (lo < 0) grid.sync();
#define GSYNC() xcd_barrier(xbar_)
    float* XR = F.out + O_Y;
#ifndef PHMASK
#define PHMASK 0xfffffu
#endif
#define IN(k) (((PHMASK >> (k)) & 1u) && lo <= (k) && (k) < hi)
#define SEAM(k) do { if (IN(k) && IN((k) + 1)) GSYNC(); } while (0)
#ifndef RPTMASK
#define RPTMASK 0u
#endif
#ifndef XSYNC
#define XSYNC 0
#endif
#define RPT(k) (((RPTMASK >> (k)) & 1u) ? 2 : 1)
#define RB(k) for (int rep_ = 0; rep_ < RPT(k); ++rep_) { if (rep_) GSYNC();
#define RE }
#define GEMM_SPLIT(g, E, nM_, nN_, S__) do { pg8::SplitOrder S_; S_.init(nM_, nN_, S__, F.G, (int)blockIdx.x); pg8::gemm_phase<pg8::EpiPartial, pg8::SplitOrder, true, true>(F.lds, g, S_, E); } while (0)
#define GEMM_PHASE(EPI, g, E) do { pg8::StaticOrder S_; S_.init((g).M, (g).N, F.G, (int)blockIdx.x); pg8::gemm_phase<EPI, pg8::StaticOrder, true, true>(F.lds, g, S_, E); } while (0)

    if (IN(0)) { RB(0)  p0_prologue(args, F);  RE } SEAM(0);
    if (IN(1)) { RB(1)  pg8::Gemm g{F.CA(), F.Wada_t(), 256, NMOD, 1024}; pg8::EpiF32Bias E{F.MOD(), NMOD, args.in[I_ADAB]}; GEMM_PHASE(pg8::EpiF32Bias, g, E);  RE } SEAM(1);
    if (IN(2)) { RB(2)  norm_phase(args, F, args.in[I_XP], args.in[I_XS], args.in[I_NMIX], F.MOD(), 0, 1024);  RE } SEAM(2);
    if (IN(3)) { RB(3)  pg8::Gemm g{F.XN(), F.Win_t(), MT, NIN, 1024}; pg8::EpiBf16<0> E{F.PROJ(), NIN, nullptr, 0, 0, 1.f}; GEMM_PHASE(pg8::EpiBf16<0>, g, E);  RE } SEAM(3);
    if (IN(4)) { RB(4)
#ifndef P4SEL
#define P4SEL 7
#endif
        if (P4SEL & 1) for (int u = F.bid; u < 512; u += F.G) attn_unit<false>(args, F, u);
        if (P4SEL & 2) for (int u = (F.bid + 128) % F.G; u < 128; u += F.G) attn_unit<true>(args, F, u);
        if (P4SEL & 4) for (int u = F.bid; u < 512; u += F.G) ret_kv_unit(args, F, u);
        __syncthreads();
    RE } SEAM(4);
    if (IN(5)) { RB(5)  ret_scan_phase(args, F);  RE } SEAM(5);
    if (IN(6)) { RB(6)  if (F.bid < 64) pret_transpose_tile(args, F, F.bid);
        for (int u = F.bid; u < 768; u += F.G) { if (u < 256) ret_out_prompt(args, F, u); else ret_sample_unit(args, F, u - 256); } __syncthreads();  RE } SEAM(6);
    if (IN(7)) { RB(7)  { pg8::Gemm g{F.MIX(), F.Wout_t(), TP, 1024, 1024, 0}; pg8::EpiResid E{args.in[I_XP], args.in[I_XS], XR, F.MOD() + 2048}; GEMM_PHASE(pg8::EpiResid, g, E); }
        { pg8::Gemm g{F.MIX() + (size_t)TP * DM, F.Wout_t(), TS, 1024, 256, 1024}; pg8::EpiPartial E{(bf16*)(F.ws + WS_PART0), TS, 0}; GEMM_SPLIT(g, E, 4, 4, 4); }  RE } SEAM(7);
    if (IN(8)) { RB(8)  norm_phase(args, F, XR, args.in[I_XS], args.in[I_NFFN], F.MOD(), 3072, 4096, (const bf16*)(F.ws + WS_PART0), 4, F.MOD() + 2048, XR);  RE } SEAM(8);
    if (IN(9)) { RB(9)  pg8::Gemm g{F.XN(), F.Wgu_t(0), MT, 2 * DFF, 1024}; pg8::EpiSwiGLU E{F.PROJ(), DFF}; GEMM_PHASE(pg8::EpiSwiGLU, g, E);  RE } SEAM(9);
    if (IN(10)) { RB(10)  { pg8::Gemm g{F.PROJ(), F.Wd_t(0), TP, 1024, DFF, 0}; pg8::EpiResid E{XR, XR + (size_t)TP * DM, XR, F.MOD() + 5120}; GEMM_PHASE(pg8::EpiResid, g, E); }
        { pg8::Gemm g{F.PROJ() + (size_t)TP * DFF, F.Wd_t(0), TS, 1024, 256, DFF}; pg8::EpiPartial E{F.MIX(), TS, 0}; GEMM_SPLIT(g, E, 4, 4, 11); }  RE } SEAM(10);
    if (IN(11)) { RB(11)  norm_phase(args, F, XR, XR + (size_t)TP * DM, args.in[I_NMIX] + 1024, F.MOD() + LMOD, 0, 1024, F.MIX(), 11, F.MOD() + 5120, XR);  RE } SEAM(11);
    if (IN(12)) { RB(12)  s5_phase<1>(args, F);  RE } SEAM(12);
    if (IN(13)) { RB(13)  s5_carry_phase(args, F);  RE } SEAM(13);
    if (IN(14)) { RB(14)  s5_phase<2>(args, F);  RE } SEAM(14);
    if (IN(15)) { RB(15)  { pg8::Gemm g{F.MIX(), F.Wglu_t(), TP, 2048, 1024, 0}; pg8::EpiGLUResid E{XR, F.MOD() + LMOD + 2048}; GEMM_PHASE(pg8::EpiGLUResid, g, E); }
        { pg8::Gemm g{F.MIX() + (size_t)TP * DM, F.Wglu_t(), TS, 2048, 256, 1024}; pg8::EpiPartial E{(bf16*)(F.ws + WS_PART0), TS, 2048}; GEMM_SPLIT(g, E, 4, 8, 4); }  RE } SEAM(15);
    if (IN(16)) { RB(16)  norm_phase(args, F, XR, XR + (size_t)TP * DM, args.in[I_NFFN] + 1024, F.MOD() + LMOD, 3072, 4096, nullptr, 4, F.MOD() + LMOD + 2048, XR, (const bf16*)(F.ws + WS_PART0));  RE } SEAM(16);
    if (IN(17)) { RB(17)  pg8::Gemm g{F.XN(), F.Wgu_t(1), MT, 2 * DFF, 1024}; pg8::EpiSwiGLU E{F.PROJ(), DFF}; GEMM_PHASE(pg8::EpiSwiGLU, g, E);  RE } SEAM(17);
    if (IN(18)) { { pg8::Gemm g{F.PROJ(), F.Wd_t(1), TP, 1024, DFF, 0}; pg8::EpiResid E{XR, XR + (size_t)TP * DM, XR, F.MOD() + LMOD + 5120}; GEMM_PHASE(pg8::EpiResid, g, E); }
        { pg8::Gemm g{F.PROJ() + (size_t)TP * DFF, F.Wd_t(1), TS, 1024, 256, DFF}; pg8::EpiPartial E{F.MIX(), TS, 0}; GEMM_SPLIT(g, E, 4, 4, 11); } } SEAM(18);
    if (IN(19)) {
        const int gw = F.bid * NWAVES + F.wave, NGW = F.G * NWAVES; const bf16* part = F.MIX();
        for (int m = TP + gw; m < MT; m += NGW) { const float* grow = F.MOD() + LMOD + 5120 + (size_t)pg8::seq_of_row(m) * NMOD;
#pragma unroll
            for (int j = 0; j < 4; ++j) { const int col = 4 * (64 * j + F.lane); const size_t po = (size_t)(m - TP) * 1024 + col; f32x4 ps = (f32x4){0.f, 0.f, 0.f, 0.f};
                for (int sl = 0; sl < 11; ++sl) { const u32x2 w = *(const u32x2*)(part + (size_t)sl * TS * 1024 + po); ps += (f32x4){bflo(w.x), bfhi(w.x), bflo(w.y), bfhi(w.y)}; }
                *(f32x4*)(XR + (size_t)m * DM + col) = *(const f32x4*)(XR + (size_t)m * DM + col) + *(const f32x4*)(grow + col) * ps; } }
    }
#undef IN
#undef SEAM
}

extern "C" void kernel_launch(void* const* d_in, const int* in_sizes, int n_in, void* d_out, int out_size, void* d_ws, size_t ws_size, hipStream_t stream) {
    static int grid = 0;
    if (grid == 0) {
        if (n_in != 32 || (size_t)out_size != O_END || ws_size < WS_END) { fprintf(stderr, "kernel_launch: unexpected shapes n_in %d out %d ws %zu\n", n_in, out_size, ws_size); grid = -1; return; }
        int dev = 0, cus = 0, per_cu = 0;
        hipGetDevice(&dev); hipDeviceGetAttribute(&cus, hipDeviceAttributeMultiprocessorCount, dev);
        hipFuncSetAttribute((const void*)mega_fwd, hipFuncAttributeMaxDynamicSharedMemorySize, LDS_BYTES);
        hipOccupancyMaxActiveBlocksPerMultiprocessor(&per_cu, (const void*)mega_fwd, NWAVES * 64, LDS_BYTES);
        if (per_cu < 1) { fprintf(stderr, "kernel_launch: occupancy query says %d blocks/CU\n", per_cu); per_cu = 1; }
        (void)hipGetLastError();
        grid = cus;
    }
    if (grid < 0) return;
    if (hipMemsetAsync(d_ws, 0, 65536, stream) != hipSuccess) { fprintf(stderr, "kernel_launch: memset failed\n"); return; }
    Args a{};
    for (int i = 0; i < 32; ++i) a.in[i] = (const float*)d_in[i];
    a.out = (float*)d_out; a.ws = (unsigned char*)d_ws; a.ph_lo = 0; a.ph_hi = 20;
    void* kargs[] = {&a};
    hipError_t e = hipLaunchCooperativeKernel((const void*)mega_fwd, dim3(grid), dim3(NWAVES * 64), kargs, LDS_BYTES, stream);
    if (e != hipSuccess) fprintf(stderr, "cooperative launch failed: %s (grid %d)\n", hipGetErrorString(e), grid);
}
```

```cpp
#include <hip/hip_runtime.h>
#include <hip/hip_cooperative_groups.h>
#include <cstdio>
#include <cstdint>
namespace cg = cooperative_groups;
namespace pg8 {
#define PG8_LAS __attribute__((address_space(3)))
typedef unsigned short bf16_t;
typedef short bf16x8 __attribute__((ext_vector_type(8)));
typedef float f32x4 __attribute__((ext_vector_type(4)));
typedef unsigned u32x4 __attribute__((ext_vector_type(4)));
constexpr int BM = 256, BK = 64, HALF = 128, HTB = HALF * BK * 2  , STAGE_BYTES = 8 * HTB, NXCD = 8, WGM = 8;

__host__ __device__ __forceinline__ int lds_byte(int r, int c) { const int st = (r >> 4) * 2 + (c >> 5), rr = r & 15, cc = c & 31, ob = rr * 64 + cc * 2; return st * 1024 + (ob ^ (((ob >> 9) & 1) << 5)); }
__host__ __device__ __forceinline__ void stage_rc(int b, int& R, int& C) { const int st = b / 1024, sb = b % 1024, swz = sb ^ (((sb >> 9) & 1) << 5); R = (st >> 1) * 16 + swz / 64; C = (st & 1) * 32 + (swz % 64) / 2; }
__host__ __device__ __forceinline__ int perm32(int rho) { const int n = rho >> 4, i = rho & 15; return 8 * (i >> 2) + 4 * n + (i & 3); }

struct Unit { int pm, pn, ks; };
struct Gemm { const bf16_t* A; const bf16_t* Bt; int M, N, K, ld; };

struct StaticOrder {
    int nM, nN, nwg, G, c;
    __host__ __device__ void init(int M, int N, int G_, int c_) { nM = M / BM; nN = N / BM; nwg = nM * nN; G = G_; c = c_; }
    __host__ __device__ bool next(int i, Unit& u) const {
        const long L = (long)i * G + c; if (L >= nwg) return false;
        int wgid = (int)L; { const int q = nwg / NXCD, r = nwg % NXCD, xcd = wgid % NXCD, off = wgid / NXCD; wgid = (xcd < r ? xcd * (q + 1) : r * (q + 1) + (xcd - r) * q) + off; }
        const int nig = WGM * nN, gid = wgid / nig, fm = gid * WGM, gsz = (nM - fm) < WGM ? (nM - fm) : WGM;
        u.pm = fm + ((wgid % nig) % gsz); u.pn = (wgid % nig) / gsz; u.ks = 0; return true;
    }
    __device__ __forceinline__ void a_ready(const Unit&) const {}
    __device__ __forceinline__ void done(const Unit&) const {}
};

struct SplitOrder {
    int nM, nN, nwg, G, c;
    __host__ __device__ void init(int nM_, int nN_, int S, int G_, int c_) { nM = nM_; nN = nN_; nwg = nM_ * nN_ * S; G = G_; c = c_; }
    __host__ __device__ bool next(int i, Unit& u) const { const int L = i * G + c; if (L >= nwg) return false; const int t = nM * nN, r = L % t; u.ks = L / t; u.pm = r % nM; u.pn = r / nM; return true; }
    __device__ __forceinline__ void a_ready(const Unit&) const {}
    __device__ __forceinline__ void done(const Unit&) const {}
};
__device__ __forceinline__ unsigned cvt_pk_bf16(float lo, float hi) { unsigned r; asm volatile("v_cvt_pk_bf16_f32 %0, %1, %2" : "=v"(r) : "v"(lo), "v"(hi)); return r; }
typedef float f32x2 __attribute__((ext_vector_type(2)));
__device__ __forceinline__ f32x2 gelu_pk(f32x2 v) {
    const f32x2 av = __builtin_elementwise_abs(v), d = av * 0.2316418882f + 1.0f;
    f32x2 t; t.x = __builtin_amdgcn_rcpf(d.x); t.y = __builtin_amdgcn_rcpf(d.y);
    f32x2 q = t * 0.5307027145f + (-0.7265760135f); q = q * t + 0.7107068705f; q = q * t + (-0.142248368f); q = q * t + 0.127414796f; q = q * t;
    const f32x2 s = (v * v) * (-0.72134752044f);
    f32x2 e; e.x = __builtin_amdgcn_exp2f(s.x); e.y = __builtin_amdgcn_exp2f(s.y);
    const f32x2 m = v * (q * e), r = v - m;
    f32x2 o; o.x = v.x < 0.f ? m.x : r.x; o.y = v.y < 0.f ? m.y : r.y; return o;
}

template <int ACT  > struct EpiBf16 {
    static constexpr bool PERM = true, AFTER_DRAIN = false; static_assert(ACT == 0 || ACT == 1, "EpiBf16: ACT is 0 (none) or 1 (gelu_pk)");
    bf16_t* O; int ldc; const float* bias; int split_cols; size_t split_stride; float scale0;
    __device__ __forceinline__ void operator()(const f32x4 (&acc)[2][2][4][2], const Unit& u, int wr, int wc, int fr, int fq) const {
        const int row0 = u.pm * BM + wr * 64 + fr; int colt = u.pn * BM; bf16_t* base = O;
        float sc = 1.f; if (split_cols) { const int t = colt / split_cols; base += (size_t)t * split_stride; colt -= t * split_cols; if (t == 0) sc = scale0; }
        const int col0 = colt + wc * 32 + 8 * fq, bcol0 = u.pn * BM + wc * 32 + 8 * fq;
        f32x4 bv[2][2];
#pragma unroll
        for (int bj = 0; bj < 2; ++bj)
#pragma unroll
            for (int n = 0; n < 2; ++n) bv[bj][n] = bias ? *(const f32x4*)(bias + bcol0 + bj * HALF + 4 * n) : (f32x4){0.f, 0.f, 0.f, 0.f};
#pragma unroll
        for (int ai = 0; ai < 2; ++ai)
#pragma unroll
            for (int m = 0; m < 4; ++m) { bf16_t* rowp = base + (size_t)(row0 + ai * HALF + m * 16) * ldc + col0;
#pragma unroll
                for (int bj = 0; bj < 2; ++bj) { f32x4 v0 = acc[ai][bj][m][0] + bv[bj][0], v1 = acc[ai][bj][m][1] + bv[bj][1];
                    if (ACT == 1) { f32x2 a = gelu_pk((f32x2){v0[0], v0[1]}), b = gelu_pk((f32x2){v0[2], v0[3]}), c = gelu_pk((f32x2){v1[0], v1[1]}), d = gelu_pk((f32x2){v1[2], v1[3]});
                        v0 = (f32x4){a.x, a.y, b.x, b.y}; v1 = (f32x4){c.x, c.y, d.x, d.y}; }
                    v0 = v0 * sc; v1 = v1 * sc; u32x4 w; w.x = cvt_pk_bf16(v0[0], v0[1]); w.y = cvt_pk_bf16(v0[2], v0[3]); w.z = cvt_pk_bf16(v1[0], v1[1]); w.w = cvt_pk_bf16(v1[2], v1[3]);
                    *(u32x4*)(rowp + bj * HALF) = w; } }
    }
};
constexpr int TPROMPT = 16384, NMODC = 12288;
__device__ __forceinline__ int seq_of_row(int row) { return row < TPROMPT ? 0 : 1 + ((row - TPROMPT) >> 3); }
__device__ __forceinline__ float sigm(float x) { return __builtin_amdgcn_rcpf(1.0f + __expf(-x)); }
typedef unsigned u32x2 __attribute__((ext_vector_type(2)));

struct EpiF32Bias {
    static constexpr bool PERM = false, AFTER_DRAIN = false;
    float* O; int ldc; const float* bias;
    __device__ __forceinline__ void operator()(const f32x4 (&acc)[2][2][4][2], const Unit& u, int wr, int wc, int fr, int fq) const {
        const int row0 = u.pm * BM + wr * 64 + fr, col0 = u.pn * BM + wc * 32 + 4 * fq;
#pragma unroll
        for (int bj = 0; bj < 2; ++bj)
#pragma unroll
            for (int n = 0; n < 2; ++n) { const int col = col0 + bj * HALF + n * 16; const f32x4 bv = *(const f32x4*)(bias + col);
#pragma unroll
                for (int ai = 0; ai < 2; ++ai)
#pragma unroll
                    for (int m = 0; m < 4; ++m) *(f32x4*)(O + (size_t)(row0 + ai * HALF + m * 16) * ldc + col) = acc[ai][bj][m][n] + bv; }
    }
};
struct EpiPartial {
    static constexpr bool PERM = false, AFTER_DRAIN = false;
    bf16_t* P; int rows; int ldp;
    __device__ __forceinline__ void operator()(const f32x4 (&acc)[2][2][4][2], const Unit& u, int wr, int wc, int fr, int fq) const {
        const int row0 = u.pm * BM + wr * 64 + fr, col0 = u.pn * BM + wc * 32 + 4 * fq; const int lp = ldp ? ldp : 1024; bf16_t* base = P + (size_t)u.ks * rows * lp;
#pragma unroll
        for (int ai = 0; ai < 2; ++ai)
#pragma unroll
            for (int m = 0; m < 4; ++m) { bf16_t* orow = base + (size_t)(row0 + ai * HALF + m * 16) * lp;
#pragma unroll
                for (int bj = 0; bj < 2; ++bj)
#pragma unroll
                    for (int n = 0; n < 2; ++n) { const f32x4 v = acc[ai][bj][m][n]; u32x2 w; w.x = cvt_pk_bf16(v[0], v[1]); w.y = cvt_pk_bf16(v[2], v[3]); *(u32x2*)(orow + col0 + bj * HALF + n * 16) = w; } }
    }
};
struct EpiResid {
    static constexpr bool PERM = false, AFTER_DRAIN = false;
    const float* bp; const float* bs; float* out; const float* gate;
    __device__ __forceinline__ void operator()(const f32x4 (&acc)[2][2][4][2], const Unit& u, int wr, int wc, int fr, int fq) const {
        const int row0 = u.pm * BM + wr * 64 + fr, col0 = u.pn * BM + wc * 32 + 4 * fq;
#pragma unroll
        for (int ai = 0; ai < 2; ++ai)
#pragma unroll
            for (int m = 0; m < 4; ++m) { const int row = row0 + ai * HALF + m * 16;
                const float* brow = row < TPROMPT ? bp + (size_t)row * 1024 : bs + (size_t)(row - TPROMPT) * 1024;
                const float* grow = gate + (size_t)seq_of_row(row) * NMODC; float* orow = out + (size_t)row * 1024;
#pragma unroll
                for (int bj = 0; bj < 2; ++bj)
#pragma unroll
                    for (int n = 0; n < 2; ++n) { const int col = col0 + bj * HALF + n * 16;
                        const f32x4 b = *(const f32x4*)(brow + col), g = *(const f32x4*)(grow + col);
                        *(f32x4*)(orow + col) = b + g * acc[ai][bj][m][n]; } }
    }
};
struct EpiSwiGLU {
    static constexpr bool PERM = false, AFTER_DRAIN = false;
    bf16_t* H; int ldh;
    __device__ __forceinline__ void operator()(const f32x4 (&acc)[2][2][4][2], const Unit& u, int wr, int wc, int fr, int fq) const {
        const int row0 = u.pm * BM + wr * 64 + fr, col0 = u.pn * 128 + wc * 16 + 4 * fq;
#pragma unroll
        for (int ai = 0; ai < 2; ++ai)
#pragma unroll
            for (int m = 0; m < 4; ++m) { bf16_t* rowp = H + (size_t)(row0 + ai * HALF + m * 16) * ldh + col0;
#pragma unroll
                for (int bj = 0; bj < 2; ++bj) { const f32x4 g = acc[ai][bj][m][0], uu = acc[ai][bj][m][1]; f32x4 hv;
#pragma unroll
                    for (int i = 0; i < 4; ++i) hv[i] = g[i] * sigm(g[i]) * uu[i];
                    u32x2 w; w.x = cvt_pk_bf16(hv[0], hv[1]); w.y = cvt_pk_bf16(hv[2], hv[3]);
                    *(u32x2*)(rowp + bj * 64) = w; } }
    }
};
struct EpiGLUResid {
    static constexpr bool PERM = false, AFTER_DRAIN = false;
    float* out; const float* gate;
    __device__ __forceinline__ void operator()(const f32x4 (&acc)[2][2][4][2], const Unit& u, int wr, int wc, int fr, int fq) const {
        const int row0 = u.pm * BM + wr * 64 + fr, col0 = u.pn * 128 + wc * 16 + 4 * fq;
#pragma unroll
        for (int ai = 0; ai < 2; ++ai)
#pragma unroll
            for (int m = 0; m < 4; ++m) { const int row = row0 + ai * HALF + m * 16;
                const float* grow = gate + (size_t)seq_of_row(row) * NMODC; float* orow = out + (size_t)row * 1024;
#pragma unroll
                for (int bj = 0; bj < 2; ++bj) { const int col = col0 + bj * 64; const f32x4 a = acc[ai][bj][m][0], b = acc[ai][bj][m][1];
                    const f32x4 x = *(const f32x4*)(orow + col), g = *(const f32x4*)(grow + col); f32x4 v;
#pragma unroll
                    for (int i = 0; i < 4; ++i) v[i] = x[i] + g[i] * (a[i] * sigm(b[i]));
                    *(f32x4*)(orow + col) = v; } }
    }
};
template <class Epi, class Sched, bool ALIGN_EPI = false, bool SP2 = false>
__device__ __forceinline__ void gemm_phase(PG8_LAS unsigned char* lds, const Gemm g, const Sched& S, const Epi& E) {
    const int tid = threadIdx.x, wid = __builtin_amdgcn_readfirstlane(tid >> 6), lane = tid & 63, wr = wid >> 2, wc = wid & 3, fr = lane & 15, fq = lane >> 4;
    const int K = g.K, nt = K / BK, ld = g.ld ? g.ld : g.K;
    unsigned voffA[2], voffB[2];
#pragma unroll
    for (int i = 0; i < 2; ++i) { int R, C; stage_rc(tid * 16 + i * 8192, R, C); const int Rb = Epi::PERM ? ((R & ~31) + perm32(R & 31)) : R;
        voffA[i] = (unsigned)(R * ld + C) * 2u; voffB[i] = (unsigned)(Rb * ld + C) * 2u; }
    const size_t kstep = (size_t)(BK * 2);
    const size_t hstep = (size_t)HALF * ld * 2;
    const size_t tstep = 2 * hstep;
    const unsigned ldsw = (unsigned)wid * 1024u;
    const int aoff = lds_byte(wr * 64 + fr, fq * 8), boff = lds_byte(wc * 32 + fr, fq * 8);
#define PG8_SA(b, h) (((b) * 2 + (h)) * HTB)
#define PG8_SB(b, h) ((4 + (b) * 2 + (h)) * HTB)
#define PG8_STAGE(bufoff, gbase, voff) do { _Pragma("unroll") for (int _i = 0; _i < 2; ++_i) \
        __builtin_amdgcn_global_load_lds((const unsigned*)((const char*)(gbase) + (voff)[_i]), (PG8_LAS unsigned*)(lds + (bufoff) + ldsw + _i * 8192), 16, 0, 0); } while (0)
#define PG8_LDA(dst, b, h) do { _Pragma("unroll") for (int m = 0; m < 4; ++m) _Pragma("unroll") for (int k = 0; k < 2; ++k) dst[m][k] = *(const PG8_LAS bf16x8*)(lds + PG8_SA(b, h) + aoff + m * 2048 + k * 1024); } while (0)
#define PG8_LDB(dst, b, h) do { _Pragma("unroll") for (int n = 0; n < 2; ++n) _Pragma("unroll") for (int k = 0; k < 2; ++k) dst[n][k] = *(const PG8_LAS bf16x8*)(lds + PG8_SB(b, h) + boff + n * 2048 + k * 1024); } while (0)
#define PG8_MMA(ai, bj, At, Bt) do { __builtin_amdgcn_s_setprio(1); _Pragma("unroll") for (int m = 0; m < 4; ++m) _Pragma("unroll") for (int n = 0; n < 2; ++n) _Pragma("unroll") for (int k = 0; k < 2; ++k) \
        acc[ai][bj][m][n] = __builtin_amdgcn_mfma_f32_16x16x32_bf16(Bt[n][k], At[m][k], acc[ai][bj][m][n], 0, 0, 0); __builtin_amdgcn_s_setprio(0); } while (0)
#define PG8_WAIT_V(n) asm volatile("s_waitcnt vmcnt(" #n ")" ::: "memory")
#define PG8_WAIT_L(n) asm volatile("s_waitcnt lgkmcnt(" #n ")" ::: "memory")
#define PG8_BAR __builtin_amdgcn_s_barrier()
#define PG8_SCHED __builtin_amdgcn_sched_barrier(0)
    Unit cur, nxt; int ui = 0;
    if (!S.next(0, cur)) return;
    f32x4 acc[2][2][4][2];
#pragma unroll
    for (int a = 0; a < 2; ++a)
#pragma unroll
        for (int b = 0; b < 2; ++b)
#pragma unroll
            for (int m = 0; m < 4; ++m)
#pragma unroll
                for (int n = 0; n < 2; ++n) acc[a][b][m][n] = (f32x4){0.f, 0.f, 0.f, 0.f};
    bf16x8 At[4][2], B0[2][2], B1[2][2];
    const char* cA = (const char*)g.A + (size_t)cur.pm * tstep + (size_t)cur.ks * K * 2; const char* cB = (const char*)g.Bt + (size_t)cur.pn * tstep + (size_t)cur.ks * K * 2;
    S.a_ready(cur);
    if constexpr (SP2) {
        PG8_STAGE(PG8_SB(0, 0), cB, voffB); PG8_STAGE(PG8_SB(0, 1), cB + hstep, voffB); PG8_STAGE(PG8_SA(0, 0), cA, voffA); PG8_STAGE(PG8_SA(0, 1), cA + hstep, voffA);
        if (wr == 1) PG8_BAR;
        PG8_WAIT_V(2); PG8_BAR;
        PG8_STAGE(PG8_SB(1, 0), cB + kstep, voffB); PG8_STAGE(PG8_SA(1, 0), cA + kstep, voffA); PG8_STAGE(PG8_SB(1, 1), cB + hstep + kstep, voffB);
        PG8_WAIT_V(6); PG8_BAR;
    } else {
        PG8_STAGE(PG8_SB(0, 0), cB, voffB); PG8_STAGE(PG8_SA(0, 0), cA, voffA); PG8_STAGE(PG8_SB(0, 1), cB + hstep, voffB); PG8_STAGE(PG8_SA(0, 1), cA + hstep, voffA);
        if (wr == 1) PG8_BAR;
        PG8_WAIT_V(4); PG8_BAR;
        PG8_STAGE(PG8_SB(1, 0), cB + kstep, voffB); PG8_STAGE(PG8_SA(1, 0), cA + kstep, voffA); PG8_STAGE(PG8_SB(1, 1), cB + hstep + kstep, voffB);
        PG8_WAIT_V(6); PG8_BAR;
    }
    for (;;) {
        const bool has_next = S.next(ui + 1, nxt);
        const char* nA = has_next ? (const char*)g.A + (size_t)nxt.pm * tstep + (size_t)nxt.ks * K * 2 : cA; const char* nB = has_next ? (const char*)g.Bt + (size_t)nxt.pn * tstep + (size_t)nxt.ks * K * 2 : cB;
        for (int t = 0; t < nt; t += 2) {
            const bool last = (t == nt - 2);
            const char* a1 = cA + (size_t)(t + 1) * kstep;
            const char* a2 = last ? nA : cA + (size_t)(t + 2) * kstep; const char* b2 = last ? nB : cB + (size_t)(t + 2) * kstep;
            const char* a3 = a2 + kstep; const char* b3 = b2 + kstep;
            if (last && has_next) S.a_ready(nxt);
            if constexpr (SP2) {
            PG8_LDB(B0, 0, 0); PG8_LDB(B1, 0, 1); PG8_SCHED; PG8_LDA(At, 0, 0); PG8_STAGE(PG8_SA(1, 1), a1 + hstep, voffA);
            PG8_WAIT_V(8); PG8_WAIT_L(0); PG8_BAR; PG8_MMA(0, 0, At, B0); PG8_MMA(0, 1, At, B1); PG8_BAR; PG8_SCHED;
            PG8_LDA(At, 0, 1); PG8_STAGE(PG8_SB(0, 0), b2, voffB); PG8_STAGE(PG8_SB(0, 1), b2 + hstep, voffB); PG8_STAGE(PG8_SA(0, 0), a2, voffA);
            PG8_WAIT_V(8); PG8_WAIT_L(0); PG8_BAR; PG8_MMA(1, 0, At, B0); PG8_MMA(1, 1, At, B1); PG8_BAR; PG8_SCHED;
            PG8_LDB(B0, 1, 0); PG8_LDB(B1, 1, 1); PG8_SCHED; PG8_LDA(At, 1, 0); PG8_STAGE(PG8_SA(0, 1), a2 + hstep, voffA);
            PG8_WAIT_V(8); PG8_WAIT_L(0); PG8_BAR; PG8_MMA(0, 0, At, B0); PG8_MMA(0, 1, At, B1); PG8_BAR; PG8_SCHED;
            PG8_LDA(At, 1, 1); PG8_STAGE(PG8_SB(1, 0), b3, voffB); PG8_STAGE(PG8_SB(1, 1), b3 + hstep, voffB); PG8_STAGE(PG8_SA(1, 0), a3, voffA);
            PG8_WAIT_V(8); PG8_WAIT_L(0); PG8_BAR; PG8_MMA(1, 0, At, B0); PG8_MMA(1, 1, At, B1); PG8_BAR; PG8_SCHED;
            } else {
            PG8_LDB(B0, 0, 0); PG8_SCHED; PG8_LDA(At, 0, 0); PG8_STAGE(PG8_SA(1, 1), a1 + hstep, voffA);
            PG8_WAIT_L(8); PG8_BAR; PG8_WAIT_L(0); PG8_MMA(0, 0, At, B0); PG8_BAR; PG8_SCHED;
            PG8_LDB(B1, 0, 1); PG8_STAGE(PG8_SB(0, 0), b2, voffB);
            PG8_BAR; PG8_WAIT_L(0); PG8_MMA(0, 1, At, B1); PG8_BAR;
            PG8_LDA(At, 0, 1); PG8_STAGE(PG8_SA(0, 0), a2, voffA);
            PG8_BAR; PG8_WAIT_L(0); PG8_MMA(1, 0, At, B0); PG8_BAR; PG8_SCHED;
            PG8_STAGE(PG8_SB(0, 1), b2 + hstep, voffB);
            PG8_WAIT_V(6); PG8_BAR; PG8_MMA(1, 1, At, B1); PG8_BAR;
            PG8_LDB(B0, 1, 0); PG8_SCHED; PG8_LDA(At, 1, 0); PG8_STAGE(PG8_SA(0, 1), a2 + hstep, voffA);
            PG8_WAIT_L(8); PG8_BAR; PG8_WAIT_L(0); PG8_MMA(0, 0, At, B0); PG8_BAR; PG8_SCHED;
            PG8_LDB(B1, 1, 1); PG8_STAGE(PG8_SB(1, 0), b3, voffB);
            PG8_BAR; PG8_WAIT_L(0); PG8_MMA(0, 1, At, B1); PG8_BAR;
            PG8_LDA(At, 1, 1); PG8_STAGE(PG8_SA(1, 0), a3, voffA);
            PG8_BAR; PG8_WAIT_L(0); PG8_MMA(1, 0, At, B0); PG8_BAR; PG8_SCHED;
            PG8_STAGE(PG8_SB(1, 1), b3 + hstep, voffB);
            PG8_WAIT_V(6); PG8_BAR; PG8_MMA(1, 1, At, B1); PG8_BAR;
            }
        }
        if constexpr (ALIGN_EPI) { if (wr == 0) PG8_BAR; }
        if constexpr (!Epi::AFTER_DRAIN) { E(acc, cur, wr, wc, fr, fq); S.done(cur); }
        if (!has_next) break;
#pragma unroll
        for (int a = 0; a < 2; ++a)
#pragma unroll
            for (int b = 0; b < 2; ++b)
#pragma unroll
                for (int m = 0; m < 4; ++m)
#pragma unroll
                    for (int n = 0; n < 2; ++n) acc[a][b][m][n] = (f32x4){0.f, 0.f, 0.f, 0.f};
        cur = nxt; cA = nA; cB = nB; ++ui;
        if constexpr (ALIGN_EPI) { if (wr == 1) PG8_BAR; }
    }
    PG8_WAIT_V(0);
    if constexpr (!ALIGN_EPI) { if (wr == 0) PG8_BAR; }
    PG8_BAR;
    if constexpr (Epi::AFTER_DRAIN) { E.fused(acc, cur, wr, wc, fr, fq, lds, wid, lane); S.done(cur); }
#undef PG8_SA
#undef PG8_SB
#undef PG8_STAGE
#undef PG8_LDA
#undef PG8_LDB
#undef PG8_MMA
#undef PG8_WAIT_V
#undef PG8_WAIT_L
#undef PG8_BAR
#undef PG8_SCHED
}
}

constexpr int TP = 16384, TS = 1024, MT = TP + TS, DM = 1024, NBATCH = 128;
constexpr int NIN = 2816, DFF = 2816, NMOD = 12288, LMOD = 6144;
constexpr float EPSN = 1e-6f, LOG2E = 1.4426950408889634f;
constexpr int NWAVES = 8;
constexpr size_t O_Y = 0, O_PK = (size_t)MT * DM, O_PV = O_PK + 16384, O_PRET = O_PV + 16384, O_PS5R = O_PRET + 65536, O_PS5I = O_PS5R + 4096,
                 O_SK = O_PS5I + 4096, O_SV = O_SK + 2097152, O_SRET = O_SV + 2097152, O_SS5R = O_SRET + 8388608, O_SS5I = O_SS5R + 524288, O_END = O_SS5I + 524288;
constexpr size_t MiB = 1u << 20;
constexpr size_t WS_CA = 1 * MiB, WS_MOD = 2 * MiB, WS_S5P = 14 * MiB, WS_WIN = 16 * MiB, WS_WOUT = 22 * MiB, WS_WGU0 = 24 * MiB, WS_WGU1 = 35 * MiB,
                 WS_WD0 = 46 * MiB, WS_WD1 = 52 * MiB, WS_WGLU = 58 * MiB, WS_XN = 62 * MiB, WS_RKV = 62 * MiB, WS_MIX = 96 * MiB, WS_PROJ = 130 * MiB,
                 WS_WADA = 130 * MiB, WS_S5E = 130 * MiB, WS_S5H = 134 * MiB, WS_SIN = 224 * MiB, WS_PART0 = 240 * MiB, WS_PART1 = 248 * MiB, WS_END = 256 * MiB;
constexpr size_t S5_LAM = 0, S5_LAM128 = 32768, S5_BBT = 65536, S5_CCT = 65536 + 262144;
constexpr int LDS_BYTES = 147456;

#define LAS __attribute__((address_space(3)))
typedef unsigned short bf16;
typedef unsigned u32x4 __attribute__((ext_vector_type(4)));
typedef unsigned u32x2 __attribute__((ext_vector_type(2)));
typedef float f32x4 __attribute__((ext_vector_type(4)));
typedef float f32x2 __attribute__((ext_vector_type(2)));
typedef float f32x16 __attribute__((ext_vector_type(16)));
typedef short bf16x8 __attribute__((ext_vector_type(8)));
typedef short s16x4 __attribute__((ext_vector_type(4)));
typedef short v4i16_t __attribute__((ext_vector_type(4)));
typedef __bf16 bf16x2_t __attribute__((ext_vector_type(2)));
#define DI __device__ __forceinline__
#define MFMA32(a, b, c) __builtin_amdgcn_mfma_f32_32x32x16_bf16((a), (b), (c), 0, 0, 0)
DI unsigned pk2(float lo, float hi) { f32x2 v = {lo, hi}; bf16x2_t b = __builtin_convertvector(v, bf16x2_t); return __builtin_bit_cast(unsigned, b); }
DI unsigned short f2bf(float f) { return (unsigned short)(pk2(f, 0.f) & 0xffffu); }
DI float bflo(unsigned w) { return __uint_as_float(w << 16); }
DI float bfhi(unsigned w) { return __uint_as_float(w & 0xffff0000u); }
DI float bf2f(unsigned short b) { return __uint_as_float((unsigned)b << 16); }
DI int crow(int r, int h) { return (r & 3) + 8 * (r >> 2) + 4 * h; }
DI float wave_sum(float v) {
#pragma unroll
    for (int o = 1; o < 64; o <<= 1) v += __shfl_xor(v, o);
    return v;
}
DI s16x4 tr_read(const LAS unsigned char* p) { return __builtin_bit_cast(s16x4, __builtin_amdgcn_ds_read_tr16_b64_v4i16((LAS v4i16_t*)p)); }
DI bf16x8 tr_frag(const LAS unsigned char* lo, int hi_off) { const s16x4 a = tr_read(lo), b = tr_read(lo + hi_off); return __builtin_shufflevector(a, b, 0, 1, 2, 3, 4, 5, 6, 7); }
DI bf16x8 pack8(float a0, float a1, float a2, float a3, float a4, float a5, float a6, float a7) {
    u32x4 p; p.x = pk2(a0, a1); p.y = pk2(a2, a3); p.z = pk2(a4, a5); p.w = pk2(a6, a7); return __builtin_bit_cast(bf16x8, p);
}
#define PACK_STEP(x, s) pack8((x)[8 * (s)], (x)[8 * (s) + 1], (x)[8 * (s) + 2], (x)[8 * (s) + 3], (x)[8 * (s) + 4], (x)[8 * (s) + 5], (x)[8 * (s) + 6], (x)[8 * (s) + 7])
DI f32x16 zero16() { f32x16 z;
#pragma unroll
    for (int i = 0; i < 16; ++i) z[i] = 0.f; return z; }
DI void unpack8(const u32x4 w, float* f) { f[0] = bflo(w.x); f[1] = bfhi(w.x); f[2] = bflo(w.y); f[3] = bfhi(w.y); f[4] = bflo(w.z); f[5] = bfhi(w.z); f[6] = bflo(w.w); f[7] = bfhi(w.w); }

struct Args { const float* in[32]; float* out; unsigned char* ws; int ph_lo, ph_hi; };
struct Frame {
    LAS unsigned char* lds; int tid, lane, wave, G, bid;
    float* out; unsigned char* ws;
    DI bf16* CA() const { return (bf16*)(ws + WS_CA); }
    DI bf16* Win_t() const { return (bf16*)(ws + WS_WIN); }
    DI bf16* Wout_t() const { return (bf16*)(ws + WS_WOUT); }
    DI bf16* Wgu_t(int l) const { return (bf16*)(ws + (l ? WS_WGU1 : WS_WGU0)); }
    DI bf16* Wd_t(int l) const { return (bf16*)(ws + (l ? WS_WD1 : WS_WD0)); }
    DI bf16* Wglu_t() const { return (bf16*)(ws + WS_WGLU); }
    DI bf16* Wada_t() const { return (bf16*)(ws + WS_WADA); }
    DI bf16* XN() const { return (bf16*)(ws + WS_XN); }
    DI bf16* MIX() const { return (bf16*)(ws + WS_MIX); }
    DI bf16* PROJ() const { return (bf16*)(ws + WS_PROJ); }
    DI bf16* SIN() const { return (bf16*)(ws + WS_SIN); }
    DI float* MOD() const { return (float*)(ws + WS_MOD); }
    DI float* RKV() const { return (float*)(ws + WS_RKV); }
    DI float* S5E() const { return (float*)(ws + WS_S5E); }
    DI float* S5H() const { return (float*)(ws + WS_S5H); }
};
enum { I_XP = 0, I_XS, I_CK, I_CV, I_SRET, I_S5R, I_S5I, I_CP, I_CS, I_ADAW, I_ADAB, I_NMIX, I_NFFN, I_WG, I_WU, I_WD, I_WIN, I_QG, I_KG, I_SINK, I_RG, I_WOUT,
       I_ARE, I_AIM, I_LDT, I_BRE, I_BIM, I_CRE, I_CIM, I_DSK, I_GLA, I_GLB };

DI void transpose_item(const float* W, int K, int N, bf16* WT, int rs, int ro, LAS float* scr, int item, int lane) {
    const int nblk = N / 32, kb = item / nblk, nb = item % nblk, k0 = 64 * kb, n0 = 32 * nb;
#pragma unroll 8
    for (int i = 0; i < 32; ++i) { const int kk = 2 * i + (lane >> 5); scr[kk * 33 + (lane & 31)] = W[(size_t)(k0 + kk) * N + n0 + (lane & 31)]; }
    asm volatile("s_waitcnt lgkmcnt(0)" ::: "memory");
    const int c = lane & 7;
#pragma unroll
    for (int j = 0; j < 4; ++j) { const int n = (lane >> 3) + 8 * j; const LAS float* s = scr + (8 * c) * 33 + n;
        u32x4 o; o.x = pk2(s[0 * 33], s[1 * 33]); o.y = pk2(s[2 * 33], s[3 * 33]); o.z = pk2(s[4 * 33], s[5 * 33]); o.w = pk2(s[6 * 33], s[7 * 33]);
        const int nn = n0 + n, drow = (nn >> 4) * rs + (nn & 15) + ro;
        *(u32x4*)(WT + (size_t)drow * K + k0 + 8 * c) = o; }
    asm volatile("s_waitcnt lgkmcnt(0)" ::: "memory");
}
DI void p0_prologue(const Args& A, const Frame& F) {
    LAS float* scr = (LAS float*)(F.lds + F.wave * 16384);
    const int gw = F.bid * NWAVES + F.wave, NGW = F.G * NWAVES;
    constexpr int I_A = 16 * 88, I_B = 16 * 32, I_C = 44 * 32, I_E = 16 * 192;
    constexpr int NITEMS = I_A + I_B + 4 * I_A + 2 * I_C + 2 * I_B + 2 * I_E;
    for (int it = gw; it < NITEMS; it += NGW) {
        int r = it;
        if (r < I_A) { transpose_item(A.in[I_WIN], 1024, NIN, F.Win_t(), 16, 0, scr, r, F.lane); continue; } r -= I_A;
        if (r < I_B) { transpose_item(A.in[I_WOUT], 1024, 1024, F.Wout_t(), 16, 0, scr, r, F.lane); continue; } r -= I_B;
        if (r < 4 * I_A) { const int which = r / I_A, rr = r % I_A, l = which >> 1, up = which & 1;
            transpose_item(A.in[up ? I_WU : I_WG] + (size_t)l * 1024 * DFF, 1024, DFF, F.Wgu_t(l), 32, up * 16, scr, rr, F.lane); continue; } r -= 4 * I_A;
        if (r < 2 * I_C) { const int l = r / I_C, rr = r % I_C; transpose_item(A.in[I_WD] + (size_t)l * DFF * 1024, DFF, 1024, F.Wd_t(l), 16, 0, scr, rr, F.lane); continue; } r -= 2 * I_C;
        if (r < 2 * I_B) { const int b = r / I_B, rr = r % I_B; transpose_item(A.in[b ? I_GLB : I_GLA], 1024, 1024, F.Wglu_t(), 32, b * 16, scr, rr, F.lane); continue; } r -= 2 * I_B;
        { const int l = r / I_E, rr = r % I_E; transpose_item(A.in[I_ADAW] + (size_t)l * 1024 * LMOD, 1024, LMOD, F.Wada_t(), 16, l * LMOD, scr, rr, F.lane); }
    }
    const int gt = F.bid * 512 + F.tid, NGT = F.G * 512;
    for (int idx = gt; idx < 256 * 1024; idx += NGT) { const int row = idx >> 10, col = idx & 1023;
        float v = 0.f; if (row == 0) v = A.in[I_CP][col]; else if (row <= NBATCH) v = A.in[I_CS][(row - 1) * 1024 + col];
        F.CA()[idx] = f2bf(v * pg8::sigm(v)); }
    if (gt < 65536) {
        const int gp = gt >> 4, i = gt & 15, g = gp >> 6, p = gp & 63;
        const float are = A.in[I_ARE][gp], aim = A.in[I_AIM][gp], dt = expf(A.in[I_LDT][g]);
        const float a = are * dt, b = aim * dt; const float mag = expf(a), cb = cosf(b), sb = sinf(b), sh = sinf(0.5f * b);
        const float lr = mag * cb, li = mag * sb;
        const float nr = expm1f(a) * cb - 2.f * sh * sh, ni = li;
        const float den = are * are + aim * aim; const float fr = (nr * are + ni * aim) / den, fi = (ni * are - nr * aim) / den;
        bf16* BBt = (bf16*)(F.ws + WS_S5P + S5_BBT); bf16* CCt = (bf16*)(F.ws + WS_S5P + S5_CCT);
        const float br = A.in[I_BRE][gt], bi = A.in[I_BIM][gt];
        BBt[(g * 128 + p) * 16 + i] = f2bf(fr * br - fi * bi); BBt[(g * 128 + 64 + p) * 16 + i] = f2bf(fr * bi + fi * br);
        { const int go = gt >> 6, pp = gt & 63;
          CCt[go * 128 + pp] = f2bf(A.in[I_CRE][go * 64 + pp]); CCt[go * 128 + 64 + pp] = f2bf(-A.in[I_CIM][go * 64 + pp]); }
        if (i == 0) {
            float* P = (float*)(F.ws + WS_S5P);
            P[(S5_LAM >> 2) + 2 * gp] = lr; P[(S5_LAM >> 2) + 2 * gp + 1] = li;
            float pr = lr, pi = li;
#pragma unroll
            for (int k = 0; k < 7; ++k) { const float t = pr * pr - pi * pi; pi = 2.f * pr * pi; pr = t; }
            P[(S5_LAM128 >> 2) + 2 * gp] = pr; P[(S5_LAM128 >> 2) + 2 * gp + 1] = pi;
        }
    }
}

DI void norm_phase(const Args& A, const Frame& F, const float* xp, const float* xs, const float* gamma, const float* mod, int sh_off, int sc_off, const bf16* part = nullptr, int ns = 0, const float* pgate = nullptr, float* xw = nullptr, const bf16* gpart = nullptr) {
    const int gw = F.bid * NWAVES + F.wave, NGW = F.G * NWAVES;
    for (int m = gw; m < MT; m += NGW) {
        const float* xrow = m < TP ? xp + (size_t)m * DM : xs + (size_t)(m - TP) * DM;
        const float* mrow = mod + (size_t)pg8::seq_of_row(m) * NMOD;
        f32x4 v[4]; float ss = 0.f;
#pragma unroll
        for (int j = 0; j < 4; ++j) { v[j] = *(const f32x4*)(xrow + 4 * (64 * j + F.lane));
            if (part && m >= TP) { const int col = 4 * (64 * j + F.lane); const size_t po = (size_t)(m - TP) * 1024 + col;
                const f32x4 g = *(const f32x4*)(pgate + (size_t)pg8::seq_of_row(m) * NMOD + col); f32x4 ps = (f32x4){0.f, 0.f, 0.f, 0.f};
                for (int sl = 0; sl < ns; ++sl) { const u32x2 w = *(const u32x2*)(part + (size_t)sl * TS * 1024 + po); ps += (f32x4){bflo(w.x), bfhi(w.x), bflo(w.y), bfhi(w.y)}; }
                v[j] = v[j] + g * ps; *(f32x4*)(xw + (size_t)m * DM + col) = v[j]; }
            if (gpart && m >= TP) { const int col = 4 * (64 * j + F.lane); const size_t po = (size_t)(m - TP) * 2048 + (col >> 4) * 32 + (col & 15);
                const f32x4 g = *(const f32x4*)(pgate + (size_t)pg8::seq_of_row(m) * NMOD + col); f32x4 pa = (f32x4){0.f, 0.f, 0.f, 0.f}, pb = pa;
                for (int sl = 0; sl < ns; ++sl) { const u32x2 wa = *(const u32x2*)(gpart + (size_t)sl * TS * 2048 + po), wb = *(const u32x2*)(gpart + (size_t)sl * TS * 2048 + po + 16);
                    pa += (f32x4){bflo(wa.x), bfhi(wa.x), bflo(wa.y), bfhi(wa.y)}; pb += (f32x4){bflo(wb.x), bfhi(wb.x), bflo(wb.y), bfhi(wb.y)}; }
                f32x4 gl; gl.x = pa.x * pg8::sigm(pb.x); gl.y = pa.y * pg8::sigm(pb.y); gl.z = pa.z * pg8::sigm(pb.z); gl.w = pa.w * pg8::sigm(pb.w);
                v[j] = v[j] + g * gl; *(f32x4*)(xw + (size_t)m * DM + col) = v[j]; }
            ss += (v[j].x * v[j].x + v[j].y * v[j].y) + (v[j].z * v[j].z + v[j].w * v[j].w); }
        const float rstd = rsqrtf(wave_sum(ss) * (1.f / DM) + EPSN);
#pragma unroll
        for (int j = 0; j < 4; ++j) { const int col = 4 * (64 * j + F.lane);
            const f32x4 g = *(const f32x4*)(gamma + col), sc = *(const f32x4*)(mrow + sc_off + col), sh = *(const f32x4*)(mrow + sh_off + col);
            const f32x4 y = v[j] * rstd * g * (1.f + sc) + sh;
            u32x2 w; w.x = pk2(y.x, y.y); w.y = pk2(y.z, y.w); *(u32x2*)(F.XN() + (size_t)m * DM + col) = w; }
    }
}

template <bool SAMPLE> DI void attn_unit(const Args& A, const Frame& F, int uidx) {
    LAS unsigned char* Kl = F.lds; LAS unsigned char* Vl = F.lds + 46080;
    int tid = F.tid; asm volatile("" : "+v"(tid)); const int lane = tid & 63, w = F.wave;
    const int q0 = SAMPLE ? 0 : 32 * uidx, b = uidx;
    const float* kgain = A.in[I_KG];
    __syncthreads();
#pragma unroll 1
    for (int it = 0; it < 5; ++it) {
        const int t = tid + 512 * it, ch = t & 7, rr = t >> 3, kv = rr >= 160 ? 1 : 0, kk = rr - 160 * kv;
        float kf[8], vf[8]; bool valid = true, donorm = true; int tok = 0;
        if (SAMPLE) {
            if (kk < 128) { donorm = false; const size_t o = ((size_t)(b * 128 + kk) * 2 + kv) * 64 + 8 * ch;
                const f32x4 k0 = *(const f32x4*)(A.in[I_CK] + o), k1 = *(const f32x4*)(A.in[I_CK] + o + 4), v0 = *(const f32x4*)(A.in[I_CV] + o), v1 = *(const f32x4*)(A.in[I_CV] + o + 4);
                kf[0] = k0.x; kf[1] = k0.y; kf[2] = k0.z; kf[3] = k0.w; kf[4] = k1.x; kf[5] = k1.y; kf[6] = k1.z; kf[7] = k1.w;
                vf[0] = v0.x; vf[1] = v0.y; vf[2] = v0.z; vf[3] = v0.w; vf[4] = v1.x; vf[5] = v1.y; vf[6] = v1.z; vf[7] = v1.w; }
            else { valid = kk < 136; tok = TP + b * 8 + ((kk - 128) & 7); }
        } else { tok = q0 - 128 + kk; valid = tok >= 0; if (!valid) tok = 0; }
        if (!SAMPLE || kk >= 128) {
            const bf16* src = F.PROJ() + (size_t)tok * NIN + 512 + kv * 64 + 8 * ch;
            const u32x4 kw = *(const u32x4*)src, vw = *(const u32x4*)(src + 128);
            unpack8(kw, kf); unpack8(vw, vf);
        }
        float ss = 0.f;
#pragma unroll
        for (int j = 0; j < 8; ++j) ss += kf[j] * kf[j];
        ss += __shfl_xor(ss, 1); ss += __shfl_xor(ss, 2); ss += __shfl_xor(ss, 4);
        const float rstd = rsqrtf(ss * (1.f / 64.f) + EPSN);
#pragma unroll
        for (int j = 0; j < 8; ++j) { if (donorm) kf[j] = kf[j] * rstd * kgain[8 * ch + j]; if (!valid) { kf[j] = 0.f; vf[j] = 0.f; } }
        const int lo = ((kv * 160 + kk) * 72 + 8 * ch) * 2;
        *(LAS u32x4*)(Kl + lo) = (u32x4){pk2(kf[0], kf[1]), pk2(kf[2], kf[3]), pk2(kf[4], kf[5]), pk2(kf[6], kf[7])};
        *(LAS u32x4*)(Vl + lo) = (u32x4){pk2(vf[0], vf[1]), pk2(vf[2], vf[3]), pk2(vf[4], vf[5]), pk2(vf[6], vf[7])};
        float* ok = nullptr; float* ov = nullptr;
        if (SAMPLE) { if (kk >= 8 && kk < 136) { const size_t o = ((size_t)(b * 128 + kk - 8) * 2 + kv) * 64 + 8 * ch; ok = F.out + O_SK + o; ov = F.out + O_SV + o; } }
        else { if (q0 == TP - 32 && kk >= 32) { const size_t o = ((size_t)(kk - 32) * 2 + kv) * 64 + 8 * ch; ok = F.out + O_PK + o; ov = F.out + O_PV + o; } }
        if (ok) { *(f32x4*)ok = (f32x4){kf[0], kf[1], kf[2], kf[3]}; *(f32x4*)(ok + 4) = (f32x4){kf[4], kf[5], kf[6], kf[7]};
                  *(f32x4*)ov = (f32x4){vf[0], vf[1], vf[2], vf[3]}; *(f32x4*)(ov + 4) = (f32x4){vf[4], vf[5], vf[6], vf[7]}; }
    }
    const int n = lane & 31, h = lane >> 5, hh = w, kvh = hh >> 2;
    const int qtok = SAMPLE ? TP + b * 8 + (n & 7) : q0 + n;
    bf16x8 qf[4];
    {
        const bf16* qp = F.PROJ() + (size_t)qtok * NIN + hh * 64 + 8 * h; float qv[4][8]; float ss = 0.f;
#pragma unroll
        for (int s = 0; s < 4; ++s) { const u32x4 raw = *(const u32x4*)(qp + 16 * s); unpack8(raw, qv[s]);
#pragma unroll
            for (int j = 0; j < 8; ++j) ss += qv[s][j] * qv[s][j]; }
        ss += __shfl_xor(ss, 32);
        const float rstd = rsqrtf(ss * (1.f / 64.f) + EPSN) * (0.125f * LOG2E);
        const float* qg = A.in[I_QG];
#pragma unroll
        for (int s = 0; s < 4; ++s) { float t[8];
#pragma unroll
            for (int j = 0; j < 8; ++j) t[j] = qv[s][j] * rstd * qg[16 * s + 8 * h + j];
            qf[s] = pack8(t[0], t[1], t[2], t[3], t[4], t[5], t[6], t[7]); }
    }
    __syncthreads();
    f32x16 S[5];
#pragma unroll
    for (int kt = 0; kt < 5; ++kt) { S[kt] = zero16();
#pragma unroll
        for (int s = 0; s < 4; ++s) { const bf16x8 a = *(const LAS bf16x8*)(Kl + ((kvh * 160 + 32 * kt + n) * 72 + 16 * s + 8 * h) * 2); S[kt] = MFMA32(a, qf[s], S[kt]); } __builtin_amdgcn_sched_barrier(0); }
    const float slope2 = exp2f(-(float)(hh + 1)) * LOG2E, sink2 = A.in[I_SINK][hh] * LOG2E;
    float mx = -1e30f;
#pragma unroll
    for (int kt = 0; kt < 5; ++kt)
#pragma unroll
        for (int r = 0; r < 16; ++r) { const int kidx = 32 * kt + crow(r, h), dist = 128 + n - kidx;
            const bool okk = dist >= 0 && dist < 128 && (SAMPLE || q0 - 128 + kidx >= 0);
            const float v = okk ? S[kt][r] - slope2 * (float)dist : -1e30f; S[kt][r] = v; mx = fmaxf(mx, v); }
    mx = fmaxf(mx, __shfl_xor(mx, 32)); mx = fmaxf(mx, sink2);
    float sum = 0.f;
    bf16x8 pfs[5][2];
#pragma unroll
    for (int kt = 0; kt < 5; ++kt)
#pragma unroll
        for (int s2 = 0; s2 < 2; ++s2) { float p[8];
#pragma unroll
            for (int j = 0; j < 8; ++j) { p[j] = exp2f(S[kt][8 * s2 + j] - mx); sum += p[j]; }
            pfs[kt][s2] = pack8(p[0], p[1], p[2], p[3], p[4], p[5], p[6], p[7]); }
    sum += __shfl_xor(sum, 32);
    const float inv = 1.f / (sum + exp2f(sink2 - mx));
    __builtin_amdgcn_sched_barrier(0);
    f32x16 O[2]; O[0] = zero16(); O[1] = zero16();
    const int i16 = lane & 15, tq = i16 >> 2, tp = i16 & 3, blk = (lane >> 4) & 1;
    const LAS unsigned char* vbase = Vl + ((kvh * 160 + 4 * h + tq) * 72 + 16 * blk + 4 * tp) * 2;
#pragma unroll
    for (int kt = 0; kt < 5; ++kt) {
#pragma unroll
        for (int s2 = 0; s2 < 2; ++s2) {
#pragma unroll
            for (int dt = 0; dt < 2; ++dt) { const bf16x8 vfr = tr_frag(vbase + ((32 * kt + 16 * s2) * 72 + 32 * dt) * 2, 8 * 72 * 2);
                O[dt] = MFMA32(vfr, pfs[kt][s2], O[dt]); } }
        __builtin_amdgcn_sched_barrier(0); }
    if (!SAMPLE || n < 8) {
        bf16* op = F.MIX() + (size_t)qtok * DM + hh * 64;
#pragma unroll
        for (int dt = 0; dt < 2; ++dt)
#pragma unroll
            for (int g4 = 0; g4 < 4; ++g4) { u32x2 wv; wv.x = pk2(O[dt][4 * g4] * inv, O[dt][4 * g4 + 1] * inv); wv.y = pk2(O[dt][4 * g4 + 2] * inv, O[dt][4 * g4 + 3] * inv);
                *(u32x2*)(op + 32 * dt + 8 * g4 + 4 * h) = wv; }
    }
}

DI float ret_log2g(int head) { return log2f(1.0f - exp2f(-5.0f - (float)head)); }
constexpr float KSC = 0.08838834764831845f;
DI void ret_kv_unit(const Args& A, const Frame& F, int uidx) {
    const int c = uidx >> 2, head = uidx & 3; int tid = F.tid; asm volatile("" : "+v"(tid)); const int lane = tid & 63, w = F.wave;
    LAS unsigned char* Kl = F.lds; LAS unsigned char* Vl = F.lds + 34816;
    const float lg = ret_log2g(head);
    __syncthreads();
#pragma unroll 1
    for (int it = 0; it < 8; ++it) { const int t = tid + 512 * it, ch = t & 15, j = (t >> 4) & 127, isv = t >> 11;
        const bf16* src = F.PROJ() + (size_t)(c * 128 + j) * NIN + (isv ? 1792 : 1280) + head * 128 + 8 * ch;
        u32x4 wv = *(const u32x4*)src;
        if (!isv) { float f[8]; unpack8(wv, f); const float sc = KSC * exp2f(lg * (float)(127 - j));
            wv = (u32x4){pk2(f[0] * sc, f[1] * sc), pk2(f[2] * sc, f[3] * sc), pk2(f[4] * sc, f[5] * sc), pk2(f[6] * sc, f[7] * sc)}; }
        *(LAS u32x4*)((isv ? Vl : Kl) + (j * 136 + 8 * ch) * 2) = wv; }
    __syncthreads();
    const int n = lane & 31, h = lane >> 5, i16 = lane & 15, tq = i16 >> 2, tp = i16 & 3, blk = (lane >> 4) & 1;
    const int et = w >> 1, dt0 = 2 * (w & 1);
    f32x16 acc[2]; acc[0] = zero16(); acc[1] = zero16();
#pragma unroll
    for (int s = 0; s < 8; ++s) { const int rowoff = (16 * s + 8 * h + tq) * 136;
        const bf16x8 a = tr_frag(Vl + (rowoff + 32 * et + 16 * blk + 4 * tp) * 2, 4 * 136 * 2);
#pragma unroll
        for (int x = 0; x < 2; ++x) { const bf16x8 bb = tr_frag(Kl + (rowoff + 32 * (dt0 + x) + 16 * blk + 4 * tp) * 2, 4 * 136 * 2); acc[x] = MFMA32(a, bb, acc[x]); } }
    float* dst = F.RKV() + ((size_t)(c * 4 + head) * 128) * 128;
#pragma unroll
    for (int x = 0; x < 2; ++x)
#pragma unroll
        for (int r = 0; r < 16; ++r) dst[(size_t)(32 * et + crow(r, h)) * 128 + 32 * (dt0 + x) + n] = acc[x][r];
}
DI void ret_scan_phase(const Args& A, const Frame& F) {
    const int gt = F.bid * 512 + F.tid;
    if (gt < 65536) { const int head = gt >> 14, e = (gt >> 7) & 127, d = gt & 127;
        const float dc = exp2f(ret_log2g(head) * 128.f); float S = 0.f;
#pragma unroll 8
        for (int c = 0; c < 128; ++c) { F.SIN()[(size_t)c * 65536 + gt] = f2bf(S); S = S * dc + F.RKV()[(size_t)c * 65536 + gt]; }
        ((float*)(F.ws + WS_S5P + MiB))[gt] = S; (void)head; (void)e; (void)d; }
}
DI void pret_transpose_tile(const Args& A, const Frame& F, int tile) {
    const int head = tile >> 4, et = (tile >> 2) & 3, dt = tile & 3; LAS float* T = (LAS float*)F.lds;
    const float* src = (const float*)(F.ws + WS_S5P + MiB) + (size_t)head * 16384; float* dst = F.out + O_PRET + (size_t)head * 16384;
    __syncthreads();
    for (int idx = F.tid; idx < 1024; idx += 512) { const int el = idx >> 5, dl = idx & 31; T[el * 33 + dl] = src[(32 * et + el) * 128 + 32 * dt + dl]; }
    __syncthreads();
    for (int idx = F.tid; idx < 1024; idx += 512) { const int dl = idx >> 5, el = idx & 31; dst[(32 * dt + dl) * 128 + 32 * et + el] = T[el * 33 + dl]; }
    __syncthreads();
}
DI void ret_out_prompt(const Args& A, const Frame& F, int bu) {
    const int c = bu >> 1, hp = bu & 1; int tid = F.tid; asm volatile("" : "+v"(tid)); const int lane = tid & 63, w = F.wave;
    LAS unsigned char* Vl = F.lds;
    __syncthreads();
#pragma unroll 1
    for (int it = 0; it < 8; ++it) { const int t = tid + 512 * it, ch = t & 15, j = (t >> 4) & 127, hl = t >> 11;
        *(LAS u32x4*)(Vl + ((hl * 128 + j) * 136 + 8 * ch) * 2) = *(const u32x4*)(F.PROJ() + (size_t)(c * 128 + j) * NIN + 1792 + (2 * hp + hl) * 128 + 8 * ch); }
    __syncthreads();
    const int hl = w >> 2, it = w & 3, head = 2 * hp + hl, n = lane & 31, h = lane >> 5, i16 = lane & 15, tq = i16 >> 2, tp = i16 & 3, blk = (lane >> 4) & 1;
    const int tok = c * 128 + 32 * it + n; const float lg = ret_log2g(head);
    bf16x8 qf[8];
#pragma unroll
    for (int s = 0; s < 8; ++s) qf[s] = *(const bf16x8*)(F.PROJ() + (size_t)tok * NIN + 768 + head * 128 + 16 * s + 8 * h);
    f32x16 acc[4];
#pragma unroll
    for (int et = 0; et < 4; ++et) { acc[et] = zero16();
#pragma unroll
        for (int s = 0; s < 8; ++s) { const bf16x8 a = *(const bf16x8*)(F.SIN() + ((size_t)(c * 4 + head) * 128 + 32 * et + n) * 128 + 16 * s + 8 * h); acc[et] = MFMA32(a, qf[s], acc[et]); } }
    const float dq = exp2f(lg * (float)(32 * it + n + 1));
#pragma unroll
    for (int et = 0; et < 4; ++et) acc[et] = acc[et] * dq;
#pragma unroll 1
    for (int jt = 0; jt <= it; ++jt) {
        f32x16 X = zero16();
#pragma unroll
        for (int s = 0; s < 8; ++s) { const bf16x8 a = *(const bf16x8*)(F.PROJ() + (size_t)(c * 128 + 32 * jt + n) * NIN + 1280 + head * 128 + 16 * s + 8 * h); X = MFMA32(a, qf[s], X); }
#pragma unroll
        for (int r = 0; r < 16; ++r) { const int dd = 32 * it + n - (32 * jt + crow(r, h)); X[r] = dd >= 0 ? X[r] * (KSC * exp2f(lg * (float)dd)) : 0.f; }
#pragma unroll
        for (int s2 = 0; s2 < 2; ++s2) { const bf16x8 pf = PACK_STEP(X, s2);
#pragma unroll
            for (int et = 0; et < 4; ++et) { const bf16x8 vfr = tr_frag(Vl + ((hl * 128 + 32 * jt + 16 * s2 + 4 * h + tq) * 136 + 32 * et + 16 * blk + 4 * tp) * 2, 8 * 136 * 2);
                acc[et] = MFMA32(vfr, pf, acc[et]); } }
    }
    float sum = 0.f;
#pragma unroll
    for (int et = 0; et < 4; ++et)
#pragma unroll
        for (int r = 0; r < 16; ++r) sum += acc[et][r];
    sum += __shfl_xor(sum, 32); const float mean = sum * (1.f / 128.f); float var = 0.f;
#pragma unroll
    for (int et = 0; et < 4; ++et)
#pragma unroll
        for (int r = 0; r < 16; ++r) { const float dlt = acc[et][r] - mean; var += dlt * dlt; }
    var += __shfl_xor(var, 32); const float rstd = rsqrtf(var * (1.f / 128.f) + EPSN);
    const bf16* gp = F.PROJ() + (size_t)tok * NIN + 2304 + head * 128; bf16* op = F.MIX() + (size_t)tok * DM + 512 + head * 128; const float* rg = A.in[I_RG] + head * 128;
#pragma unroll
    for (int et = 0; et < 4; ++et)
#pragma unroll
        for (int g4 = 0; g4 < 4; ++g4) { const int e0 = 32 * et + 8 * g4 + 4 * h; const u32x2 gw = *(const u32x2*)(gp + e0); const f32x4 rgv = *(const f32x4*)(rg + e0);
            float gv[4] = {bflo(gw.x), bfhi(gw.x), bflo(gw.y), bfhi(gw.y)}; float y[4];
#pragma unroll
            for (int i = 0; i < 4; ++i) y[i] = (acc[et][4 * g4 + i] - mean) * rstd * rgv[i] * (gv[i] * pg8::sigm(gv[i]));
            u32x2 wv; wv.x = pk2(y[0], y[1]); wv.y = pk2(y[2], y[3]); *(u32x2*)(op + e0) = wv; }
}
DI void ret_sample_unit(const Args& A, const Frame& F, int uidx) {
    const int b = uidx >> 2, head = uidx & 3; const int tid = F.tid, lane = F.lane, w = F.wave;
    LAS float* Q = (LAS float*)F.lds; LAS float* Ks = Q + 1024; LAS float* V = Ks + 1024; LAS float* INN = V + 1024; LAS float* OO = INN + 64; LAS float* O2 = OO + 1024;
    const float lg = ret_log2g(head);
    __syncthreads();
    for (int idx = tid; idx < 3072; idx += 512) { const int which = idx >> 10, i = (idx >> 7) & 7, d = idx & 127;
        const float v = bf2f(F.PROJ()[(size_t)(TP + b * 8 + i) * NIN + (which == 0 ? 768 : which == 1 ? 1280 : 1792) + head * 128 + d]);
        (which == 0 ? Q : which == 1 ? Ks : V)[i * 128 + d] = which == 1 ? v * KSC : v; }
    __syncthreads();
    if (tid < 64) { const int i = tid >> 3, j = tid & 7; float dot = 0.f;
        for (int d = 0; d < 128; ++d) dot += Q[i * 128 + d] * Ks[j * 128 + d];
        INN[tid] = j <= i ? dot * exp2f(lg * (float)(i - j)) : 0.f; }
    {
        const int e4 = (tid & 31) * 4, dg = tid >> 5; f32x4 vv[8], o2[8];
#pragma unroll
        for (int j = 0; j < 8; ++j) { vv[j] = *(const LAS f32x4*)(V + j * 128 + e4) * exp2f(lg * (float)(7 - j)); o2[j] = (f32x4){0.f, 0.f, 0.f, 0.f}; }
        const float dc = exp2f(lg * 8.f);
        const float* S0 = A.in[I_SRET] + ((size_t)(b * 4 + head) * 128) * 128; float* S1 = F.out + O_SRET + ((size_t)(b * 4 + head) * 128) * 128;
        f32x4 sv[8];
#pragma unroll
        for (int dd = 0; dd < 8; ++dd) sv[dd] = *(const f32x4*)(S0 + (dg * 8 + dd) * 128 + e4);
#pragma unroll
        for (int dd = 0; dd < 8; ++dd) { const int d = dg * 8 + dd; const f32x4 s = sv[dd]; f32x4 sn = s * dc;
#pragma unroll
            for (int j = 0; j < 8; ++j) { o2[j] += Q[j * 128 + d] * s; sn += Ks[j * 128 + d] * vv[j]; }
            *(f32x4*)(S1 + d * 128 + e4) = sn; }
#pragma unroll
        for (int i = 0; i < 8; ++i) *(LAS f32x4*)(O2 + (dg * 8 + i) * 128 + e4) = o2[i];
    }
    __syncthreads();
    { const int e = tid & 127, ig = tid >> 7;
#pragma unroll
        for (int ii = 0; ii < 2; ++ii) { const int i = 2 * ig + ii; float o = 0.f;
#pragma unroll
            for (int dg = 0; dg < 16; ++dg) o += O2[(dg * 8 + i) * 128 + e];
            o *= exp2f(lg * (float)(i + 1));
            for (int j = 0; j <= i; ++j) o += INN[i * 8 + j] * V[j * 128 + e];
            OO[i * 128 + e] = o; } }
    __syncthreads();
    { const int i = w; const float a0 = OO[i * 128 + lane], a1 = OO[i * 128 + 64 + lane];
        const float mean = wave_sum(a0 + a1) * (1.f / 128.f); const float d0 = a0 - mean, d1 = a1 - mean;
        const float rstd = rsqrtf(wave_sum(d0 * d0 + d1 * d1) * (1.f / 128.f) + EPSN);
        const int tok = TP + b * 8 + i; const bf16* gp = F.PROJ() + (size_t)tok * NIN + 2304 + head * 128; bf16* op = F.MIX() + (size_t)tok * DM + 512 + head * 128; const float* rg = A.in[I_RG] + head * 128;
        const float g0 = bf2f(gp[lane]), g1 = bf2f(gp[64 + lane]);
        op[lane] = f2bf(d0 * rstd * rg[lane] * (g0 * pg8::sigm(g0))); op[64 + lane] = f2bf(d1 * rstd * rg[64 + lane] * (g1 * pg8::sigm(g1))); }
}

template <int PASS> DI void s5_phase(const Args& A, const Frame& F) {
    const int lane = F.lane, w = F.wave; const int gw = F.bid * NWAVES + w, NGW = F.G * NWAVES;
    LAS unsigned char* L = F.lds + w * 16896;
    const float* P = (const float*)(F.ws + WS_S5P); const bf16* BBt = (const bf16*)(F.ws + WS_S5P + S5_BBT); const bf16* CCt = (const bf16*)(F.ws + WS_S5P + S5_CCT);
    const int n = lane & 31, h = lane >> 5;
    const int nunits = PASS == 1 ? 64 * 128 : 2 * 64 * 128;
#pragma unroll 1
    for (int u = gw; u < nunits; u += NGW) {
        const bool sample = u >= 8192; const int uu = sample ? u - 8192 : u; const int g = uu & 63, cb = uu >> 6;
        const int tok0 = sample ? TP + cb * 8 : cb * 128, ntok = sample ? 8 : 128;
        const float lr = P[(S5_LAM >> 2) + 2 * (g * 64 + lane)], li = P[(S5_LAM >> 2) + 2 * (g * 64 + lane) + 1];
        float hr = 0.f, hi = 0.f;
        if (PASS == 2) { if (sample) { hr = A.in[I_S5R][(size_t)(cb * 64 + g) * 64 + lane]; hi = A.in[I_S5I][(size_t)(cb * 64 + g) * 64 + lane]; }
                         else { hr = F.S5H()[(size_t)(cb * 64 + g) * 128 + lane]; hi = F.S5H()[(size_t)(cb * 64 + g) * 128 + 64 + lane]; } }
        bf16x8 bbf[4];
#pragma unroll
        for (int qt = 0; qt < 4; ++qt) bbf[qt] = *(const bf16x8*)(BBt + (size_t)(g * 128 + 32 * qt + n) * 16 + 8 * h);
        bf16x8 cfh[8];
        if (PASS == 2) {
#pragma unroll
            for (int s = 0; s < 8; ++s) cfh[s] = *(const bf16x8*)(CCt + (size_t)(g * 16 + (n & 15)) * 128 + 16 * s + 8 * h); }
        bf16x8 dfr = (bf16x8){0, 0, 0, 0, 0, 0, 0, 0};
        if (PASS == 2) { const unsigned dbf = (unsigned)f2bf(A.in[I_DSK][g * 16 + (n & 15)]); const int jd = n < 16 ? (n & 15) - 8 * h : -100;
            u32x4 dw; dw.x = (jd == 0 ? dbf : 0u) | (jd == 1 ? dbf << 16 : 0u); dw.y = (jd == 2 ? dbf : 0u) | (jd == 3 ? dbf << 16 : 0u);
            dw.z = (jd == 4 ? dbf : 0u) | (jd == 5 ? dbf << 16 : 0u); dw.w = (jd == 6 ? dbf : 0u) | (jd == 7 ? dbf << 16 : 0u);
            dfr = __builtin_bit_cast(bf16x8, dw); }
        bf16x8 a4[4];
#pragma unroll
        for (int i = 0; i < 4; ++i) { a4[i] = (bf16x8){0, 0, 0, 0, 0, 0, 0, 0}; if (32 * i + n < ntok) a4[i] = *(const bf16x8*)(F.XN() + (size_t)(tok0 + 32 * i + n) * DM + g * 16 + 8 * h); }
        asm volatile("s_waitcnt vmcnt(0)" ::: "memory");
#pragma unroll
        for (int sti = 0; sti < 4; ++sti) { if (32 * sti < ntok) {
            const int st = 32 * sti;
            const int nv = ntok - st < 32 ? ntok - st : 32;
            const bf16x8 a = a4[sti];
#pragma unroll
            for (int qt = 0; qt < 4; ++qt) { const f32x16 cc = MFMA32(a, bbf[qt], zero16());
#pragma unroll
                for (int r = 0; r < 16; ++r) *(LAS float*)(L + crow(r, h) * 528 + 4 * (32 * qt + n)) = cc[r]; }
#pragma unroll 4
            for (int t = 0; t < nv; ++t) { const float br = *(LAS float*)(L + t * 528 + 4 * lane), bi = *(LAS float*)(L + t * 528 + 256 + 4 * lane);
                const float nr = lr * hr - li * hi + br, ni = lr * hi + li * hr + bi; hr = nr; hi = ni;
                if (PASS == 2) { *(LAS unsigned short*)(L + t * 528 + 2 * lane) = f2bf(hr); *(LAS unsigned short*)(L + t * 528 + 128 + 2 * lane) = f2bf(hi); } }
            if (PASS == 2) {
                f32x16 y = MFMA32(a, dfr, zero16());
#pragma unroll
                for (int s = 0; s < 8; ++s) { const bf16x8 hs = *(const LAS bf16x8*)(L + n * 528 + 32 * s + 16 * h); y = MFMA32(hs, cfh[s], y); }
                if (n < 16) {
#pragma unroll
                    for (int r = 0; r < 16; ++r) { const int t = crow(r, h);
                        if (t < nv) { const size_t o = (size_t)(tok0 + st + t) * DM + g * 16 + n; const float yy = y[r];
                            const float z = 0.7978845608028654f * (yy + 0.044715f * yy * yy * yy); F.MIX()[o] = f2bf(yy * pg8::sigm(2.f * z)); } } }
            }
        } }
        if (PASS == 1) { F.S5E()[(size_t)(cb * 64 + g) * 128 + lane] = hr; F.S5E()[(size_t)(cb * 64 + g) * 128 + 64 + lane] = hi; }
        else { if (sample) { F.out[O_SS5R + (size_t)(cb * 64 + g) * 64 + lane] = hr; F.out[O_SS5I + (size_t)(cb * 64 + g) * 64 + lane] = hi; }
               else if (cb == 127) { F.out[O_PS5R + g * 64 + lane] = hr; F.out[O_PS5I + g * 64 + lane] = hi; } }
    }
}
DI void s5_carry_phase(const Args& A, const Frame& F) {
    const int gt = F.bid * 512 + F.tid;
    if (gt < 4096) { const int g = gt >> 6, p = gt & 63; const float* P = (const float*)(F.ws + WS_S5P);
        const float ar = P[(S5_LAM128 >> 2) + 2 * gt], ai = P[(S5_LAM128 >> 2) + 2 * gt + 1]; float Hr = 0.f, Hi = 0.f;
#pragma unroll 8
        for (int c = 0; c < 128; ++c) { const size_t o = (size_t)(c * 64 + g) * 128 + p; F.S5H()[o] = Hr; F.S5H()[o + 64] = Hi;
            const float er = F.S5E()[o], ei = F.S5E()[o + 64]; const float nr = ar * Hr - ai * Hi + er, ni = ar * Hi + ai * Hr + ei; Hr = nr; Hi = ni; } }
}

#define XB_TMO      128
#define XB_XCNT(j)  (256  + 64 * (j))
#define XB_XSUB(j)  (1280 + 64 * (j))
#define XB_XGEN(j)  (2304 + 64 * (j))
#define XB_TOP      3328
#define XB_TOPGEN   3392
#define XCD_BAR_WORDS 3456
#define XB_SPIN_CAP (1u << 18)

__device__ __forceinline__ unsigned xb_ld(unsigned* p)              { return __hip_atomic_load(p, __ATOMIC_RELAXED, __HIP_MEMORY_SCOPE_AGENT); }
__device__ __forceinline__ unsigned xb_add(unsigned* p, unsigned v) { return __hip_atomic_fetch_add(p, v, __ATOMIC_RELAXED, __HIP_MEMORY_SCOPE_AGENT); }
__device__ __forceinline__ unsigned xb_xcc_id() { return (unsigned)__builtin_amdgcn_s_getreg((3 << 11) | 20) & 0xFu; }
#define XB_SPIN(cond, bar) do { unsigned _sp = 0; while (cond) { __builtin_amdgcn_s_sleep(1); \
    if ((++_sp & 255u) == 0u) { if (xb_ld(&(bar)[XB_TMO])) break; if (_sp > XB_SPIN_CAP) { atomicAdd(&(bar)[XB_TMO], 1u); break; } } } } while (0)

struct XcdBarrier {
    unsigned* bar; unsigned x;
    volatile LAS unsigned* st;
};

__device__ __forceinline__ XcdBarrier xcd_barrier_post(unsigned* bar, volatile LAS unsigned* st) {
    XcdBarrier b; b.bar = bar; b.x = xb_xcc_id(); b.st = st;
    if (threadIdx.x == 0) (void)xb_add(&bar[XB_XCNT(b.x)], 1u);
    return b;
}
__device__ __forceinline__ void xcd_barrier_complete(unsigned* bar, unsigned x, unsigned& nloc, unsigned& nx) {
    const unsigned G = gridDim.x * gridDim.y * gridDim.z;
    unsigned sum, cnt, mine, sp = 0u;
    for (;;) {
        sum = 0u; cnt = 0u; mine = 0u;
#pragma unroll
        for (unsigned j = 0; j < 16; ++j) { const unsigned c = xb_ld(&bar[XB_XCNT(j)]); sum += c; cnt += (c > 0u) ? 1u : 0u; mine = (j == x) ? c : mine; }
        if (sum == G) break;
        __builtin_amdgcn_s_sleep(1);
        if ((++sp & 255u) == 0u) { if (xb_ld(&bar[XB_TMO])) break; if (sp > XB_SPIN_CAP) { atomicAdd(&bar[XB_TMO], 1u); break; } }
    }
    nloc = mine > 0u ? mine : 1u; nx = cnt > 0u ? cnt : 1u;
}

__device__ __forceinline__ void xcd_barrier(const XcdBarrier& b) {
    asm volatile("s_waitcnt vmcnt(0)" ::: "memory");
    __syncthreads();
    if (threadIdx.x == 0) {
        unsigned* bar = b.bar;
        __builtin_amdgcn_s_waitcnt(0);
        unsigned nloc = b.st[0], nx = b.st[1];
        if (nloc == 0u) { xcd_barrier_complete(bar, b.x, nloc, nx); b.st[0] = nloc; b.st[1] = nx; }
        const unsigned old = xb_add(&bar[XB_XSUB(b.x)], 1u);
        const unsigned gen = old / nloc;
        if (old + 1u == (gen + 1u) * nloc) {
            __builtin_amdgcn_fence(__ATOMIC_RELEASE, "agent");
            asm volatile("s_waitcnt vmcnt(0)" ::: "memory");
            const unsigned og = xb_add(&bar[XB_TOP], 1u);
            const unsigned tg = og / nx;
            if (og + 1u == (tg + 1u) * nx) xb_add(&bar[XB_TOPGEN], 1u);
            else XB_SPIN(xb_ld(&bar[XB_TOPGEN]) == tg, bar);
            __builtin_amdgcn_fence(__ATOMIC_ACQUIRE, "");
            xb_add(&bar[XB_XGEN(b.x)], 1u);
            asm volatile("s_waitcnt vmcnt(0)" ::: "memory");
        } else {
            XB_SPIN(xb_ld(&bar[XB_XGEN(b.x)]) == gen, bar);
            __builtin_amdgcn_fence(__ATOMIC_ACQUIRE, "");
            asm volatile("s_waitcnt vmcnt(0)" ::: "memory");
        }
    }
    __syncthreads();
}

constexpr int NPHASE = 17;
__global__ void __launch_bounds__(NWAVES * 64, 2) mega_fwd(Args args) {
    extern __shared__ __attribute__((aligned(16))) unsigned char lds_raw[];
    cg::grid_group grid = cg::this_grid();
    Frame F;
    F.lds = (LAS unsigned char*)lds_raw; F.tid = threadIdx.x; F.lane = F.tid & 63; F.wave = __builtin_amdgcn_readfirstlane(F.tid >> 6); F.G = gridDim.x; F.bid = blockIdx.x;
    F.out = args.out; F.ws = args.ws;
    const int lo = args.ph_lo, hi = args.ph_hi;
    volatile LAS unsigned* misc_ = (volatile LAS unsigned*)(F.lds + LDS_BYTES - 64);
    if (F.tid < 16) misc_[F.tid] = 0u;
    __syncthreads();
    const XcdBarrier xbar_ = xcd_barrier_post((unsigned*)args.ws, misc_);
    if (lo < 0) grid.sync();
#define GSYNC() xcd_barrier(xbar_)
    float* XR = F.out + O_Y;
#ifndef PHMASK
#define PHMASK 0xfffffu
#endif
#define IN(k) (((PHMASK >> (k)) & 1u) && lo <= (k) && (k) < hi)
#define SEAM(k) do { if (IN(k) && IN((k) + 1)) GSYNC(); } while (0)
#ifndef RPTMASK
#define RPTMASK 0u
#endif
#ifndef XSYNC
#define XSYNC 0
#endif
#define RPT(k) (((RPTMASK >> (k)) & 1u) ? 2 : 1)
#define RB(k) for (int rep_ = 0; rep_ < RPT(k); ++rep_) { if (rep_) GSYNC();
#define RE }
#define GEMM_SPLIT(g, E, nM_, nN_, S__) do { pg8::SplitOrder S_; S_.init(nM_, nN_, S__, F.G, (int)blockIdx.x); pg8::gemm_phase<pg8::EpiPartial, pg8::SplitOrder, true, true>(F.lds, g, S_, E); } while (0)
#define GEMM_PHASE(EPI, g, E) do { pg8::StaticOrder S_; S_.init((g).M, (g).N, F.G, (int)blockIdx.x); pg8::gemm_phase<EPI, pg8::StaticOrder, true, true>(F.lds, g, S_, E); } while (0)

    if (IN(0)) { RB(0)  p0_prologue(args, F);  RE } SEAM(0);
    if (IN(1)) { RB(1)  pg8::Gemm g{F.CA(), F.Wada_t(), 256, NMOD, 1024}; pg8::EpiF32Bias E{F.MOD(), NMOD, args.in[I_ADAB]}; GEMM_PHASE(pg8::EpiF32Bias, g, E);  RE } SEAM(1);
    if (IN(2)) { RB(2)  norm_phase(args, F, args.in[I_XP], args.in[I_XS], args.in[I_NMIX], F.MOD(), 0, 1024);  RE } SEAM(2);
    if (IN(3)) { RB(3)  pg8::Gemm g{F.XN(), F.Win_t(), MT, NIN, 1024}; pg8::EpiBf16<0> E{F.PROJ(), NIN, nullptr, 0, 0, 1.f}; GEMM_PHASE(pg8::EpiBf16<0>, g, E);  RE } SEAM(3);
    if (IN(4)) { RB(4)
#ifndef P4SEL
#define P4SEL 7
#endif
        if (P4SEL & 1) for (int u = F.bid; u < 512; u += F.G) attn_unit<false>(args, F, u);
        if (P4SEL & 2) for (int u = (F.bid + 128) % F.G; u < 128; u += F.G) attn_unit<true>(args, F, u);
        if (P4SEL & 4) for (int u = F.bid; u < 512; u += F.G) ret_kv_unit(args, F, u);
        __syncthreads();
    RE } SEAM(4);
    if (IN(5)) { RB(5)  ret_scan_phase(args, F);  RE } SEAM(5);
    if (IN(6)) { RB(6)  if (F.bid < 64) pret_transpose_tile(args, F, F.bid);
        for (int u = F.bid; u < 768; u += F.G) { if (u < 256) ret_out_prompt(args, F, u); else ret_sample_unit(args, F, u - 256); } __syncthreads();  RE } SEAM(6);
    if (IN(7)) { RB(7)  { pg8::Gemm g{F.MIX(), F.Wout_t(), TP, 1024, 1024, 0}; pg8::EpiResid E{args.in[I_XP], args.in[I_XS], XR, F.MOD() + 2048}; GEMM_PHASE(pg8::EpiResid, g, E); }
        { pg8::Gemm g{F.MIX() + (size_t)TP * DM, F.Wout_t(), TS, 1024, 256, 1024}; pg8::EpiPartial E{(bf16*)(F.ws + WS_PART0), TS, 0}; GEMM_SPLIT(g, E, 4, 4, 4); }  RE } SEAM(7);
    if (IN(8)) { RB(8)  norm_phase(args, F, XR, args.in[I_XS], args.in[I_NFFN], F.MOD(), 3072, 4096, (const bf16*)(F.ws + WS_PART0), 4, F.MOD() + 2048, XR);  RE } SEAM(8);
    if (IN(9)) { RB(9)  pg8::Gemm g{F.XN(), F.Wgu_t(0), MT, 2 * DFF, 1024}; pg8::EpiSwiGLU E{F.PROJ(), DFF}; GEMM_PHASE(pg8::EpiSwiGLU, g, E);  RE } SEAM(9);
    if (IN(10)) { RB(10)  { pg8::Gemm g{F.PROJ(), F.Wd_t(0), TP, 1024, DFF, 0}; pg8::EpiResid E{XR, XR + (size_t)TP * DM, XR, F.MOD() + 5120}; GEMM_PHASE(pg8::EpiResid, g, E); }
        { pg8::Gemm g{F.PROJ() + (size_t)TP * DFF, F.Wd_t(0), TS, 1024, 256, DFF}; pg8::EpiPartial E{F.MIX(), TS, 0}; GEMM_SPLIT(g, E, 4, 4, 11); }  RE } SEAM(10);
    if (IN(11)) { RB(11)  norm_phase(args, F, XR, XR + (size_t)TP * DM, args.in[I_NMIX] + 1024, F.MOD() + LMOD, 0, 1024, F.MIX(), 11, F.MOD() + 5120, XR);  RE } SEAM(11);
    if (IN(12)) { RB(12)  s5_phase<1>(args, F);  RE } SEAM(12);
    if (IN(13)) { RB(13)  s5_carry_phase(args, F);  RE } SEAM(13);
    if (IN(14)) { RB(14)  s5_phase<2>(args, F);  RE } SEAM(14);
    if (IN(15)) { RB(15)  { pg8::Gemm g{F.MIX(), F.Wglu_t(), TP, 2048, 1024, 0}; pg8::EpiGLUResid E{XR, F.MOD() + LMOD + 2048}; GEMM_PHASE(pg8::EpiGLUResid, g, E); }
        { pg8::Gemm g{F.MIX() + (size_t)TP * DM, F.Wglu_t(), TS, 2048, 256, 1024}; pg8::EpiPartial E{(bf16*)(F.ws + WS_PART0), TS, 2048}; GEMM_SPLIT(g, E, 4, 8, 4); }  RE } SEAM(15);
    if (IN(16)) { RB(16)  norm_phase(args, F, XR, XR + (size_t)TP * DM, args.in[I_NFFN] + 1024, F.MOD() + LMOD, 3072, 4096, nullptr, 4, F.MOD() + LMOD + 2048, XR, (const bf16*)(F.ws + WS_PART0));  RE } SEAM(16);
    if (IN(17)) { RB(17)  pg8::Gemm g{F.XN(), F.Wgu_t(1), MT, 2 * DFF, 1024}; pg8::EpiSwiGLU E{F.PROJ(), DFF}; GEMM_PHASE(pg8::EpiSwiGLU, g, E);  RE } SEAM(17);
    if (IN(18)) { { pg8::Gemm g{F.PROJ(), F.Wd_t(1), TP, 1024, DFF, 0}; pg8::EpiResid E{XR, XR + (size_t)TP * DM, XR, F.MOD() + LMOD + 5120}; GEMM_PHASE(pg8::EpiResid, g, E); }
        { pg8::Gemm g{F.PROJ() + (size_t)TP * DFF, F.Wd_t(1), TS, 1024, 256, DFF}; pg8::EpiPartial E{F.MIX(), TS, 0}; GEMM_SPLIT(g, E, 4, 4, 11); } } SEAM(18);
    if (IN(19)) {
        const int gw = F.bid * NWAVES + F.wave, NGW = F.G * NWAVES; const bf16* part = F.MIX();
        for (int m = TP + gw; m < MT; m += NGW) { const float* grow = F.MOD() + LMOD + 5120 + (size_t)pg8::seq_of_row(m) * NMOD;
#pragma unroll
            for (int j = 0; j < 4; ++j) { const int col = 4 * (64 * j + F.lane); const size_t po = (size_t)(m - TP) * 1024 + col; f32x4 ps = (f32x4){0.f, 0.f, 0.f, 0.f};
                for (int sl = 0; sl < 11; ++sl) { const u32x2 w = *(const u32x2*)(part + (size_t)sl * TS * 1024 + po); ps += (f32x4){bflo(w.x), bfhi(w.x), bflo(w.y), bfhi(w.y)}; }
                *(f32x4*)(XR + (size_t)m * DM + col) = *(const f32x4*)(XR + (size_t)m * DM + col) + *(const f32x4*)(grow + col) * ps; } }
    }
#undef IN
#undef SEAM
}

extern "C" void kernel_launch(void* const* d_in, const int* in_sizes, int n_in, void* d_out, int out_size, void* d_ws, size_t ws_size, hipStream_t stream) {
    static int grid = 0;
    if (grid == 0) {
        if (n_in != 32 || (size_t)out_size != O_END || ws_size < WS_END) { fprintf(stderr, "kernel_launch: unexpected shapes n_in %d out %d ws %zu\n", n_in, out_size, ws_size); grid = -1; return; }
        int dev = 0, cus = 0, per_cu = 0;
        hipGetDevice(&dev); hipDeviceGetAttribute(&cus, hipDeviceAttributeMultiprocessorCount, dev);
        hipFuncSetAttribute((const void*)mega_fwd, hipFuncAttributeMaxDynamicSharedMemorySize, LDS_BYTES);
        hipOccupancyMaxActiveBlocksPerMultiprocessor(&per_cu, (const void*)mega_fwd, NWAVES * 64, LDS_BYTES);
        if (per_cu < 1) { fprintf(stderr, "kernel_launch: occupancy query says %d blocks/CU\n", per_cu); per_cu = 1; }
        (void)hipGetLastError();
        grid = cus;
    }
    if (grid < 0) return;
    if (hipMemsetAsync(d_ws, 0, 65536, stream) != hipSuccess) { fprintf(stderr, "kernel_launch: memset failed\n"); return; }
    Args a{};
    for (int i = 0; i < 32; ++i) a.in[i] = (const float*)d_in[i];
    a.out = (float*)d_out; a.ws = (unsigned char*)d_ws; a.ph_lo = 0; a.ph_hi = 20;
    void* kargs[] = {&a};
    hipError_t e = hipLaunchCooperativeKernel((const void*)mega_fwd, dim3(grid), dim3(NWAVES * 64), kargs, LDS_BYTES, stream);
    if (e != hipSuccess) fprintf(stderr, "cooperative launch failed: %s (grid %d)\n", hipGetErrorString(e), grid);
}
```

```cpp
#include <hip/hip_runtime.h>
#include <hip/hip_cooperative_groups.h>
#include <cstdio>
#include <cstdint>
namespace cg = cooperative_groups;
namespace pg8 {
#define PG8_LAS __attribute__((address_space(3)))
typedef unsigned short bf16_t;
typedef short bf16x8 __attribute__((ext_vector_type(8)));
typedef float f32x4 __attribute__((ext_vector_type(4)));
typedef unsigned u32x4 __attribute__((ext_vector_type(4)));
constexpr int BM = 256, BK = 64, HALF = 128, HTB = HALF * BK * 2  , STAGE_BYTES = 8 * HTB, NXCD = 8, WGM = 8;

__host__ __device__ __forceinline__ int lds_byte(int r, int c) { const int st = (r >> 4) * 2 + (c >> 5), rr = r & 15, cc = c & 31, ob = rr * 64 + cc * 2; return st * 1024 + (ob ^ (((ob >> 9) & 1) << 5)); }
__host__ __device__ __forceinline__ void stage_rc(int b, int& R, int& C) { const int st = b / 1024, sb = b % 1024, swz = sb ^ (((sb >> 9) & 1) << 5); R = (st >> 1) * 16 + swz / 64; C = (st & 1) * 32 + (swz % 64) / 2; }
__host__ __device__ __forceinline__ int perm32(int rho) { const int n = rho >> 4, i = rho & 15; return 8 * (i >> 2) + 4 * n + (i & 3); }

struct Unit { int pm, pn, ks; };
struct Gemm { const bf16_t* A; const bf16_t* Bt; int M, N, K, ld; };

struct StaticOrder {
    int nM, nN, nwg, G, c;
    __host__ __device__ void init(int M, int N, int G_, int c_) { nM = M / BM; nN = N / BM; nwg = nM * nN; G = G_; c = c_; }
    __host__ __device__ bool next(int i, Unit& u) const {
        const long L = (long)i * G + c; if (L >= nwg) return false;
        int wgid = (int)L; { const int q = nwg / NXCD, r = nwg % NXCD, xcd = wgid % NXCD, off = wgid / NXCD; wgid = (xcd < r ? xcd * (q + 1) : r * (q + 1) + (xcd - r) * q) + off; }
        const int nig = WGM * nN, gid = wgid / nig, fm = gid * WGM, gsz = (nM - fm) < WGM ? (nM - fm) : WGM;
        u.pm = fm + ((wgid % nig) % gsz); u.pn = (wgid % nig) / gsz; u.ks = 0; return true;
    }
    __device__ __forceinline__ void a_ready(const Unit&) const {}
    __device__ __forceinline__ void done(const Unit&) const {}
};

struct SplitOrder {
    int nM, nN, nwg, G, c;
    __host__ __device__ void init(int nM_, int nN_, int S, int G_, int c_) { nM = nM_; nN = nN_; nwg = nM_ * nN_ * S; G = G_; c = c_; }
    __host__ __device__ bool next(int i, Unit& u) const { const int L = i * G + c; if (L >= nwg) return false; const int t = nM * nN, r = L % t; u.ks = L / t; u.pm = r % nM; u.pn = r / nM; return true; }
    __device__ __forceinline__ void a_ready(const Unit&) const {}
    __device__ __forceinline__ void done(const Unit&) const {}
};
__device__ __forceinline__ unsigned cvt_pk_bf16(float lo, float hi) { unsigned r; asm volatile("v_cvt_pk_bf16_f32 %0, %1, %2" : "=v"(r) : "v"(lo), "v"(hi)); return r; }
typedef float f32x2 __attribute__((ext_vector_type(2)));
__device__ __forceinline__ f32x2 gelu_pk(f32x2 v) {
    const f32x2 av = __builtin_elementwise_abs(v), d = av * 0.2316418882f + 1.0f;
    f32x2 t; t.x = __builtin_amdgcn_rcpf(d.x); t.y = __builtin_amdgcn_rcpf(d.y);
    f32x2 q = t * 0.5307027145f + (-0.7265760135f); q = q * t + 0.7107068705f; q = q * t + (-0.142248368f); q = q * t + 0.127414796f; q = q * t;
    const f32x2 s = (v * v) * (-0.72134752044f);
    f32x2 e; e.x = __builtin_amdgcn_exp2f(s.x); e.y = __builtin_amdgcn_exp2f(s.y);
    const f32x2 m = v * (q * e), r = v - m;
    f32x2 o; o.x = v.x < 0.f ? m.x : r.x; o.y = v.y < 0.f ? m.y : r.y; return o;
}

template <int ACT  > struct EpiBf16 {
    static constexpr bool PERM = true, AFTER_DRAIN = false; static_assert(ACT == 0 || ACT == 1, "EpiBf16: ACT is 0 (none) or 1 (gelu_pk)");
    bf16_t* O; int ldc; const float* bias; int split_cols; size_t split_stride; float scale0;
    __device__ __forceinline__ void operator()(const f32x4 (&acc)[2][2][4][2], const Unit& u, int wr, int wc, int fr, int fq) const {
        const int row0 = u.pm * BM + wr * 64 + fr; int colt = u.pn * BM; bf16_t* base = O;
        float sc = 1.f; if (split_cols) { const int t = colt / split_cols; base += (size_t)t * split_stride; colt -= t * split_cols; if (t == 0) sc = scale0; }
        const int col0 = colt + wc * 32 + 8 * fq, bcol0 = u.pn * BM + wc * 32 + 8 * fq;
        f32x4 bv[2][2];
#pragma unroll
        for (int bj = 0; bj < 2; ++bj)
#pragma unroll
            for (int n = 0; n < 2; ++n) bv[bj][n] = bias ? *(const f32x4*)(bias + bcol0 + bj * HALF + 4 * n) : (f32x4){0.f, 0.f, 0.f, 0.f};
#pragma unroll
        for (int ai = 0; ai < 2; ++ai)
#pragma unroll
            for (int m = 0; m < 4; ++m) { bf16_t* rowp = base + (size_t)(row0 + ai * HALF + m * 16) * ldc + col0;
#pragma unroll
                for (int bj = 0; bj < 2; ++bj) { f32x4 v0 = acc[ai][bj][m][0] + bv[bj][0], v1 = acc[ai][bj][m][1] + bv[bj][1];
                    if (ACT == 1) { f32x2 a = gelu_pk((f32x2){v0[0], v0[1]}), b = gelu_pk((f32x2){v0[2], v0[3]}), c = gelu_pk((f32x2){v1[0], v1[1]}), d = gelu_pk((f32x2){v1[2], v1[3]});
                        v0 = (f32x4){a.x, a.y, b.x, b.y}; v1 = (f32x4){c.x, c.y, d.x, d.y}; }
                    v0 = v0 * sc; v1 = v1 * sc; u32x4 w; w.x = cvt_pk_bf16(v0[0], v0[1]); w.y = cvt_pk_bf16(v0[2], v0[3]); w.z = cvt_pk_bf16(v1[0], v1[1]); w.w = cvt_pk_bf16(v1[2], v1[3]);
                    *(u32x4*)(rowp + bj * HALF) = w; } }
    }
};
constexpr int TPROMPT = 16384, NMODC = 12288;
__device__ __forceinline__ int seq_of_row(int row) { return row < TPROMPT ? 0 : 1 + ((row - TPROMPT) >> 3); }
__device__ __forceinline__ float sigm(float x) { return __builtin_amdgcn_rcpf(1.0f + __expf(-x)); }
typedef unsigned u32x2 __attribute__((ext_vector_type(2)));

struct EpiF32Bias {
    static constexpr bool PERM = false, AFTER_DRAIN = false;
    float* O; int ldc; const float* bias;
    __device__ __forceinline__ void operator()(const f32x4 (&acc)[2][2][4][2], const Unit& u, int wr, int wc, int fr, int fq) const {
        const int row0 = u.pm * BM + wr * 64 + fr, col0 = u.pn * BM + wc * 32 + 4 * fq;
#pragma unroll
        for (int bj = 0; bj < 2; ++bj)
#pragma unroll
            for (int n = 0; n < 2; ++n) { const int col = col0 + bj * HALF + n * 16; const f32x4 bv = *(const f32x4*)(bias + col);
#pragma unroll
                for (int ai = 0; ai < 2; ++ai)
#pragma unroll
                    for (int m = 0; m < 4; ++m) *(f32x4*)(O + (size_t)(row0 + ai * HALF + m * 16) * ldc + col) = acc[ai][bj][m][n] + bv; }
    }
};
struct EpiPartial {
    static constexpr bool PERM = false, AFTER_DRAIN = false;
    bf16_t* P; int rows; int ldp;
    __device__ __forceinline__ void operator()(const f32x4 (&acc)[2][2][4][2], const Unit& u, int wr, int wc, int fr, int fq) const {
        const int row0 = u.pm * BM + wr * 64 + fr, col0 = u.pn * BM + wc * 32 + 4 * fq; const int lp = ldp ? ldp : 1024; bf16_t* base = P + (size_t)u.ks * rows * lp;
#pragma unroll
        for (int ai = 0; ai < 2; ++ai)
#pragma unroll
            for (int m = 0; m < 4; ++m) { bf16_t* orow = base + (size_t)(row0 + ai * HALF + m * 16) * lp;
#pragma unroll
                for (int bj = 0; bj < 2; ++bj)
#pragma unroll
                    for (int n = 0; n < 2; ++n) { const f32x4 v = acc[ai][bj][m][n]; u32x2 w; w.x = cvt_pk_bf16(v[0], v[1]); w.y = cvt_pk_bf16(v[2], v[3]); *(u32x2*)(orow + col0 + bj * HALF + n * 16) = w; } }
    }
};
struct EpiResid {
    static constexpr bool PERM = false, AFTER_DRAIN = false;
    const float* bp; const float* bs; float* out; const float* gate;
    __device__ __forceinline__ void operator()(const f32x4 (&acc)[2][2][4][2], const Unit& u, int wr, int wc, int fr, int fq) const {
        const int row0 = u.pm * BM + wr * 64 + fr, col0 = u.pn * BM + wc * 32 + 4 * fq;
#pragma unroll
        for (int ai = 0; ai < 2; ++ai)
#pragma unroll
            for (int m = 0; m < 4; ++m) { const int row = row0 + ai * HALF + m * 16;
                const float* brow = row < TPROMPT ? bp + (size_t)row * 1024 : bs + (size_t)(row - TPROMPT) * 1024;
                const float* grow = gate + (size_t)seq_of_row(row) * NMODC; float* orow = out + (size_t)row * 1024;
#pragma unroll
                for (int bj = 0; bj < 2; ++bj)
#pragma unroll
                    for (int n = 0; n < 2; ++n) { const int col = col0 + bj * HALF + n * 16;
                        const f32x4 b = *(const f32x4*)(brow + col), g = *(const f32x4*)(grow + col);
                        *(f32x4*)(orow + col) = b + g * acc[ai][bj][m][n]; } }
    }
};
struct EpiSwiGLU {
    static constexpr bool PERM = false, AFTER_DRAIN = false;
    bf16_t* H; int ldh;
    __device__ __forceinline__ void operator()(const f32x4 (&acc)[2][2][4][2], const Unit& u, int wr, int wc, int fr, int fq) const {
        const int row0 = u.pm * BM + wr * 64 + fr, col0 = u.pn * 128 + wc * 16 + 4 * fq;
#pragma unroll
        for (int ai = 0; ai < 2; ++ai)
#pragma unroll
            for (int m = 0; m < 4; ++m) { bf16_t* rowp = H + (size_t)(row0 + ai * HALF + m * 16) * ldh + col0;
#pragma unroll
                for (int bj = 0; bj < 2; ++bj) { const f32x4 g = acc[ai][bj][m][0], uu = acc[ai][bj][m][1]; f32x4 hv;
#pragma unroll
                    for (int i = 0; i < 4; ++i) hv[i] = g[i] * sigm(g[i]) * uu[i];
                    u32x2 w; w.x = cvt_pk_bf16(hv[0], hv[1]); w.y = cvt_pk_bf16(hv[2], hv[3]);
                    *(u32x2*)(rowp + bj * 64) = w; } }
    }
};
struct EpiGLUResid {
    static constexpr bool PERM = false, AFTER_DRAIN = false;
    float* out; const float* gate;
    __device__ __forceinline__ void operator()(const f32x4 (&acc)[2][2][4][2], const Unit& u, int wr, int wc, int fr, int fq) const {
        const int row0 = u.pm * BM + wr * 64 + fr, col0 = u.pn * 128 + wc * 16 + 4 * fq;
#pragma unroll
        for (int ai = 0; ai < 2; ++ai)
#pragma unroll
            for (int m = 0; m < 4; ++m) { const int row = row0 + ai * HALF + m * 16;
                const float* grow = gate + (size_t)seq_of_row(row) * NMODC; float* orow = out + (size_t)row * 1024;
#pragma unroll
                for (int bj = 0; bj < 2; ++bj) { const int col = col0 + bj * 64; const f32x4 a = acc[ai][bj][m][0], b = acc[ai][bj][m][1];
                    const f32x4 x = *(const f32x4*)(orow + col), g = *(const f32x4*)(grow + col); f32x4 v;
#pragma unroll
                    for (int i = 0; i < 4; ++i) v[i] = x[i] + g[i] * (a[i] * sigm(b[i]));
                    *(f32x4*)(orow + col) = v; } }
    }
};
template <class Epi, class Sched, bool ALIGN_EPI = false, bool SP2 = false>
__device__ __forceinline__ void gemm_phase(PG8_LAS unsigned char* lds, const Gemm g, const Sched& S, const Epi& E) {
    const int tid = threadIdx.x, wid = __builtin_amdgcn_readfirstlane(tid >> 6), lane = tid & 63, wr = wid >> 2, wc = wid & 3, fr = lane & 15, fq = lane >> 4;
    const int K = g.K, nt = K / BK, ld = g.ld ? g.ld : g.K;
    unsigned voffA[2], voffB[2];
#pragma unroll
    for (int i = 0; i < 2; ++i) { int R, C; stage_rc(tid * 16 + i * 8192, R, C); const int Rb = Epi::PERM ? ((R & ~31) + perm32(R & 31)) : R;
        voffA[i] = (unsigned)(R * ld + C) * 2u; voffB[i] = (unsigned)(Rb * ld + C) * 2u; }
    const size_t kstep = (size_t)(BK * 2);
    const size_t hstep = (size_t)HALF * ld * 2;
    const size_t tstep = 2 * hstep;
    const unsigned ldsw = (unsigned)wid * 1024u;
    const int aoff = lds_byte(wr * 64 + fr, fq * 8), boff = lds_byte(wc * 32 + fr, fq * 8);
#define PG8_SA(b, h) (((b) * 2 + (h)) * HTB)
#define PG8_SB(b, h) ((4 + (b) * 2 + (h)) * HTB)
#define PG8_STAGE(bufoff, gbase, voff) do { _Pragma("unroll") for (int _i = 0; _i < 2; ++_i) \
        __builtin_amdgcn_global_load_lds((const unsigned*)((const char*)(gbase) + (voff)[_i]), (PG8_LAS unsigned*)(lds + (bufoff) + ldsw + _i * 8192), 16, 0, 0); } while (0)
#define PG8_LDA(dst, b, h) do { _Pragma("unroll") for (int m = 0; m < 4; ++m) _Pragma("unroll") for (int k = 0; k < 2; ++k) dst[m][k] = *(const PG8_LAS bf16x8*)(lds + PG8_SA(b, h) + aoff + m * 2048 + k * 1024); } while (0)
#define PG8_LDB(dst, b, h) do { _Pragma("unroll") for (int n = 0; n < 2; ++n) _Pragma("unroll") for (int k = 0; k < 2; ++k) dst[n][k] = *(const PG8_LAS bf16x8*)(lds + PG8_SB(b, h) + boff + n * 2048 + k * 1024); } while (0)
#define PG8_MMA(ai, bj, At, Bt) do { __builtin_amdgcn_s_setprio(1); _Pragma("unroll") for (int m = 0; m < 4; ++m) _Pragma("unroll") for (int n = 0; n < 2; ++n) _Pragma("unroll") for (int k = 0; k < 2; ++k) \
        acc[ai][bj][m][n] = __builtin_amdgcn_mfma_f32_16x16x32_bf16(Bt[n][k], At[m][k], acc[ai][bj][m][n], 0, 0, 0); __builtin_amdgcn_s_setprio(0); } while (0)
#define PG8_WAIT_V(n) asm volatile("s_waitcnt vmcnt(" #n ")" ::: "memory")
#define PG8_WAIT_L(n) asm volatile("s_waitcnt lgkmcnt(" #n ")" ::: "memory")
#define PG8_BAR __builtin_amdgcn_s_barrier()
#define PG8_SCHED __builtin_amdgcn_sched_barrier(0)
    Unit cur, nxt; int ui = 0;
    if (!S.next(0, cur)) return;
    f32x4 acc[2][2][4][2];
#pragma unroll
    for (int a = 0; a < 2; ++a)
#pragma unroll
        for (int b = 0; b < 2; ++b)
#pragma unroll
            for (int m = 0; m < 4; ++m)
#pragma unroll
                for (int n = 0; n < 2; ++n) acc[a][b][m][n] = (f32x4){0.f, 0.f, 0.f, 0.f};
    bf16x8 At[4][2], B0[2][2], B1[2][2];
    const char* cA = (const char*)g.A + (size_t)cur.pm * tstep + (size_t)cur.ks * K * 2; const char* cB = (const char*)g.Bt + (size_t)cur.pn * tstep + (size_t)cur.ks * K * 2;
    S.a_ready(cur);
    if constexpr (SP2) {
        PG8_STAGE(PG8_SB(0, 0), cB, voffB); PG8_STAGE(PG8_SB(0, 1), cB + hstep, voffB); PG8_STAGE(PG8_SA(0, 0), cA, voffA); PG8_STAGE(PG8_SA(0, 1), cA + hstep, voffA);
        if (wr == 1) PG8_BAR;
        PG8_WAIT_V(2); PG8_BAR;
        PG8_STAGE(PG8_SB(1, 0), cB + kstep, voffB); PG8_STAGE(PG8_SA(1, 0), cA + kstep, voffA); PG8_STAGE(PG8_SB(1, 1), cB + hstep + kstep, voffB);
        PG8_WAIT_V(6); PG8_BAR;
    } else {
        PG8_STAGE(PG8_SB(0, 0), cB, voffB); PG8_STAGE(PG8_SA(0, 0), cA, voffA); PG8_STAGE(PG8_SB(0, 1), cB + hstep, voffB); PG8_STAGE(PG8_SA(0, 1), cA + hstep, voffA);
        if (wr == 1) PG8_BAR;
        PG8_WAIT_V(4); PG8_BAR;
        PG8_STAGE(PG8_SB(1, 0), cB + kstep, voffB); PG8_STAGE(PG8_SA(1, 0), cA + kstep, voffA); PG8_STAGE(PG8_SB(1, 1), cB + hstep + kstep, voffB);
        PG8_WAIT_V(6); PG8_BAR;
    }
    for (;;) {
        const bool has_next = S.next(ui + 1, nxt);
        const char* nA = has_next ? (const char*)g.A + (size_t)nxt.pm * tstep + (size_t)nxt.ks * K * 2 : cA; const char* nB = has_next ? (const char*)g.Bt + (size_t)nxt.pn * tstep + (size_t)nxt.ks * K * 2 : cB;
        for (int t = 0; t < nt; t += 2) {
            const bool last = (t == nt - 2);
            const char* a1 = cA + (size_t)(t + 1) * kstep;
            const char* a2 = last ? nA : cA + (size_t)(t + 2) * kstep; const char* b2 = last ? nB : cB + (size_t)(t + 2) * kstep;
            const char* a3 = a2 + kstep; const char* b3 = b2 + kstep;
            if (last && has_next) S.a_ready(nxt);
            if constexpr (SP2) {
            PG8_LDB(B0, 0, 0); PG8_LDB(B1, 0, 1); PG8_SCHED; PG8_LDA(At, 0, 0); PG8_STAGE(PG8_SA(1, 1), a1 + hstep, voffA);
            PG8_WAIT_V(8); PG8_WAIT_L(0); PG8_BAR; PG8_MMA(0, 0, At, B0); PG8_MMA(0, 1, At, B1); PG8_BAR; PG8_SCHED;
            PG8_LDA(At, 0, 1); PG8_STAGE(PG8_SB(0, 0), b2, voffB); PG8_STAGE(PG8_SB(0, 1), b2 + hstep, voffB); PG8_STAGE(PG8_SA(0, 0), a2, voffA);
            PG8_WAIT_V(8); PG8_WAIT_L(0); PG8_BAR; PG8_MMA(1, 0, At, B0); PG8_MMA(1, 1, At, B1); PG8_BAR; PG8_SCHED;
            PG8_LDB(B0, 1, 0); PG8_LDB(B1, 1, 1); PG8_SCHED; PG8_LDA(At, 1, 0); PG8_STAGE(PG8_SA(0, 1), a2 + hstep, voffA);
            PG8_WAIT_V(8); PG8_WAIT_L(0); PG8_BAR; PG8_MMA(0, 0, At, B0); PG8_MMA(0, 1, At, B1); PG8_BAR; PG8_SCHED;
            PG8_LDA(At, 1, 1); PG8_STAGE(PG8_SB(1, 0), b3, voffB); PG8_STAGE(PG8_SB(1, 1), b3 + hstep, voffB); PG8_STAGE(PG8_SA(1, 0), a3, voffA);
            PG8_WAIT_V(8); PG8_WAIT_L(0); PG8_BAR; PG8_MMA(1, 0, At, B0); PG8_MMA(1, 1, At, B1); PG8_BAR; PG8_SCHED;
            } else {
            PG8_LDB(B0, 0, 0); PG8_SCHED; PG8_LDA(At, 0, 0); PG8_STAGE(PG8_SA(1, 1), a1 + hstep, voffA);
            PG8_WAIT_L(8); PG8_BAR; PG8_WAIT_L(0); PG8_MMA(0, 0, At, B0); PG8_BAR; PG8_SCHED;
            PG8_LDB(B1, 0, 1); PG8_STAGE(PG8_SB(0, 0), b2, voffB);
            PG8_BAR; PG8_WAIT_L(0); PG8_MMA(0, 1, At, B1); PG8_BAR;
            PG8_LDA(At, 0, 1); PG8_STAGE(PG8_SA(0, 0), a2, voffA);
            PG8_BAR; PG8_WAIT_L(0); PG8_MMA(1, 0, At, B0); PG8_BAR; PG8_SCHED;
            PG8_STAGE(PG8_SB(0, 1), b2 + hstep, voffB);
            PG8_WAIT_V(6); PG8_BAR; PG8_MMA(1, 1, At, B1); PG8_BAR;
            PG8_LDB(B0, 1, 0); PG8_SCHED; PG8_LDA(At, 1, 0); PG8_STAGE(PG8_SA(0, 1), a2 + hstep, voffA);
            PG8_WAIT_L(8); PG8_BAR; PG8_WAIT_L(0); PG8_MMA(0, 0, At, B0); PG8_BAR; PG8_SCHED;
            PG8_LDB(B1, 1, 1); PG8_STAGE(PG8_SB(1, 0), b3, voffB);
            PG8_BAR; PG8_WAIT_L(0); PG8_MMA(0, 1, At, B1); PG8_BAR;
            PG8_LDA(At, 1, 1); PG8_STAGE(PG8_SA(1, 0), a3, voffA);
            PG8_BAR; PG8_WAIT_L(0); PG8_MMA(1, 0, At, B0); PG8_BAR; PG8_SCHED;
            PG8_STAGE(PG8_SB(1, 1), b3 + hstep, voffB);
            PG8_WAIT_V(6); PG8_BAR; PG8_MMA(1, 1, At, B1); PG8_BAR;
            }
        }
        if constexpr (ALIGN_EPI) { if (wr == 0) PG8_BAR; }
        if constexpr (!Epi::AFTER_DRAIN) { E(acc, cur, wr, wc, fr, fq); S.done(cur); }
        if (!has_next) break;
#pragma unroll
        for (int a = 0; a < 2; ++a)
#pragma unroll
            for (int b = 0; b < 2; ++b)
#pragma unroll
                for (int m = 0; m < 4; ++m)
#pragma unroll
                    for (int n = 0; n < 2; ++n) acc[a][b][m][n] = (f32x4){0.f, 0.f, 0.f, 0.f};
        cur = nxt; cA = nA; cB = nB; ++ui;
        if constexpr (ALIGN_EPI) { if (wr == 1) PG8_BAR; }
    }
    PG8_WAIT_V(0);
    if constexpr (!ALIGN_EPI) { if (wr == 0) PG8_BAR; }
    PG8_BAR;
    if constexpr (Epi::AFTER_DRAIN) { E.fused(acc, cur, wr, wc, fr, fq, lds, wid, lane); S.done(cur); }
#undef PG8_SA
#undef PG8_SB
#undef PG8_STAGE
#undef PG8_LDA
#undef PG8_LDB
#undef PG8_MMA
#undef PG8_WAIT_V
#undef PG8_WAIT_L
#undef PG8_BAR
#undef PG8_SCHED
}
}

constexpr int TP = 16384, TS = 1024, MT = TP + TS, DM = 1024, NBATCH = 128;
constexpr int NIN = 2816, DFF = 2816, NMOD = 12288, LMOD = 6144;
constexpr float EPSN = 1e-6f, LOG2E = 1.4426950408889634f;
constexpr int NWAVES = 8;
constexpr size_t O_Y = 0, O_PK = (size_t)MT * DM, O_PV = O_PK + 16384, O_PRET = O_PV + 16384, O_PS5R = O_PRET + 65536, O_PS5I = O_PS5R + 4096,
                 O_SK = O_PS5I + 4096, O_SV = O_SK + 2097152, O_SRET = O_SV + 2097152, O_SS5R = O_SRET + 8388608, O_SS5I = O_SS5R + 524288, O_END = O_SS5I + 524288;
constexpr size_t MiB = 1u << 20;
constexpr size_t WS_CA = 1 * MiB, WS_MOD = 2 * MiB, WS_S5P = 14 * MiB, WS_WIN = 16 * MiB, WS_WOUT = 22 * MiB, WS_WGU0 = 24 * MiB, WS_WGU1 = 35 * MiB,
                 WS_WD0 = 46 * MiB, WS_WD1 = 52 * MiB, WS_WGLU = 58 * MiB, WS_XN = 62 * MiB, WS_RKV = 62 * MiB, WS_MIX = 96 * MiB, WS_PROJ = 130 * MiB,
                 WS_WADA = 130 * MiB, WS_S5E = 130 * MiB, WS_S5H = 134 * MiB, WS_SIN = 224 * MiB, WS_PART0 = 240 * MiB, WS_PART1 = 248 * MiB, WS_END = 256 * MiB;
constexpr size_t S5_LAM = 0, S5_LAM128 = 32768, S5_BBT = 65536, S5_CCT = 65536 + 262144;
constexpr int LDS_BYTES = 147456;

#define LAS __attribute__((address_space(3)))
typedef unsigned short bf16;
typedef unsigned u32x4 __attribute__((ext_vector_type(4)));
typedef unsigned u32x2 __attribute__((ext_vector_type(2)));
typedef float f32x4 __attribute__((ext_vector_type(4)));
typedef float f32x2 __attribute__((ext_vector_type(2)));
typedef float f32x16 __attribute__((ext_vector_type(16)));
typedef short bf16x8 __attribute__((ext_vector_type(8)));
typedef short s16x4 __attribute__((ext_vector_type(4)));
typedef short v4i16_t __attribute__((ext_vector_type(4)));
typedef __bf16 bf16x2_t __attribute__((ext_vector_type(2)));
#define DI __device__ __forceinline__
#define MFMA32(a, b, c) __builtin_amdgcn_mfma_f32_32x32x16_bf16((a), (b), (c), 0, 0, 0)
DI unsigned pk2(float lo, float hi) { f32x2 v = {lo, hi}; bf16x2_t b = __builtin_convertvector(v, bf16x2_t); return __builtin_bit_cast(unsigned, b); }
DI unsigned short f2bf(float f) { return (unsigned short)(pk2(f, 0.f) & 0xffffu); }
DI float bflo(unsigned w) { return __uint_as_float(w << 16); }
DI float bfhi(unsigned w) { return __uint_as_float(w & 0xffff0000u); }
DI float bf2f(unsigned short b) { return __uint_as_float((unsigned)b << 16); }
DI int crow(int r, int h) { return (r & 3) + 8 * (r >> 2) + 4 * h; }
DI float wave_sum(float v) {
#pragma unroll
    for (int o = 1; o < 64; o <<= 1) v += __shfl_xor(v, o);
    return v;
}
DI s16x4 tr_read(const LAS unsigned char* p) { return __builtin_bit_cast(s16x4, __builtin_amdgcn_ds_read_tr16_b64_v4i16((LAS v4i16_t*)p)); }
DI bf16x8 tr_frag(const LAS unsigned char* lo, int hi_off) { const s16x4 a = tr_read(lo), b = tr_read(lo + hi_off); return __builtin_shufflevector(a, b, 0, 1, 2, 3, 4, 5, 6, 7); }
DI bf16x8 pack8(float a0, float a1, float a2, float a3, float a4, float a5, float a6, float a7) {
    u32x4 p; p.x = pk2(a0, a1); p.y = pk2(a2, a3); p.z = pk2(a4, a5); p.w = pk2(a6, a7); return __builtin_bit_cast(bf16x8, p);
}
#define PACK_STEP(x, s) pack8((x)[8 * (s)], (x)[8 * (s) + 1], (x)[8 * (s) + 2], (x)[8 * (s) + 3], (x)[8 * (s) + 4], (x)[8 * (s) + 5], (x)[8 * (s) + 6], (x)[8 * (s) + 7])
DI f32x16 zero16() { f32x16 z;
#pragma unroll
    for (int i = 0; i < 16; ++i) z[i] = 0.f; return z; }
DI void unpack8(const u32x4 w, float* f) { f[0] = bflo(w.x); f[1] = bfhi(w.x); f[2] = bflo(w.y); f[3] = bfhi(w.y); f[4] = bflo(w.z); f[5] = bfhi(w.z); f[6] = bflo(w.w); f[7] = bfhi(w.w); }

struct Args { const float* in[32]; float* out; unsigned char* ws; int ph_lo, ph_hi; };
struct Frame {
    LAS unsigned char* lds; int tid, lane, wave, G, bid;
    float* out; unsigned char* ws;
    DI bf16* CA() const { return (bf16*)(ws + WS_CA); }
    DI bf16* Win_t() const { return (bf16*)(ws + WS_WIN); }
    DI bf16* Wout_t() const { return (bf16*)(ws + WS_WOUT); }
    DI bf16* Wgu_t(int l) const { return (bf16*)(ws + (l ? WS_WGU1 : WS_WGU0)); }
    DI bf16* Wd_t(int l) const { return (bf16*)(ws + (l ? WS_WD1 : WS_WD0)); }
    DI bf16* Wglu_t() const { return (bf16*)(ws + WS_WGLU); }
    DI bf16* Wada_t() const { return (bf16*)(ws + WS_WADA); }
    DI bf16* XN() const { return (bf16*)(ws + WS_XN); }
    DI bf16* MIX() const { return (bf16*)(ws + WS_MIX); }
    DI bf16* PROJ() const { return (bf16*)(ws + WS_PROJ); }
    DI bf16* SIN() const { return (bf16*)(ws + WS_SIN); }
    DI float* MOD() const { return (float*)(ws + WS_MOD); }
    DI float* RKV() const { return (float*)(ws + WS_RKV); }
    DI float* S5E() const { return (float*)(ws + WS_S5E); }
    DI float* S5H() const { return (float*)(ws + WS_S5H); }
};
enum { I_XP = 0, I_XS, I_CK, I_CV, I_SRET, I_S5R, I_S5I, I_CP, I_CS, I_ADAW, I_ADAB, I_NMIX, I_NFFN, I_WG, I_WU, I_WD, I_WIN, I_QG, I_KG, I_SINK, I_RG, I_WOUT,
       I_ARE, I_AIM, I_LDT, I_BRE, I_BIM, I_CRE, I_CIM, I_DSK, I_GLA, I_GLB };

DI void transpose_item(const float* W, int K, int N, bf16* WT, int rs, int ro, LAS float* scr, int item, int lane) {
    const int nblk = N / 32, kb = item / nblk, nb = item % nblk, k0 = 64 * kb, n0 = 32 * nb;
#pragma unroll 8
    for (int i = 0; i < 32; ++i) { const int kk = 2 * i + (lane >> 5); scr[kk * 33 + (lane & 31)] = W[(size_t)(k0 + kk) * N + n0 + (lane & 31)]; }
    asm volatile("s_waitcnt lgkmcnt(0)" ::: "memory");
    const int c = lane & 7;
#pragma unroll
    for (int j = 0; j < 4; ++j) { const int n = (lane >> 3) + 8 * j; const LAS float* s = scr + (8 * c) * 33 + n;
        u32x4 o; o.x = pk2(s[0 * 33], s[1 * 33]); o.y = pk2(s[2 * 33], s[3 * 33]); o.z = pk2(s[4 * 33], s[5 * 33]); o.w = pk2(s[6 * 33], s[7 * 33]);
        const int nn = n0 + n, drow = (nn >> 4) * rs + (nn & 15) + ro;
        *(u32x4*)(WT + (size_t)drow * K + k0 + 8 * c) = o; }
    asm volatile("s_waitcnt lgkmcnt(0)" ::: "memory");
}
DI void p0_prologue(const Args& A, const Frame& F) {
    LAS float* scr = (LAS float*)(F.lds + F.wave * 16384);
    const int gw = F.bid * NWAVES + F.wave, NGW = F.G * NWAVES;
    constexpr int I_A = 16 * 88, I_B = 16 * 32, I_C = 44 * 32, I_E = 16 * 192;
    constexpr int NITEMS = I_A + I_B + 4 * I_A + 2 * I_C + 2 * I_B + 2 * I_E;
    for (int it = gw; it < NITEMS; it += NGW) {
        int r = it;
        if (r < I_A) { transpose_item(A.in[I_WIN], 1024, NIN, F.Win_t(), 16, 0, scr, r, F.lane); continue; } r -= I_A;
        if (r < I_B) { transpose_item(A.in[I_WOUT], 1024, 1024, F.Wout_t(), 16, 0, scr, r, F.lane); continue; } r -= I_B;
        if (r < 4 * I_A) { const int which = r / I_A, rr = r % I_A, l = which >> 1, up = which & 1;
            transpose_item(A.in[up ? I_WU : I_WG] + (size_t)l * 1024 * DFF, 1024, DFF, F.Wgu_t(l), 32, up * 16, scr, rr, F.lane); continue; } r -= 4 * I_A;
        if (r < 2 * I_C) { const int l = r / I_C, rr = r % I_C; transpose_item(A.in[I_WD] + (size_t)l * DFF * 1024, DFF, 1024, F.Wd_t(l), 16, 0, scr, rr, F.lane); continue; } r -= 2 * I_C;
        if (r < 2 * I_B) { const int b = r / I_B, rr = r % I_B; transpose_item(A.in[b ? I_GLB : I_GLA], 1024, 1024, F.Wglu_t(), 32, b * 16, scr, rr, F.lane); continue; } r -= 2 * I_B;
        { const int l = r / I_E, rr = r % I_E; transpose_item(A.in[I_ADAW] + (size_t)l * 1024 * LMOD, 1024, LMOD, F.Wada_t(), 16, l * LMOD, scr, rr, F.lane); }
    }
    const int gt = F.bid * 512 + F.tid, NGT = F.G * 512;
    for (int idx = gt; idx < 256 * 1024; idx += NGT) { const int row = idx >> 10, col = idx & 1023;
        float v = 0.f; if (row == 0) v = A.in[I_CP][col]; else if (row <= NBATCH) v = A.in[I_CS][(row - 1) * 1024 + col];
        F.CA()[idx] = f2bf(v * pg8::sigm(v)); }
    if (gt < 65536) {
        const int gp = gt >> 4, i = gt & 15, g = gp >> 6, p = gp & 63;
        const float are = A.in[I_ARE][gp], aim = A.in[I_AIM][gp], dt = expf(A.in[I_LDT][g]);
        const float a = are * dt, b = aim * dt; const float mag = expf(a), cb = cosf(b), sb = sinf(b), sh = sinf(0.5f * b);
        const float lr = mag * cb, li = mag * sb;
        const float nr = expm1f(a) * cb - 2.f * sh * sh, ni = li;
        const float den = are * are + aim * aim; const float fr = (nr * are + ni * aim) / den, fi = (ni * are - nr * aim) / den;
        bf16* BBt = (bf16*)(F.ws + WS_S5P + S5_BBT); bf16* CCt = (bf16*)(F.ws + WS_S5P + S5_CCT);
        const float br = A.in[I_BRE][gt], bi = A.in[I_BIM][gt];
        BBt[(g * 128 + p) * 16 + i] = f2bf(fr * br - fi * bi); BBt[(g * 128 + 64 + p) * 16 + i] = f2bf(fr * bi + fi * br);
        { const int go = gt >> 6, pp = gt & 63;
          CCt[go * 128 + pp] = f2bf(A.in[I_CRE][go * 64 + pp]); CCt[go * 128 + 64 + pp] = f2bf(-A.in[I_CIM][go * 64 + pp]); }
        if (i == 0) {
            float* P = (float*)(F.ws + WS_S5P);
            P[(S5_LAM >> 2) + 2 * gp] = lr; P[(S5_LAM >> 2) + 2 * gp + 1] = li;
            float pr = lr, pi = li;
#pragma unroll
            for (int k = 0; k < 7; ++k) { const float t = pr * pr - pi * pi; pi = 2.f * pr * pi; pr = t; }
            P[(S5_LAM128 >> 2) + 2 * gp] = pr; P[(S5_LAM128 >> 2) + 2 * gp + 1] = pi;
        }
    }
}

DI void norm_phase(const Args& A, const Frame& F, const float* xp, const float* xs, const float* gamma, const float* mod, int sh_off, int sc_off, const bf16* part = nullptr, int ns = 0, const float* pgate = nullptr, float* xw = nullptr, const bf16* gpart = nullptr) {
    const int gw = F.bid * NWAVES + F.wave, NGW = F.G * NWAVES;
    for (int m = gw; m < MT; m += NGW) {
        const float* xrow = m < TP ? xp + (size_t)m * DM : xs + (size_t)(m - TP) * DM;
        const float* mrow = mod + (size_t)pg8::seq_of_row(m) * NMOD;
        f32x4 v[4]; float ss = 0.f;
#pragma unroll
        for (int j = 0; j < 4; ++j) { v[j] = *(const f32x4*)(xrow + 4 * (64 * j + F.lane));
            if (part && m >= TP) { const int col = 4 * (64 * j + F.lane); const size_t po = (size_t)(m - TP) * 1024 + col;
                const f32x4 g = *(const f32x4*)(pgate + (size_t)pg8::seq_of_row(m) * NMOD + col); f32x4 ps = (f32x4){0.f, 0.f, 0.f, 0.f};
                for (int sl = 0; sl < ns; ++sl) { const u32x2 w = *(const u32x2*)(part + (size_t)sl * TS * 1024 + po); ps += (f32x4){bflo(w.x), bfhi(w.x), bflo(w.y), bfhi(w.y)}; }
                v[j] = v[j] + g * ps; *(f32x4*)(xw + (size_t)m * DM + col) = v[j]; }
            if (gpart && m >= TP) { const int col = 4 * (64 * j + F.lane); const size_t po = (size_t)(m - TP) * 2048 + (col >> 4) * 32 + (col & 15);
                const f32x4 g = *(const f32x4*)(pgate + (size_t)pg8::seq_of_row(m) * NMOD + col); f32x4 pa = (f32x4){0.f, 0.f, 0.f, 0.f}, pb = pa;
                for (int sl = 0; sl < ns; ++sl) { const u32x2 wa = *(const u32x2*)(gpart + (size_t)sl * TS * 2048 + po), wb = *(const u32x2*)(gpart + (size_t)sl * TS * 2048 + po + 16);
                    pa += (f32x4){bflo(wa.x), bfhi(wa.x), bflo(wa.y), bfhi(wa.y)}; pb += (f32x4){bflo(wb.x), bfhi(wb.x), bflo(wb.y), bfhi(wb.y)}; }
                f32x4 gl; gl.x = pa.x * pg8::sigm(pb.x); gl.y = pa.y * pg8::sigm(pb.y); gl.z = pa.z * pg8::sigm(pb.z); gl.w = pa.w * pg8::sigm(pb.w);
                v[j] = v[j] + g * gl; *(f32x4*)(xw + (size_t)m * DM + col) = v[j]; }
            ss += (v[j].x * v[j].x + v[j].y * v[j].y) + (v[j].z * v[j].z + v[j].w * v[j].w); }
        const float rstd = rsqrtf(wave_sum(ss) * (1.f / DM) + EPSN);
#pragma unroll
        for (int j = 0; j < 4; ++j) { const int col = 4 * (64 * j + F.lane);
            const f32x4 g = *(const f32x4*)(gamma + col), sc = *(const f32x4*)(mrow + sc_off + col), sh = *(const f32x4*)(mrow + sh_off + col);
            const f32x4 y = v[j] * rstd * g * (1.f + sc) + sh;
            u32x2 w; w.x = pk2(y.x, y.y); w.y = pk2(y.z, y.w); *(u32x2*)(F.XN() + (size_t)m * DM + col) = w; }
    }
}

template <bool SAMPLE> DI void attn_unit(const Args& A, const Frame& F, int uidx) {
    LAS unsigned char* Kl = F.lds; LAS unsigned char* Vl = F.lds + 46080;
    int tid = F.tid; asm volatile("" : "+v"(tid)); const int lane = tid & 63, w = F.wave;
    const int q0 = SAMPLE ? 0 : 32 * uidx, b = uidx;
    const float* kgain = A.in[I_KG];
    __syncthreads();
#pragma unroll
    for (int it = 0; it < 5; ++it) {
        const int t = tid + 512 * it, ch = t & 7, rr = t >> 3, kv = rr >= 160 ? 1 : 0, kk = rr - 160 * kv;
        float kf[8], vf[8]; bool valid = true, donorm = true; int tok = 0;
        if (SAMPLE) {
            if (kk < 128) { donorm = false; const size_t o = ((size_t)(b * 128 + kk) * 2 + kv) * 64 + 8 * ch;
                const f32x4 k0 = *(const f32x4*)(A.in[I_CK] + o), k1 = *(const f32x4*)(A.in[I_CK] + o + 4), v0 = *(const f32x4*)(A.in[I_CV] + o), v1 = *(const f32x4*)(A.in[I_CV] + o + 4);
                kf[0] = k0.x; kf[1] = k0.y; kf[2] = k0.z; kf[3] = k0.w; kf[4] = k1.x; kf[5] = k1.y; kf[6] = k1.z; kf[7] = k1.w;
                vf[0] = v0.x; vf[1] = v0.y; vf[2] = v0.z; vf[3] = v0.w; vf[4] = v1.x; vf[5] = v1.y; vf[6] = v1.z; vf[7] = v1.w; }
            else { valid = kk < 136; tok = TP + b * 8 + ((kk - 128) & 7); }
        } else { tok = q0 - 128 + kk; valid = tok >= 0; if (!valid) tok = 0; }
        if (!SAMPLE || kk >= 128) {
            const bf16* src = F.PROJ() + (size_t)tok * NIN + 512 + kv * 64 + 8 * ch;
            const u32x4 kw = *(const u32x4*)src, vw = *(const u32x4*)(src + 128);
            unpack8(kw, kf); unpack8(vw, vf);
        }
        float ss = 0.f;
#pragma unroll
        for (int j = 0; j < 8; ++j) ss += kf[j] * kf[j];
        ss += __shfl_xor(ss, 1); ss += __shfl_xor(ss, 2); ss += __shfl_xor(ss, 4);
        const float rstd = rsqrtf(ss * (1.f / 64.f) + EPSN);
#pragma unroll
        for (int j = 0; j < 8; ++j) { if (donorm) kf[j] = kf[j] * rstd * kgain[8 * ch + j]; if (!valid) { kf[j] = 0.f; vf[j] = 0.f; } }
        const int lo = ((kv * 160 + kk) * 72 + 8 * ch) * 2;
        *(LAS u32x4*)(Kl + lo) = (u32x4){pk2(kf[0], kf[1]), pk2(kf[2], kf[3]), pk2(kf[4], kf[5]), pk2(kf[6], kf[7])};
        *(LAS u32x4*)(Vl + lo) = (u32x4){pk2(vf[0], vf[1]), pk2(vf[2], vf[3]), pk2(vf[4], vf[5]), pk2(vf[6], vf[7])};
        float* ok = nullptr; float* ov = nullptr;
        if (SAMPLE) { if (kk >= 8 && kk < 136) { const size_t o = ((size_t)(b * 128 + kk - 8) * 2 + kv) * 64 + 8 * ch; ok = F.out + O_SK + o; ov = F.out + O_SV + o; } }
        else { if (q0 == TP - 32 && kk >= 32) { const size_t o = ((size_t)(kk - 32) * 2 + kv) * 64 + 8 * ch; ok = F.out + O_PK + o; ov = F.out + O_PV + o; } }
        if (ok) { *(f32x4*)ok = (f32x4){kf[0], kf[1], kf[2], kf[3]}; *(f32x4*)(ok + 4) = (f32x4){kf[4], kf[5], kf[6], kf[7]};
                  *(f32x4*)ov = (f32x4){vf[0], vf[1], vf[2], vf[3]}; *(f32x4*)(ov + 4) = (f32x4){vf[4], vf[5], vf[6], vf[7]}; }
    }
    const int n = lane & 31, h = lane >> 5, hh = w, kvh = hh >> 2;
    const int qtok = SAMPLE ? TP + b * 8 + (n & 7) : q0 + n;
    bf16x8 qf[4];
    {
        const bf16* qp = F.PROJ() + (size_t)qtok * NIN + hh * 64 + 8 * h; float qv[4][8]; float ss = 0.f;
#pragma unroll
        for (int s = 0; s < 4; ++s) { const u32x4 raw = *(const u32x4*)(qp + 16 * s); unpack8(raw, qv[s]);
#pragma unroll
            for (int j = 0; j < 8; ++j) ss += qv[s][j] * qv[s][j]; }
        ss += __shfl_xor(ss, 32);
        const float rstd = rsqrtf(ss * (1.f / 64.f) + EPSN) * (0.125f * LOG2E);
        const float* qg = A.in[I_QG];
#pragma unroll
        for (int s = 0; s < 4; ++s) { float t[8];
#pragma unroll
            for (int j = 0; j < 8; ++j) t[j] = qv[s][j] * rstd * qg[16 * s + 8 * h + j];
            qf[s] = pack8(t[0], t[1], t[2], t[3], t[4], t[5], t[6], t[7]); }
    }
    __syncthreads();
    f32x16 S[5];
#pragma unroll
    for (int kt = 0; kt < 5; ++kt) { S[kt] = zero16();
#pragma unroll
        for (int s = 0; s < 4; ++s) { const bf16x8 a = *(const LAS bf16x8*)(Kl + ((kvh * 160 + 32 * kt + n) * 72 + 16 * s + 8 * h) * 2); S[kt] = MFMA32(a, qf[s], S[kt]); } __builtin_amdgcn_sched_barrier(0); }
    const float slope2 = exp2f(-(float)(hh + 1)) * LOG2E, sink2 = A.in[I_SINK][hh] * LOG2E;
    float mx = -1e30f;
#pragma unroll
    for (int kt = 0; kt < 5; ++kt)
#pragma unroll
        for (int r = 0; r < 16; ++r) { const int kidx = 32 * kt + crow(r, h), dist = 128 + n - kidx;
            const bool okk = dist >= 0 && dist < 128 && (SAMPLE || q0 - 128 + kidx >= 0);
            const float v = okk ? S[kt][r] - slope2 * (float)dist : -1e30f; S[kt][r] = v; mx = fmaxf(mx, v); }
    mx = fmaxf(mx, __shfl_xor(mx, 32)); mx = fmaxf(mx, sink2);
    float sum = 0.f;
    bf16x8 pfs[5][2];
#pragma unroll
    for (int kt = 0; kt < 5; ++kt)
#pragma unroll
        for (int s2 = 0; s2 < 2; ++s2) { float p[8];
#pragma unroll
            for (int j = 0; j < 8; ++j) { p[j] = exp2f(S[kt][8 * s2 + j] - mx); sum += p[j]; }
            pfs[kt][s2] = pack8(p[0], p[1], p[2], p[3], p[4], p[5], p[6], p[7]); }
    sum += __shfl_xor(sum, 32);
    const float inv = 1.f / (sum + exp2f(sink2 - mx));
    __builtin_amdgcn_sched_barrier(0);
    f32x16 O[2]; O[0] = zero16(); O[1] = zero16();
    const int i16 = lane & 15, tq = i16 >> 2, tp = i16 & 3, blk = (lane >> 4) & 1;
    const LAS unsigned char* vbase = Vl + ((kvh * 160 + 4 * h + tq) * 72 + 16 * blk + 4 * tp) * 2;
#pragma unroll
    for (int kt = 0; kt < 5; ++kt) {
#pragma unroll
        for (int s2 = 0; s2 < 2; ++s2) {
#pragma unroll
            for (int dt = 0; dt < 2; ++dt) { const bf16x8 vfr = tr_frag(vbase + ((32 * kt + 16 * s2) * 72 + 32 * dt) * 2, 8 * 72 * 2);
                O[dt] = MFMA32(vfr, pfs[kt][s2], O[dt]); } }
        __builtin_amdgcn_sched_barrier(0); }
    if (!SAMPLE || n < 8) {
        bf16* op = F.MIX() + (size_t)qtok * DM + hh * 64;
#pragma unroll
        for (int dt = 0; dt < 2; ++dt)
#pragma unroll
            for (int g4 = 0; g4 < 4; ++g4) { u32x2 wv; wv.x = pk2(O[dt][4 * g4] * inv, O[dt][4 * g4 + 1] * inv); wv.y = pk2(O[dt][4 * g4 + 2] * inv, O[dt][4 * g4 + 3] * inv);
                *(u32x2*)(op + 32 * dt + 8 * g4 + 4 * h) = wv; }
    }
}

DI float ret_log2g(int head) { return log2f(1.0f - exp2f(-5.0f - (float)head)); }
constexpr float KSC = 0.08838834764831845f;
DI void ret_kv_unit(const Args& A, const Frame& F, int uidx) {
    const int c = uidx >> 2, head = uidx & 3; int tid = F.tid; asm volatile("" : "+v"(tid)); const int lane = tid & 63, w = F.wave;
    LAS unsigned char* Kl = F.lds; LAS unsigned char* Vl = F.lds + 34816;
    const float lg = ret_log2g(head);
    __syncthreads();
#pragma unroll
    for (int it = 0; it < 8; ++it) { const int t = tid + 512 * it, ch = t & 15, j = (t >> 4) & 127, isv = t >> 11;
        const bf16* src = F.PROJ() + (size_t)(c * 128 + j) * NIN + (isv ? 1792 : 1280) + head * 128 + 8 * ch;
        u32x4 wv = *(const u32x4*)src;
        if (!isv) { float f[8]; unpack8(wv, f); const float sc = KSC * exp2f(lg * (float)(127 - j));
            wv = (u32x4){pk2(f[0] * sc, f[1] * sc), pk2(f[2] * sc, f[3] * sc), pk2(f[4] * sc, f[5] * sc), pk2(f[6] * sc, f[7] * sc)}; }
        *(LAS u32x4*)((isv ? Vl : Kl) + (j * 136 + 8 * ch) * 2) = wv; }
    __syncthreads();
    const int n = lane & 31, h = lane >> 5, i16 = lane & 15, tq = i16 >> 2, tp = i16 & 3, blk = (lane >> 4) & 1;
    const int et = w >> 1, dt0 = 2 * (w & 1);
    f32x16 acc[2]; acc[0] = zero16(); acc[1] = zero16();
#pragma unroll
    for (int s = 0; s < 8; ++s) { const int rowoff = (16 * s + 8 * h + tq) * 136;
        const bf16x8 a = tr_frag(Vl + (rowoff + 32 * et + 16 * blk + 4 * tp) * 2, 4 * 136 * 2);
#pragma unroll
        for (int x = 0; x < 2; ++x) { const bf16x8 bb = tr_frag(Kl + (rowoff + 32 * (dt0 + x) + 16 * blk + 4 * tp) * 2, 4 * 136 * 2); acc[x] = MFMA32(a, bb, acc[x]); } }
    float* dst = F.RKV() + ((size_t)(c * 4 + head) * 128) * 128;
#pragma unroll
    for (int x = 0; x < 2; ++x)
#pragma unroll
        for (int r = 0; r < 16; ++r) dst[(size_t)(32 * et + crow(r, h)) * 128 + 32 * (dt0 + x) + n] = acc[x][r];
}
DI void ret_scan_phase(const Args& A, const Frame& F) {
    const int gt = F.bid * 512 + F.tid;
    if (gt < 65536) { const int head = gt >> 14, e = (gt >> 7) & 127, d = gt & 127;
        const float dc = exp2f(ret_log2g(head) * 128.f); float S = 0.f;
#pragma unroll 8
        for (int c = 0; c < 128; ++c) { F.SIN()[(size_t)c * 65536 + gt] = f2bf(S); S = S * dc + F.RKV()[(size_t)c * 65536 + gt]; }
        ((float*)(F.ws + WS_S5P + MiB))[gt] = S; (void)head; (void)e; (void)d; }
}
DI void pret_transpose_tile(const Args& A, const Frame& F, int tile) {
    const int head = tile >> 4, et = (tile >> 2) & 3, dt = tile & 3; LAS float* T = (LAS float*)F.lds;
    const float* src = (const float*)(F.ws + WS_S5P + MiB) + (size_t)head * 16384; float* dst = F.out + O_PRET + (size_t)head * 16384;
    __syncthreads();
    for (int idx = F.tid; idx < 1024; idx += 512) { const int el = idx >> 5, dl = idx & 31; T[el * 33 + dl] = src[(32 * et + el) * 128 + 32 * dt + dl]; }
    __syncthreads();
    for (int idx = F.tid; idx < 1024; idx += 512) { const int dl = idx >> 5, el = idx & 31; dst[(32 * dt + dl) * 128 + 32 * et + el] = T[el * 33 + dl]; }
    __syncthreads();
}
DI void ret_out_prompt(const Args& A, const Frame& F, int bu) {
    const int c = bu >> 1, hp = bu & 1; int tid = F.tid; asm volatile("" : "+v"(tid)); const int lane = tid & 63, w = F.wave;
    LAS unsigned char* Vl = F.lds;
    __syncthreads();
#pragma unroll
    for (int it = 0; it < 8; ++it) { const int t = tid + 512 * it, ch = t & 15, j = (t >> 4) & 127, hl = t >> 11;
        *(LAS u32x4*)(Vl + ((hl * 128 + j) * 136 + 8 * ch) * 2) = *(const u32x4*)(F.PROJ() + (size_t)(c * 128 + j) * NIN + 1792 + (2 * hp + hl) * 128 + 8 * ch); }
    __syncthreads();
    const int hl = w >> 2, it = w & 3, head = 2 * hp + hl, n = lane & 31, h = lane >> 5, i16 = lane & 15, tq = i16 >> 2, tp = i16 & 3, blk = (lane >> 4) & 1;
    const int tok = c * 128 + 32 * it + n; const float lg = ret_log2g(head);
    bf16x8 qf[8];
#pragma unroll
    for (int s = 0; s < 8; ++s) qf[s] = *(const bf16x8*)(F.PROJ() + (size_t)tok * NIN + 768 + head * 128 + 16 * s + 8 * h);
    f32x16 acc[4];
#pragma unroll
    for (int et = 0; et < 4; ++et) { acc[et] = zero16();
#pragma unroll
        for (int s = 0; s < 8; ++s) { const bf16x8 a = *(const bf16x8*)(F.SIN() + ((size_t)(c * 4 + head) * 128 + 32 * et + n) * 128 + 16 * s + 8 * h); acc[et] = MFMA32(a, qf[s], acc[et]); } }
    const float dq = exp2f(lg * (float)(32 * it + n + 1));
#pragma unroll
    for (int et = 0; et < 4; ++et) acc[et] = acc[et] * dq;
#pragma unroll 1
    for (int jt = 0; jt <= it; ++jt) {
        f32x16 X = zero16();
#pragma unroll
        for (int s = 0; s < 8; ++s) { const bf16x8 a = *(const bf16x8*)(F.PROJ() + (size_t)(c * 128 + 32 * jt + n) * NIN + 1280 + head * 128 + 16 * s + 8 * h); X = MFMA32(a, qf[s], X); }
#pragma unroll
        for (int r = 0; r < 16; ++r) { const int dd = 32 * it + n - (32 * jt + crow(r, h)); X[r] = dd >= 0 ? X[r] * (KSC * exp2f(lg * (float)dd)) : 0.f; }
#pragma unroll
        for (int s2 = 0; s2 < 2; ++s2) { const bf16x8 pf = PACK_STEP(X, s2);
#pragma unroll
            for (int et = 0; et < 4; ++et) { const bf16x8 vfr = tr_frag(Vl + ((hl * 128 + 32 * jt + 16 * s2 + 4 * h + tq) * 136 + 32 * et + 16 * blk + 4 * tp) * 2, 8 * 136 * 2);
                acc[et] = MFMA32(vfr, pf, acc[et]); } }
    }
    float sum = 0.f;
#pragma unroll
    for (int et = 0; et < 4; ++et)
#pragma unroll
        for (int r = 0; r < 16; ++r) sum += acc[et][r];
    sum += __shfl_xor(sum, 32); const float mean = sum * (1.f / 128.f); float var = 0.f;
#pragma unroll
    for (int et = 0; et < 4; ++et)
#pragma unroll
        for (int r = 0; r < 16; ++r) { const float dlt = acc[et][r] - mean; var += dlt * dlt; }
    var += __shfl_xor(var, 32); const float rstd = rsqrtf(var * (1.f / 128.f) + EPSN);
    const bf16* gp = F.PROJ() + (size_t)tok * NIN + 2304 + head * 128; bf16* op = F.MIX() + (size_t)tok * DM + 512 + head * 128; const float* rg = A.in[I_RG] + head * 128;
#pragma unroll
    for (int et = 0; et < 4; ++et)
#pragma unroll
        for (int g4 = 0; g4 < 4; ++g4) { const int e0 = 32 * et + 8 * g4 + 4 * h; const u32x2 gw = *(const u32x2*)(gp + e0); const f32x4 rgv = *(const f32x4*)(rg + e0);
            float gv[4] = {bflo(gw.x), bfhi(gw.x), bflo(gw.y), bfhi(gw.y)}; float y[4];
#pragma unroll
            for (int i = 0; i < 4; ++i) y[i] = (acc[et][4 * g4 + i] - mean) * rstd * rgv[i] * (gv[i] * pg8::sigm(gv[i]));
            u32x2 wv; wv.x = pk2(y[0], y[1]); wv.y = pk2(y[2], y[3]); *(u32x2*)(op + e0) = wv; }
}
DI void ret_sample_unit(const Args& A, const Frame& F, int uidx) {
    const int b = uidx >> 2, head = uidx & 3; const int tid = F.tid, lane = F.lane, w = F.wave;
    LAS float* Q = (LAS float*)F.lds; LAS float* Ks = Q + 1024; LAS float* V = Ks + 1024; LAS float* INN = V + 1024; LAS float* OO = INN + 64; LAS float* O2 = OO + 1024;
    const float lg = ret_log2g(head);
    __syncthreads();
    for (int idx = tid; idx < 3072; idx += 512) { const int which = idx >> 10, i = (idx >> 7) & 7, d = idx & 127;
        const float v = bf2f(F.PROJ()[(size_t)(TP + b * 8 + i) * NIN + (which == 0 ? 768 : which == 1 ? 1280 : 1792) + head * 128 + d]);
        (which == 0 ? Q : which == 1 ? Ks : V)[i * 128 + d] = which == 1 ? v * KSC : v; }
    __syncthreads();
    if (tid < 64) { const int i = tid >> 3, j = tid & 7; float dot = 0.f;
        for (int d = 0; d < 128; ++d) dot += Q[i * 128 + d] * Ks[j * 128 + d];
        INN[tid] = j <= i ? dot * exp2f(lg * (float)(i - j)) : 0.f; }
    {
        const int e4 = (tid & 31) * 4, dg = tid >> 5; f32x4 vv[8], o2[8];
#pragma unroll
        for (int j = 0; j < 8; ++j) { vv[j] = *(const LAS f32x4*)(V + j * 128 + e4) * exp2f(lg * (float)(7 - j)); o2[j] = (f32x4){0.f, 0.f, 0.f, 0.f}; }
        const float dc = exp2f(lg * 8.f);
        const float* S0 = A.in[I_SRET] + ((size_t)(b * 4 + head) * 128) * 128; float* S1 = F.out + O_SRET + ((size_t)(b * 4 + head) * 128) * 128;
        f32x4 sv[8];
#pragma unroll
        for (int dd = 0; dd < 8; ++dd) sv[dd] = *(const f32x4*)(S0 + (dg * 8 + dd) * 128 + e4);
#pragma unroll
        for (int dd = 0; dd < 8; ++dd) { const int d = dg * 8 + dd; const f32x4 s = sv[dd]; f32x4 sn = s * dc;
#pragma unroll
            for (int j = 0; j < 8; ++j) { o2[j] += Q[j * 128 + d] * s; sn += Ks[j * 128 + d] * vv[j]; }
            *(f32x4*)(S1 + d * 128 + e4) = sn; }
#pragma unroll
        for (int i = 0; i < 8; ++i) *(LAS f32x4*)(O2 + (dg * 8 + i) * 128 + e4) = o2[i];
    }
    __syncthreads();
    { const int e = tid & 127, ig = tid >> 7;
#pragma unroll
        for (int ii = 0; ii < 2; ++ii) { const int i = 2 * ig + ii; float o = 0.f;
#pragma unroll
            for (int dg = 0; dg < 16; ++dg) o += O2[(dg * 8 + i) * 128 + e];
            o *= exp2f(lg * (float)(i + 1));
            for (int j = 0; j <= i; ++j) o += INN[i * 8 + j] * V[j * 128 + e];
            OO[i * 128 + e] = o; } }
    __syncthreads();
    { const int i = w; const float a0 = OO[i * 128 + lane], a1 = OO[i * 128 + 64 + lane];
        const float mean = wave_sum(a0 + a1) * (1.f / 128.f); const float d0 = a0 - mean, d1 = a1 - mean;
        const float rstd = rsqrtf(wave_sum(d0 * d0 + d1 * d1) * (1.f / 128.f) + EPSN);
        const int tok = TP + b * 8 + i; const bf16* gp = F.PROJ() + (size_t)tok * NIN + 2304 + head * 128; bf16* op = F.MIX() + (size_t)tok * DM + 512 + head * 128; const float* rg = A.in[I_RG] + head * 128;
        const float g0 = bf2f(gp[lane]), g1 = bf2f(gp[64 + lane]);
        op[lane] = f2bf(d0 * rstd * rg[lane] * (g0 * pg8::sigm(g0))); op[64 + lane] = f2bf(d1 * rstd * rg[64 + lane] * (g1 * pg8::sigm(g1))); }
}

template <int PASS> DI void s5_phase(const Args& A, const Frame& F) {
    const int lane = F.lane, w = F.wave; const int gw = F.bid * NWAVES + w, NGW = F.G * NWAVES;
    LAS unsigned char* L = F.lds + w * 16896;
    const float* P = (const float*)(F.ws + WS_S5P); const bf16* BBt = (const bf16*)(F.ws + WS_S5P + S5_BBT); const bf16* CCt = (const bf16*)(F.ws + WS_S5P + S5_CCT);
    const int n = lane & 31, h = lane >> 5;
    const int nunits = PASS == 1 ? 64 * 128 : 2 * 64 * 128;
#pragma unroll 1
    for (int u = gw; u < nunits; u += NGW) {
        const bool sample = u >= 8192; const int uu = sample ? u - 8192 : u; const int g = uu & 63, cb = uu >> 6;
        const int tok0 = sample ? TP + cb * 8 : cb * 128, ntok = sample ? 8 : 128;
        const float lr = P[(S5_LAM >> 2) + 2 * (g * 64 + lane)], li = P[(S5_LAM >> 2) + 2 * (g * 64 + lane) + 1];
        float hr = 0.f, hi = 0.f;
        if (PASS == 2) { if (sample) { hr = A.in[I_S5R][(size_t)(cb * 64 + g) * 64 + lane]; hi = A.in[I_S5I][(size_t)(cb * 64 + g) * 64 + lane]; }
                         else { hr = F.S5H()[(size_t)(cb * 64 + g) * 128 + lane]; hi = F.S5H()[(size_t)(cb * 64 + g) * 128 + 64 + lane]; } }
        bf16x8 bbf[4];
#pragma unroll
        for (int qt = 0; qt < 4; ++qt) bbf[qt] = *(const bf16x8*)(BBt + (size_t)(g * 128 + 32 * qt + n) * 16 + 8 * h);
        bf16x8 cfh[8];
        if (PASS == 2) {
#pragma unroll
            for (int s = 0; s < 8; ++s) cfh[s] = *(const bf16x8*)(CCt + (size_t)(g * 16 + (n & 15)) * 128 + 16 * s + 8 * h); }
        bf16x8 dfr = (bf16x8){0, 0, 0, 0, 0, 0, 0, 0};
        if (PASS == 2) { const unsigned dbf = (unsigned)f2bf(A.in[I_DSK][g * 16 + (n & 15)]); const int jd = n < 16 ? (n & 15) - 8 * h : -100;
            u32x4 dw; dw.x = (jd == 0 ? dbf : 0u) | (jd == 1 ? dbf << 16 : 0u); dw.y = (jd == 2 ? dbf : 0u) | (jd == 3 ? dbf << 16 : 0u);
            dw.z = (jd == 4 ? dbf : 0u) | (jd == 5 ? dbf << 16 : 0u); dw.w = (jd == 6 ? dbf : 0u) | (jd == 7 ? dbf << 16 : 0u);
            dfr = __builtin_bit_cast(bf16x8, dw); }
        bf16x8 a4[4];
#pragma unroll
        for (int i = 0; i < 4; ++i) { a4[i] = (bf16x8){0, 0, 0, 0, 0, 0, 0, 0}; if (32 * i + n < ntok) a4[i] = *(const bf16x8*)(F.XN() + (size_t)(tok0 + 32 * i + n) * DM + g * 16 + 8 * h); }
        asm volatile("s_waitcnt vmcnt(0)" ::: "memory");
#pragma unroll
        for (int sti = 0; sti < 4; ++sti) { if (32 * sti < ntok) {
            const int st = 32 * sti;
            const int nv = ntok - st < 32 ? ntok - st : 32;
            const bf16x8 a = a4[sti];
#pragma unroll
            for (int qt = 0; qt < 4; ++qt) { const f32x16 cc = MFMA32(a, bbf[qt], zero16());
#pragma unroll
                for (int r = 0; r < 16; ++r) *(LAS float*)(L + crow(r, h) * 528 + 4 * (32 * qt + n)) = cc[r]; }
#pragma unroll 4
            for (int t = 0; t < nv; ++t) { const float br = *(LAS float*)(L + t * 528 + 4 * lane), bi = *(LAS float*)(L + t * 528 + 256 + 4 * lane);
                const float nr = lr * hr - li * hi + br, ni = lr * hi + li * hr + bi; hr = nr; hi = ni;
                if (PASS == 2) { *(LAS unsigned short*)(L + t * 528 + 2 * lane) = f2bf(hr); *(LAS unsigned short*)(L + t * 528 + 128 + 2 * lane) = f2bf(hi); } }
            if (PASS == 2) {
                f32x16 y = MFMA32(a, dfr, zero16());
#pragma unroll
                for (int s = 0; s < 8; ++s) { const bf16x8 hs = *(const LAS bf16x8*)(L + n * 528 + 32 * s + 16 * h); y = MFMA32(hs, cfh[s], y); }
                if (n < 16) {
#pragma unroll
                    for (int r = 0; r < 16; ++r) { const int t = crow(r, h);
                        if (t < nv) { const size_t o = (size_t)(tok0 + st + t) * DM + g * 16 + n; const float yy = y[r];
                            const float z = 0.7978845608028654f * (yy + 0.044715f * yy * yy * yy); F.MIX()[o] = f2bf(yy * pg8::sigm(2.f * z)); } } }
            }
        } }
        if (PASS == 1) { F.S5E()[(size_t)(cb * 64 + g) * 128 + lane] = hr; F.S5E()[(size_t)(cb * 64 + g) * 128 + 64 + lane] = hi; }
        else { if (sample) { F.out[O_SS5R + (size_t)(cb * 64 + g) * 64 + lane] = hr; F.out[O_SS5I + (size_t)(cb * 64 + g) * 64 + lane] = hi; }
               else if (cb == 127) { F.out[O_PS5R + g * 64 + lane] = hr; F.out[O_PS5I + g * 64 + lane] = hi; } }
    }
}
DI void s5_carry_phase(const Args& A, const Frame& F) {
    const int gt = F.bid * 512 + F.tid;
    if (gt < 4096) { const int g = gt >> 6, p = gt & 63; const float* P = (const float*)(F.ws + WS_S5P);
        const float ar = P[(S5_LAM128 >> 2) + 2 * gt], ai = P[(S5_LAM128 >> 2) + 2 * gt + 1]; float Hr = 0.f, Hi = 0.f;
#pragma unroll 8
        for (int c = 0; c < 128; ++c) { const size_t o = (size_t)(c * 64 + g) * 128 + p; F.S5H()[o] = Hr; F.S5H()[o + 64] = Hi;
            const float er = F.S5E()[o], ei = F.S5E()[o + 64]; const float nr = ar * Hr - ai * Hi + er, ni = ar * Hi + ai * Hr + ei; Hr = nr; Hi = ni; } }
}

#define XB_TMO      128
#define XB_XCNT(j)  (256  + 64 * (j))
#define XB_XSUB(j)  (1280 + 64 * (j))
#define XB_XGEN(j)  (2304 + 64 * (j))
#define XB_TOP      3328
#define XB_TOPGEN   3392
#define XCD_BAR_WORDS 3456
#define XB_SPIN_CAP (1u << 18)

__device__ __forceinline__ unsigned xb_ld(unsigned* p)              { return __hip_atomic_load(p, __ATOMIC_RELAXED, __HIP_MEMORY_SCOPE_AGENT); }
__device__ __forceinline__ unsigned xb_add(unsigned* p, unsigned v) { return __hip_atomic_fetch_add(p, v, __ATOMIC_RELAXED, __HIP_MEMORY_SCOPE_AGENT); }
__device__ __forceinline__ unsigned xb_xcc_id() { return (unsigned)__builtin_amdgcn_s_getreg((3 << 11) | 20) & 0xFu; }
#define XB_SPIN(cond, bar) do { unsigned _sp = 0; while (cond) { __builtin_amdgcn_s_sleep(1); \
    if ((++_sp & 255u) == 0u) { if (xb_ld(&(bar)[XB_TMO])) break; if (_sp > XB_SPIN_CAP) { atomicAdd(&(bar)[XB_TMO], 1u); break; } } } } while (0)

struct XcdBarrier {
    unsigned* bar; unsigned x;
    volatile LAS unsigned* st;
};

__device__ __forceinline__ XcdBarrier xcd_barrier_post(unsigned* bar, volatile LAS unsigned* st) {
    XcdBarrier b; b.bar = bar; b.x = xb_xcc_id(); b.st = st;
    if (threadIdx.x == 0) (void)xb_add(&bar[XB_XCNT(b.x)], 1u);
    return b;
}
__device__ __forceinline__ void xcd_barrier_complete(unsigned* bar, unsigned x, unsigned& nloc, unsigned& nx) {
    const unsigned G = gridDim.x * gridDim.y * gridDim.z;
    unsigned sum, cnt, mine, sp = 0u;
    for (;;) {
        sum = 0u; cnt = 0u; mine = 0u;
#pragma unroll
        for (unsigned j = 0; j < 16; ++j) { const unsigned c = xb_ld(&bar[XB_XCNT(j)]); sum += c; cnt += (c > 0u) ? 1u : 0u; mine = (j == x) ? c : mine; }
        if (sum == G) break;
        __builtin_amdgcn_s_sleep(1);
        if ((++sp & 255u) == 0u) { if (xb_ld(&bar[XB_TMO])) break; if (sp > XB_SPIN_CAP) { atomicAdd(&bar[XB_TMO], 1u); break; } }
    }
    nloc = mine > 0u ? mine : 1u; nx = cnt > 0u ? cnt : 1u;
}

__device__ __forceinline__ void xcd_barrier(const XcdBarrier& b) {
    asm volatile("s_waitcnt vmcnt(0)" ::: "memory");
    __syncthreads();
    if (threadIdx.x == 0) {
        unsigned* bar = b.bar;
        __builtin_amdgcn_s_waitcnt(0);
        unsigned nloc = b.st[0], nx = b.st[1];
        if (nloc == 0u) { xcd_barrier_complete(bar, b.x, nloc, nx); b.st[0] = nloc; b.st[1] = nx; }
        const unsigned old = xb_add(&bar[XB_XSUB(b.x)], 1u);
        const unsigned gen = old / nloc;
        if (old + 1u == (gen + 1u) * nloc) {
            __builtin_amdgcn_fence(__ATOMIC_RELEASE, "agent");
            asm volatile("s_waitcnt vmcnt(0)" ::: "memory");
            const unsigned og = xb_add(&bar[XB_TOP], 1u);
            const unsigned tg = og / nx;
            if (og + 1u == (tg + 1u) * nx) xb_add(&bar[XB_TOPGEN], 1u);
            else XB_SPIN(xb_ld(&bar[XB_TOPGEN]) == tg, bar);
            __builtin_amdgcn_fence(__ATOMIC_ACQUIRE, "");
            xb_add(&bar[XB_XGEN(b.x)], 1u);
            asm volatile("s_waitcnt vmcnt(0)" ::: "memory");
        } else {
            XB_SPIN(xb_ld(&bar[XB_XGEN(b.x)]) == gen, bar);
            __builtin_amdgcn_fence(__ATOMIC_ACQUIRE, "");
            asm volatile("s_waitcnt vmcnt(0)" ::: "memory");
        }
    }
    __syncthreads();
}

constexpr int NPHASE = 17;
__global__ void __launch_bounds__(NWAVES * 64, 2) mega_fwd(Args args) {
    extern __shared__ __attribute__((aligned(16))) unsigned char lds_raw[];
    cg::grid_group grid = cg::this_grid();
    Frame F;
    F.lds = (LAS unsigned char*)lds_raw; F.tid = threadIdx.x; F.lane = F.tid & 63; F.wave = __builtin_amdgcn_readfirstlane(F.tid >> 6); F.G = gridDim.x; F.bid = blockIdx.x;
    F.out = args.out; F.ws = args.ws;
    const int lo = args.ph_lo, hi = args.ph_hi;
    volatile LAS unsigned* misc_ = (volatile LAS unsigned*)(F.lds + LDS_BYTES - 64);
    if (F.tid < 16) misc_[F.tid] = 0u;
    __syncthreads();
    const XcdBarrier xbar_ = xcd_barrier_post((unsigned*)args.ws, misc_);
    if (lo < 0) grid.sync();
#define GSYNC() xcd_barrier(xbar_)
    float* XR = F.out + O_Y;
#ifndef PHMASK
#define PHMASK 0xfffffu
#endif
#define IN(k) (((PHMASK >> (k)) & 1u) && lo <= (k) && (k) < hi)
#define SEAM(k) do { if (IN(k) && IN((k) + 1)) GSYNC(); } while (0)
#ifndef RPTMASK
#define RPTMASK 0u
#endif
#ifndef XSYNC
#define XSYNC 0
#endif
#define RPT(k) (((RPTMASK >> (k)) & 1u) ? 2 : 1)
#define RB(k) for (int rep_ = 0; rep_ < RPT(k); ++rep_) { if (rep_) GSYNC();
#define RE }
#define GEMM_SPLIT(g, E, nM_, nN_, S__) do { pg8::SplitOrder S_; S_.init(nM_, nN_, S__, F.G, (int)blockIdx.x); pg8::gemm_phase<pg8::EpiPartial, pg8::SplitOrder, true, true>(F.lds, g, S_, E); } while (0)
#define GEMM_PHASE(EPI, g, E) do { pg8::StaticOrder S_; S_.init((g).M, (g).N, F.G, (int)blockIdx.x); pg8::gemm_phase<EPI, pg8::StaticOrder, true, true>(F.lds, g, S_, E); } while (0)

    if (IN(0)) { RB(0)  p0_prologue(args, F);  RE } SEAM(0);
    if (IN(1)) { RB(1)  pg8::Gemm g{F.CA(), F.Wada_t(), 256, NMOD, 1024}; pg8::EpiF32Bias E{F.MOD(), NMOD, args.in[I_ADAB]}; GEMM_PHASE(pg8::EpiF32Bias, g, E);  RE } SEAM(1);
    if (IN(2)) { RB(2)  norm_phase(args, F, args.in[I_XP], args.in[I_XS], args.in[I_NMIX], F.MOD(), 0, 1024);  RE } SEAM(2);
    if (IN(3)) { RB(3)  pg8::Gemm g{F.XN(), F.Win_t(), MT, NIN, 1024}; pg8::EpiBf16<0> E{F.PROJ(), NIN, nullptr, 0, 0, 1.f}; GEMM_PHASE(pg8::EpiBf16<0>, g, E);  RE } SEAM(3);
    if (IN(4)) { RB(4)
#ifndef P4SEL
#define P4SEL 7
#endif
        if (P4SEL & 1) for (int u = F.bid; u < 512; u += F.G) attn_unit<false>(args, F, u);
        if (P4SEL & 2) for (int u = (F.bid + 128) % F.G; u < 128; u += F.G) attn_unit<true>(args, F, u);
        if (P4SEL & 4) for (int u = F.bid; u < 512; u += F.G) ret_kv_unit(args, F, u);
        __syncthreads();
    RE } SEAM(4);
    if (IN(5)) { RB(5)  ret_scan_phase(args, F);  RE } SEAM(5);
    if (IN(6)) { RB(6)  if (F.bid < 64) pret_transpose_tile(args, F, F.bid);
        for (int u = F.bid; u < 768; u += F.G) { if (u < 256) ret_out_prompt(args, F, u); else ret_sample_unit(args, F, u - 256); } __syncthreads();  RE } SEAM(6);
    if (IN(7)) { RB(7)  { pg8::Gemm g{F.MIX(), F.Wout_t(), TP, 1024, 1024, 0}; pg8::EpiResid E{args.in[I_XP], args.in[I_XS], XR, F.MOD() + 2048}; GEMM_PHASE(pg8::EpiResid, g, E); }
        { pg8::Gemm g{F.MIX() + (size_t)TP * DM, F.Wout_t(), TS, 1024, 256, 1024}; pg8::EpiPartial E{(bf16*)(F.ws + WS_PART0), TS, 0}; GEMM_SPLIT(g, E, 4, 4, 4); }  RE } SEAM(7);
    if (IN(8)) { RB(8)  norm_phase(args, F, XR, args.in[I_XS], args.in[I_NFFN], F.MOD(), 3072, 4096, (const bf16*)(F.ws + WS_PART0), 4, F.MOD() + 2048, XR);  RE } SEAM(8);
    if (IN(9)) { RB(9)  pg8::Gemm g{F.XN(), F.Wgu_t(0), MT, 2 * DFF, 1024}; pg8::EpiSwiGLU E{F.PROJ(), DFF}; GEMM_PHASE(pg8::EpiSwiGLU, g, E);  RE } SEAM(9);
    if (IN(10)) { RB(10)  { pg8::Gemm g{F.PROJ(), F.Wd_t(0), TP, 1024, DFF, 0}; pg8::EpiResid E{XR, XR + (size_t)TP * DM, XR, F.MOD() + 5120}; GEMM_PHASE(pg8::EpiResid, g, E); }
        { pg8::Gemm g{F.PROJ() + (size_t)TP * DFF, F.Wd_t(0), TS, 1024, 256, DFF}; pg8::EpiPartial E{F.MIX(), TS, 0}; GEMM_SPLIT(g, E, 4, 4, 11); }  RE } SEAM(10);
    if (IN(11)) { RB(11)  norm_phase(args, F, XR, XR + (size_t)TP * DM, args.in[I_NMIX] + 1024, F.MOD() + LMOD, 0, 1024, F.MIX(), 11, F.MOD() + 5120, XR);  RE } SEAM(11);
    if (IN(12)) { RB(12)  s5_phase<1>(args, F);  RE } SEAM(12);
    if (IN(13)) { RB(13)  s5_carry_phase(args, F);  RE } SEAM(13);
    if (IN(14)) { RB(14)  s5_phase<2>(args, F);  RE } SEAM(14);
    if (IN(15)) { RB(15)  { pg8::Gemm g{F.MIX(), F.Wglu_t(), TP, 2048, 1024, 0}; pg8::EpiGLUResid E{XR, F.MOD() + LMOD + 2048}; GEMM_PHASE(pg8::EpiGLUResid, g, E); }
        { pg8::Gemm g{F.MIX() + (size_t)TP * DM, F.Wglu_t(), TS, 2048, 256, 1024}; pg8::EpiPartial E{(bf16*)(F.ws + WS_PART0), TS, 2048}; GEMM_SPLIT(g, E, 4, 8, 4); }  RE } SEAM(15);
    if (IN(16)) { RB(16)  norm_phase(args, F, XR, XR + (size_t)TP * DM, args.in[I_NFFN] + 1024, F.MOD() + LMOD, 3072, 4096, nullptr, 4, F.MOD() + LMOD + 2048, XR, (const bf16*)(F.ws + WS_PART0));  RE } SEAM(16);
    if (IN(17)) { RB(17)  pg8::Gemm g{F.XN(), F.Wgu_t(1), MT, 2 * DFF, 1024}; pg8::EpiSwiGLU E{F.PROJ(), DFF}; GEMM_PHASE(pg8::EpiSwiGLU, g, E);  RE } SEAM(17);
    if (IN(18)) { { pg8::Gemm g{F.PROJ(), F.Wd_t(1), TP, 1024, DFF, 0}; pg8::EpiResid E{XR, XR + (size_t)TP * DM, XR, F.MOD() + LMOD + 5120}; GEMM_PHASE(pg8::EpiResid, g, E); }
        { pg8::Gemm g{F.PROJ() + (size_t)TP * DFF, F.Wd_t(1), TS, 1024, 256, DFF}; pg8::EpiPartial E{F.MIX(), TS, 0}; GEMM_SPLIT(g, E, 4, 4, 11); } } SEAM(18);
    if (IN(19)) {
        const int gw = F.bid * NWAVES + F.wave, NGW = F.G * NWAVES; const bf16* part = F.MIX();
        for (int m = TP + gw; m < MT; m += NGW) { const float* grow = F.MOD() + LMOD + 5120 + (size_t)pg8::seq_of_row(m) * NMOD;
#pragma unroll
            for (int j = 0; j < 4; ++j) { const int col = 4 * (64 * j + F.lane); const size_t po = (size_t)(m - TP) * 1024 + col; f32x4 ps = (f32x4){0.f, 0.f, 0.f, 0.f};
                for (int sl = 0; sl < 11; ++sl) { const u32x2 w = *(const u32x2*)(part + (size_t)sl * TS * 1024 + po); ps += (f32x4){bflo(w.x), bfhi(w.x), bflo(w.y), bfhi(w.y)}; }
                *(f32x4*)(XR + (size_t)m * DM + col) = *(const f32x4*)(XR + (size_t)m * DM + col) + *(const f32x4*)(grow + col) * ps; } }
    }
#undef IN
#undef SEAM
}

extern "C" void kernel_launch(void* const* d_in, const int* in_sizes, int n_in, void* d_out, int out_size, void* d_ws, size_t ws_size, hipStream_t stream) {
    static int grid = 0;
    if (grid == 0) {
        if (n_in != 32 || (size_t)out_size != O_END || ws_size < WS_END) { fprintf(stderr, "kernel_launch: unexpected shapes n_in %d out %d ws %zu\n", n_in, out_size, ws_size); grid = -1; return; }
        int dev = 0, cus = 0, per_cu = 0;
        hipGetDevice(&dev); hipDeviceGetAttribute(&cus, hipDeviceAttributeMultiprocessorCount, dev);
        hipFuncSetAttribute((const void*)mega_fwd, hipFuncAttributeMaxDynamicSharedMemorySize, LDS_BYTES);
        hipOccupancyMaxActiveBlocksPerMultiprocessor(&per_cu, (const void*)mega_fwd, NWAVES * 64, LDS_BYTES);
        if (per_cu < 1) { fprintf(stderr, "kernel_launch: occupancy query says %d blocks/CU\n", per_cu); per_cu = 1; }
        (void)hipGetLastError();
        grid = cus;
    }
    if (grid < 0) return;
    if (hipMemsetAsync(d_ws, 0, 65536, stream) != hipSuccess) { fprintf(stderr, "kernel_launch: memset failed\n"); return; }
    Args a{};
    for (int i = 0; i < 32; ++i) a.in[i] = (const float*)d_in[i];
    a.out = (float*)d_out; a.ws = (unsigned char*)d_ws; a.ph_lo = 0; a.ph_hi = 20;
    void* kargs[] = {&a};
    hipError_t e = hipLaunchCooperativeKernel((const void*)mega_fwd, dim3(grid), dim3(NWAVES * 64), kargs, LDS_BYTES, stream);
    if (e != hipSuccess) fprintf(stderr, "cooperative launch failed: %s (grid %d)\n", hipGetErrorString(e), grid);
}
```

```cpp
#include <hip/hip_runtime.h>
#include <hip/hip_cooperative_groups.h>
#include <cstdio>
#include <cstdint>
namespace cg = cooperative_groups;
namespace pg8 {
#define PG8_LAS __attribute__((address_space(3)))
typedef unsigned short bf16_t;
typedef short bf16x8 __attribute__((ext_vector_type(8)));
typedef float f32x4 __attribute__((ext_vector_type(4)));
typedef unsigned u32x4 __attribute__((ext_vector_type(4)));
constexpr int BM = 256, BK = 64, HALF = 128, HTB = HALF * BK * 2  , STAGE_BYTES = 8 * HTB, NXCD = 8, WGM = 8;

__host__ __device__ __forceinline__ int lds_byte(int r, int c) { const int st = (r >> 4) * 2 + (c >> 5), rr = r & 15, cc = c & 31, ob = rr * 64 + cc * 2; return st * 1024 + (ob ^ (((ob >> 9) & 1) << 5)); }
__host__ __device__ __forceinline__ void stage_rc(int b, int& R, int& C) { const int st = b / 1024, sb = b % 1024, swz = sb ^ (((sb >> 9) & 1) << 5); R = (st >> 1) * 16 + swz / 64; C = (st & 1) * 32 + (swz % 64) / 2; }
__host__ __device__ __forceinline__ int perm32(int rho) { const int n = rho >> 4, i = rho & 15; return 8 * (i >> 2) + 4 * n + (i & 3); }

struct Unit { int pm, pn, ks; };
struct Gemm { const bf16_t* A; const bf16_t* Bt; int M, N, K, ld; };

struct StaticOrder {
    int nM, nN, nwg, G, c;
    __host__ __device__ void init(int M, int N, int G_, int c_) { nM = M / BM; nN = N / BM; nwg = nM * nN; G = G_; c = c_; }
    __host__ __device__ bool next(int i, Unit& u) const {
        const long L = (long)i * G + c; if (L >= nwg) return false;
        int wgid = (int)L; { const int q = nwg / NXCD, r = nwg % NXCD, xcd = wgid % NXCD, off = wgid / NXCD; wgid = (xcd < r ? xcd * (q + 1) : r * (q + 1) + (xcd - r) * q) + off; }
        const int nig = WGM * nN, gid = wgid / nig, fm = gid * WGM, gsz = (nM - fm) < WGM ? (nM - fm) : WGM;
        u.pm = fm + ((wgid % nig) % gsz); u.pn = (wgid % nig) / gsz; u.ks = 0; return true;
    }
    __device__ __forceinline__ void a_ready(const Unit&) const {}
    __device__ __forceinline__ void done(const Unit&) const {}
};

struct SplitOrder {
    int nM, nN, nwg, G, c;
    __host__ __device__ void init(int nM_, int nN_, int S, int G_, int c_) { nM = nM_; nN = nN_; nwg = nM_ * nN_ * S; G = G_; c = c_; }
    __host__ __device__ bool next(int i, Unit& u) const { const int L = i * G + c; if (L >= nwg) return false; const int t = nM * nN, r = L % t; u.ks = L / t; u.pm = r % nM; u.pn = r / nM; return true; }
    __device__ __forceinline__ void a_ready(const Unit&) const {}
    __device__ __forceinline__ void done(const Unit&) const {}
};
__device__ __forceinline__ unsigned cvt_pk_bf16(float lo, float hi) { unsigned r; asm volatile("v_cvt_pk_bf16_f32 %0, %1, %2" : "=v"(r) : "v"(lo), "v"(hi)); return r; }
typedef float f32x2 __attribute__((ext_vector_type(2)));
__device__ __forceinline__ f32x2 gelu_pk(f32x2 v) {
    const f32x2 av = __builtin_elementwise_abs(v), d = av * 0.2316418882f + 1.0f;
    f32x2 t; t.x = __builtin_amdgcn_rcpf(d.x); t.y = __builtin_amdgcn_rcpf(d.y);
    f32x2 q = t * 0.5307027145f + (-0.7265760135f); q = q * t + 0.7107068705f; q = q * t + (-0.142248368f); q = q * t + 0.127414796f; q = q * t;
    const f32x2 s = (v * v) * (-0.72134752044f);
    f32x2 e; e.x = __builtin_amdgcn_exp2f(s.x); e.y = __builtin_amdgcn_exp2f(s.y);
    const f32x2 m = v * (q * e), r = v - m;
    f32x2 o; o.x = v.x < 0.f ? m.x : r.x; o.y = v.y < 0.f ? m.y : r.y; return o;
}

template <int ACT  > struct EpiBf16 {
    static constexpr bool PERM = true, AFTER_DRAIN = false; static_assert(ACT == 0 || ACT == 1, "EpiBf16: ACT is 0 (none) or 1 (gelu_pk)");
    bf16_t* O; int ldc; const float* bias; int split_cols; size_t split_stride; float scale0;
    __device__ __forceinline__ void operator()(const f32x4 (&acc)[2][2][4][2], const Unit& u, int wr, int wc, int fr, int fq) const {
        const int row0 = u.pm * BM + wr * 64 + fr; int colt = u.pn * BM; bf16_t* base = O;
        float sc = 1.f; if (split_cols) { const int t = colt / split_cols; base += (size_t)t * split_stride; colt -= t * split_cols; if (t == 0) sc = scale0; }
        const int col0 = colt + wc * 32 + 8 * fq, bcol0 = u.pn * BM + wc * 32 + 8 * fq;
        f32x4 bv[2][2];
#pragma unroll
        for (int bj = 0; bj < 2; ++bj)
#pragma unroll
            for (int n = 0; n < 2; ++n) bv[bj][n] = bias ? *(const f32x4*)(bias + bcol0 + bj * HALF + 4 * n) : (f32x4){0.f, 0.f, 0.f, 0.f};
#pragma unroll
        for (int ai = 0; ai < 2; ++ai)
#pragma unroll
            for (int m = 0; m < 4; ++m) { bf16_t* rowp = base + (size_t)(row0 + ai * HALF + m * 16) * ldc + col0;
#pragma unroll
                for (int bj = 0; bj < 2; ++bj) { f32x4 v0 = acc[ai][bj][m][0] + bv[bj][0], v1 = acc[ai][bj][m][1] + bv[bj][1];
                    if (ACT == 1) { f32x2 a = gelu_pk((f32x2){v0[0], v0[1]}), b = gelu_pk((f32x2){v0[2], v0[3]}), c = gelu_pk((f32x2){v1[0], v1[1]}), d = gelu_pk((f32x2){v1[2], v1[3]});
                        v0 = (f32x4){a.x, a.y, b.x, b.y}; v1 = (f32x4){c.x, c.y, d.x, d.y}; }
                    v0 = v0 * sc; v1 = v1 * sc; u32x4 w; w.x = cvt_pk_bf16(v0[0], v0[1]); w.y = cvt_pk_bf16(v0[2], v0[3]); w.z = cvt_pk_bf16(v1[0], v1[1]); w.w = cvt_pk_bf16(v1[2], v1[3]);
                    *(u32x4*)(rowp + bj * HALF) = w; } }
    }
};
constexpr int TPROMPT = 16384, NMODC = 12288;
__device__ __forceinline__ int seq_of_row(int row) { return row < TPROMPT ? 0 : 1 + ((row - TPROMPT) >> 3); }
__device__ __forceinline__ float sigm(float x) { return __builtin_amdgcn_rcpf(1.0f + __expf(-x)); }
typedef unsigned u32x2 __attribute__((ext_vector_type(2)));

struct EpiF32Bias {
    static constexpr bool PERM = false, AFTER_DRAIN = false;
    float* O; int ldc; const float* bias;
    __device__ __forceinline__ void operator()(const f32x4 (&acc)[2][2][4][2], const Unit& u, int wr, int wc, int fr, int fq) const {
        const int row0 = u.pm * BM + wr * 64 + fr, col0 = u.pn * BM + wc * 32 + 4 * fq;
#pragma unroll
        for (int bj = 0; bj < 2; ++bj)
#pragma unroll
            for (int n = 0; n < 2; ++n) { const int col = col0 + bj * HALF + n * 16; const f32x4 bv = *(const f32x4*)(bias + col);
#pragma unroll
                for (int ai = 0; ai < 2; ++ai)
#pragma unroll
                    for (int m = 0; m < 4; ++m) *(f32x4*)(O + (size_t)(row0 + ai * HALF + m * 16) * ldc + col) = acc[ai][bj][m][n] + bv; }
    }
};
struct EpiPartial {
    static constexpr bool PERM = false, AFTER_DRAIN = false;
    bf16_t* P; int rows; int ldp;
    __device__ __forceinline__ void operator()(const f32x4 (&acc)[2][2][4][2], const Unit& u, int wr, int wc, int fr, int fq) const {
        const int row0 = u.pm * BM + wr * 64 + fr, col0 = u.pn * BM + wc * 32 + 4 * fq; const int lp = ldp ? ldp : 1024; bf16_t* base = P + (size_t)u.ks * rows * lp;
#pragma unroll
        for (int ai = 0; ai < 2; ++ai)
#pragma unroll
            for (int m = 0; m < 4; ++m) { bf16_t* orow = base + (size_t)(row0 + ai * HALF + m * 16) * lp;
#pragma unroll
                for (int bj = 0; bj < 2; ++bj)
#pragma unroll
                    for (int n = 0; n < 2; ++n) { const f32x4 v = acc[ai][bj][m][n]; u32x2 w; w.x = cvt_pk_bf16(v[0], v[1]); w.y = cvt_pk_bf16(v[2], v[3]); *(u32x2*)(orow + col0 + bj * HALF + n * 16) = w; } }
    }
};
struct EpiResid {
    static constexpr bool PERM = false, AFTER_DRAIN = false;
    const float* bp; const float* bs; float* out; const float* gate;
    __device__ __forceinline__ void operator()(const f32x4 (&acc)[2][2][4][2], const Unit& u, int wr, int wc, int fr, int fq) const {
        const int row0 = u.pm * BM + wr * 64 + fr, col0 = u.pn * BM + wc * 32 + 4 * fq;
#pragma unroll
        for (int ai = 0; ai < 2; ++ai)
#pragma unroll
            for (int m = 0; m < 4; ++m) { const int row = row0 + ai * HALF + m * 16;
                const float* brow = row < TPROMPT ? bp + (size_t)row * 1024 : bs + (size_t)(row - TPROMPT) * 1024;
                const float* grow = gate + (size_t)seq_of_row(row) * NMODC; float* orow = out + (size_t)row * 1024;
#pragma unroll
                for (int bj = 0; bj < 2; ++bj)
#pragma unroll
                    for (int n = 0; n < 2; ++n) { const int col = col0 + bj * HALF + n * 16;
                        const f32x4 b = *(const f32x4*)(brow + col), g = *(const f32x4*)(grow + col);
                        *(f32x4*)(orow + col) = b + g * acc[ai][bj][m][n]; } }
    }
};
struct EpiSwiGLU {
    static constexpr bool PERM = false, AFTER_DRAIN = false;
    bf16_t* H; int ldh;
    __device__ __forceinline__ void operator()(const f32x4 (&acc)[2][2][4][2], const Unit& u, int wr, int wc, int fr, int fq) const {
        const int row0 = u.pm * BM + wr * 64 + fr, col0 = u.pn * 128 + wc * 16 + 4 * fq;
#pragma unroll
        for (int ai = 0; ai < 2; ++ai)
#pragma unroll
            for (int m = 0; m < 4; ++m) { bf16_t* rowp = H + (size_t)(row0 + ai * HALF + m * 16) * ldh + col0;
#pragma unroll
                for (int bj = 0; bj < 2; ++bj) { const f32x4 g = acc[ai][bj][m][0], uu = acc[ai][bj][m][1]; f32x4 hv;
#pragma unroll
                    for (int i = 0; i < 4; ++i) hv[i] = g[i] * sigm(g[i]) * uu[i];
                    u32x2 w; w.x = cvt_pk_bf16(hv[0], hv[1]); w.y = cvt_pk_bf16(hv[2], hv[3]);
                    *(u32x2*)(rowp + bj * 64) = w; } }
    }
};
struct EpiGLUResid {
    static constexpr bool PERM = false, AFTER_DRAIN = false;
    float* out; const float* gate;
    __device__ __forceinline__ void operator()(const f32x4 (&acc)[2][2][4][2], const Unit& u, int wr, int wc, int fr, int fq) const {
        const int row0 = u.pm * BM + wr * 64 + fr, col0 = u.pn * 128 + wc * 16 + 4 * fq;
#pragma unroll
        for (int ai = 0; ai < 2; ++ai)
#pragma unroll
            for (int m = 0; m < 4; ++m) { const int row = row0 + ai * HALF + m * 16;
                const float* grow = gate + (size_t)seq_of_row(row) * NMODC; float* orow = out + (size_t)row * 1024;
#pragma unroll
                for (int bj = 0; bj < 2; ++bj) { const int col = col0 + bj * 64; const f32x4 a = acc[ai][bj][m][0], b = acc[ai][bj][m][1];
                    const f32x4 x = *(const f32x4*)(orow + col), g = *(const f32x4*)(grow + col); f32x4 v;
#pragma unroll
                    for (int i = 0; i < 4; ++i) v[i] = x[i] + g[i] * (a[i] * sigm(b[i]));
                    *(f32x4*)(orow + col) = v; } }
    }
};
template <class Epi, class Sched, bool ALIGN_EPI = false, bool SP2 = false>
__device__ __forceinline__ void gemm_phase(PG8_LAS unsigned char* lds, const Gemm g, const Sched& S, const Epi& E) {
    const int tid = threadIdx.x, wid = __builtin_amdgcn_readfirstlane(tid >> 6), lane = tid & 63, wr = wid >> 2, wc = wid & 3, fr = lane & 15, fq = lane >> 4;
    const int K = g.K, nt = K / BK, ld = g.ld ? g.ld : g.K;
    unsigned voffA[2], voffB[2];
#pragma unroll
    for (int i = 0; i < 2; ++i) { int R, C; stage_rc(tid * 16 + i * 8192, R, C); const int Rb = Epi::PERM ? ((R & ~31) + perm32(R & 31)) : R;
        voffA[i] = (unsigned)(R * ld + C) * 2u; voffB[i] = (unsigned)(Rb * ld + C) * 2u; }
    const size_t kstep = (size_t)(BK * 2);
    const size_t hstep = (size_t)HALF * ld * 2;
    const size_t tstep = 2 * hstep;
    const unsigned ldsw = (unsigned)wid * 1024u;
    const int aoff = lds_byte(wr * 64 + fr, fq * 8), boff = lds_byte(wc * 32 + fr, fq * 8);
#define PG8_SA(b, h) (((b) * 2 + (h)) * HTB)
#define PG8_SB(b, h) ((4 + (b) * 2 + (h)) * HTB)
#define PG8_STAGE(bufoff, gbase, voff) do { _Pragma("unroll") for (int _i = 0; _i < 2; ++_i) \
        __builtin_amdgcn_global_load_lds((const unsigned*)((const char*)(gbase) + (voff)[_i]), (PG8_LAS unsigned*)(lds + (bufoff) + ldsw + _i * 8192), 16, 0, 0); } while (0)
#define PG8_LDA(dst, b, h) do { _Pragma("unroll") for (int m = 0; m < 4; ++m) _Pragma("unroll") for (int k = 0; k < 2; ++k) dst[m][k] = *(const PG8_LAS bf16x8*)(lds + PG8_SA(b, h) + aoff + m * 2048 + k * 1024); } while (0)
#define PG8_LDB(dst, b, h) do { _Pragma("unroll") for (int n = 0; n < 2; ++n) _Pragma("unroll") for (int k = 0; k < 2; ++k) dst[n][k] = *(const PG8_LAS bf16x8*)(lds + PG8_SB(b, h) + boff + n * 2048 + k * 1024); } while (0)
#define PG8_MMA(ai, bj, At, Bt) do { __builtin_amdgcn_s_setprio(1); _Pragma("unroll") for (int m = 0; m < 4; ++m) _Pragma("unroll") for (int n = 0; n < 2; ++n) _Pragma("unroll") for (int k = 0; k < 2; ++k) \
        acc[ai][bj][m][n] = __builtin_amdgcn_mfma_f32_16x16x32_bf16(Bt[n][k], At[m][k], acc[ai][bj][m][n], 0, 0, 0); __builtin_amdgcn_s_setprio(0); } while (0)
#define PG8_WAIT_V(n) asm volatile("s_waitcnt vmcnt(" #n ")" ::: "memory")
#define PG8_WAIT_L(n) asm volatile("s_waitcnt lgkmcnt(" #n ")" ::: "memory")
#define PG8_BAR __builtin_amdgcn_s_barrier()
#define PG8_SCHED __builtin_amdgcn_sched_barrier(0)
    Unit cur, nxt; int ui = 0;
    if (!S.next(0, cur)) return;
    f32x4 acc[2][2][4][2];
#pragma unroll
    for (int a = 0; a < 2; ++a)
#pragma unroll
        for (int b = 0; b < 2; ++b)
#pragma unroll
            for (int m = 0; m < 4; ++m)
#pragma unroll
                for (int n = 0; n < 2; ++n) acc[a][b][m][n] = (f32x4){0.f, 0.f, 0.f, 0.f};
    bf16x8 At[4][2], B0[2][2], B1[2][2];
    const char* cA = (const char*)g.A + (size_t)cur.pm * tstep + (size_t)cur.ks * K * 2; const char* cB = (const char*)g.Bt + (size_t)cur.pn * tstep + (size_t)cur.ks * K * 2;
    S.a_ready(cur);
    if constexpr (SP2) {
        PG8_STAGE(PG8_SB(0, 0), cB, voffB); PG8_STAGE(PG8_SB(0, 1), cB + hstep, voffB); PG8_STAGE(PG8_SA(0, 0), cA, voffA); PG8_STAGE(PG8_SA(0, 1), cA + hstep, voffA);
        if (wr == 1) PG8_BAR;
        PG8_WAIT_V(2); PG8_BAR;
        PG8_STAGE(PG8_SB(1, 0), cB + kstep, voffB); PG8_STAGE(PG8_SA(1, 0), cA + kstep, voffA); PG8_STAGE(PG8_SB(1, 1), cB + hstep + kstep, voffB);
        PG8_WAIT_V(6); PG8_BAR;
    } else {
        PG8_STAGE(PG8_SB(0, 0), cB, voffB); PG8_STAGE(PG8_SA(0, 0), cA, voffA); PG8_STAGE(PG8_SB(0, 1), cB + hstep, voffB); PG8_STAGE(PG8_SA(0, 1), cA + hstep, voffA);
        if (wr == 1) PG8_BAR;
        PG8_WAIT_V(4); PG8_BAR;
        PG8_STAGE(PG8_SB(1, 0), cB + kstep, voffB); PG8_STAGE(PG8_SA(1, 0), cA + kstep, voffA); PG8_STAGE(PG8_SB(1, 1), cB + hstep + kstep, voffB);
        PG8_WAIT_V(6); PG8_BAR;
    }
    for (;;) {
        const bool has_next = S.next(ui + 1, nxt);
        const char* nA = has_next ? (const char*)g.A + (size_t)nxt.pm * tstep + (size_t)nxt.ks * K * 2 : cA; const char* nB = has_next ? (const char*)g.Bt + (size_t)nxt.pn * tstep + (size_t)nxt.ks * K * 2 : cB;
        for (int t = 0; t < nt; t += 2) {
            const bool last = (t == nt - 2);
            const char* a1 = cA + (size_t)(t + 1) * kstep;
            const char* a2 = last ? nA : cA + (size_t)(t + 2) * kstep; const char* b2 = last ? nB : cB + (size_t)(t + 2) * kstep;
            const char* a3 = a2 + kstep; const char* b3 = b2 + kstep;
            if (last && has_next) S.a_ready(nxt);
            if constexpr (SP2) {
            PG8_LDB(B0, 0, 0); PG8_LDB(B1, 0, 1); PG8_SCHED; PG8_LDA(At, 0, 0); PG8_STAGE(PG8_SA(1, 1), a1 + hstep, voffA);
            PG8_WAIT_V(8); PG8_WAIT_L(0); PG8_BAR; PG8_MMA(0, 0, At, B0); PG8_MMA(0, 1, At, B1); PG8_BAR; PG8_SCHED;
            PG8_LDA(At, 0, 1); PG8_STAGE(PG8_SB(0, 0), b2, voffB); PG8_STAGE(PG8_SB(0, 1), b2 + hstep, voffB); PG8_STAGE(PG8_SA(0, 0), a2, voffA);
            PG8_WAIT_V(8); PG8_WAIT_L(0); PG8_BAR; PG8_MMA(1, 0, At, B0); PG8_MMA(1, 1, At, B1); PG8_BAR; PG8_SCHED;
            PG8_LDB(B0, 1, 0); PG8_LDB(B1, 1, 1); PG8_SCHED; PG8_LDA(At, 1, 0); PG8_STAGE(PG8_SA(0, 1), a2 + hstep, voffA);
            PG8_WAIT_V(8); PG8_WAIT_L(0); PG8_BAR; PG8_MMA(0, 0, At, B0); PG8_MMA(0, 1, At, B1); PG8_BAR; PG8_SCHED;
            PG8_LDA(At, 1, 1); PG8_STAGE(PG8_SB(1, 0), b3, voffB); PG8_STAGE(PG8_SB(1, 1), b3 + hstep, voffB); PG8_STAGE(PG8_SA(1, 0), a3, voffA);
            PG8_WAIT_V(8); PG8_WAIT_L(0); PG8_BAR; PG8_MMA(1, 0, At, B0); PG8_MMA(1, 1, At, B1); PG8_BAR; PG8_SCHED;
            } else {
            PG8_LDB(B0, 0, 0); PG8_SCHED; PG8_LDA(At, 0, 0); PG8_STAGE(PG8_SA(1, 1), a1 + hstep, voffA);
            PG8_WAIT_L(8); PG8_BAR; PG8_WAIT_L(0); PG8_MMA(0, 0, At, B0); PG8_BAR; PG8_SCHED;
            PG8_LDB(B1, 0, 1); PG8_STAGE(PG8_SB(0, 0), b2, voffB);
            PG8_BAR; PG8_WAIT_L(0); PG8_MMA(0, 1, At, B1); PG8_BAR;
            PG8_LDA(At, 0, 1); PG8_STAGE(PG8_SA(0, 0), a2, voffA);
            PG8_BAR; PG8_WAIT_L(0); PG8_MMA(1, 0, At, B0); PG8_BAR; PG8_SCHED;
            PG8_STAGE(PG8_SB(0, 1), b2 + hstep, voffB);
            PG8_WAIT_V(6); PG8_BAR; PG8_MMA(1, 1, At, B1); PG8_BAR;
            PG8_LDB(B0, 1, 0); PG8_SCHED; PG8_LDA(At, 1, 0); PG8_STAGE(PG8_SA(0, 1), a2 + hstep, voffA);
            PG8_WAIT_L(8); PG8_BAR; PG8_WAIT_L(0); PG8_MMA(0, 0, At, B0); PG8_BAR; PG8_SCHED;
            PG8_LDB(B1, 1, 1); PG8_STAGE(PG8_SB(1, 0), b3, voffB);
            PG8_BAR; PG8_WAIT_L(0); PG8_MMA(0, 1, At, B1); PG8_BAR;
            PG8_LDA(At, 1, 1); PG8_STAGE(PG8_SA(1, 0), a3, voffA);
            PG8_BAR; PG8_WAIT_L(0); PG8_MMA(1, 0, At, B0); PG8_BAR; PG8_SCHED;
            PG8_STAGE(PG8_SB(1, 1), b3 + hstep, voffB);
            PG8_WAIT_V(6); PG8_BAR; PG8_MMA(1, 1, At, B1); PG8_BAR;
            }
        }
        if constexpr (ALIGN_EPI) { if (wr == 0) PG8_BAR; }
        if constexpr (!Epi::AFTER_DRAIN) { E(acc, cur, wr, wc, fr, fq); S.done(cur); }
        if (!has_next) break;
#pragma unroll
        for (int a = 0; a < 2; ++a)
#pragma unroll
            for (int b = 0; b < 2; ++b)
#pragma unroll
                for (int m = 0; m < 4; ++m)
#pragma unroll
                    for (int n = 0; n < 2; ++n) acc[a][b][m][n] = (f32x4){0.f, 0.f, 0.f, 0.f};
        cur = nxt; cA = nA; cB = nB; ++ui;
        if constexpr (ALIGN_EPI) { if (wr == 1) PG8_BAR; }
    }
    PG8_WAIT_V(0);
    if constexpr (!ALIGN_EPI) { if (wr == 0) PG8_BAR; }
    PG8_BAR;
    if constexpr (Epi::AFTER_DRAIN) { E.fused(acc, cur, wr, wc, fr, fq, lds, wid, lane); S.done(cur); }
#undef PG8_SA
#undef PG8_SB
#undef PG8_STAGE
#undef PG8_LDA
#undef PG8_LDB
#undef PG8_MMA
#undef PG8_WAIT_V
#undef PG8_WAIT_L
#undef PG8_BAR
#undef PG8_SCHED
}
}

constexpr int TP = 16384, TS = 1024, MT = TP + TS, DM = 1024, NBATCH = 128;
constexpr int NIN = 2816, DFF = 2816, NMOD = 12288, LMOD = 6144;
constexpr float EPSN = 1e-6f, LOG2E = 1.4426950408889634f;
constexpr int NWAVES = 8;
constexpr size_t O_Y = 0, O_PK = (size_t)MT * DM, O_PV = O_PK + 16384, O_PRET = O_PV + 16384, O_PS5R = O_PRET + 65536, O_PS5I = O_PS5R + 4096,
                 O_SK = O_PS5I + 4096, O_SV = O_SK + 2097152, O_SRET = O_SV + 2097152, O_SS5R = O_SRET + 8388608, O_SS5I = O_SS5R + 524288, O_END = O_SS5I + 524288;
constexpr size_t MiB = 1u << 20;
constexpr size_t WS_CA = 1 * MiB, WS_MOD = 2 * MiB, WS_S5P = 14 * MiB, WS_WIN = 16 * MiB, WS_WOUT = 22 * MiB, WS_WGU0 = 24 * MiB, WS_WGU1 = 35 * MiB,
                 WS_WD0 = 46 * MiB, WS_WD1 = 52 * MiB, WS_WGLU = 58 * MiB, WS_XN = 62 * MiB, WS_RKV = 62 * MiB, WS_MIX = 96 * MiB, WS_PROJ = 130 * MiB,
                 WS_WADA = 130 * MiB, WS_S5E = 130 * MiB, WS_S5H = 134 * MiB, WS_SIN = 224 * MiB, WS_PART0 = 240 * MiB, WS_PART1 = 248 * MiB, WS_END = 256 * MiB;
constexpr size_t S5_LAM = 0, S5_LAM128 = 32768, S5_BBT = 65536, S5_CCT = 65536 + 262144;
constexpr int LDS_BYTES = 147456;

#define LAS __attribute__((address_space(3)))
typedef unsigned short bf16;
typedef unsigned u32x4 __attribute__((ext_vector_type(4)));
typedef unsigned u32x2 __attribute__((ext_vector_type(2)));
typedef float f32x4 __attribute__((ext_vector_type(4)));
typedef float f32x2 __attribute__((ext_vector_type(2)));
typedef float f32x16 __attribute__((ext_vector_type(16)));
typedef short bf16x8 __attribute__((ext_vector_type(8)));
typedef short s16x4 __attribute__((ext_vector_type(4)));
typedef short v4i16_t __attribute__((ext_vector_type(4)));
typedef __bf16 bf16x2_t __attribute__((ext_vector_type(2)));
#define DI __device__ __forceinline__
#define MFMA32(a, b, c) __builtin_amdgcn_mfma_f32_32x32x16_bf16((a), (b), (c), 0, 0, 0)
DI unsigned pk2(float lo, float hi) { f32x2 v = {lo, hi}; bf16x2_t b = __builtin_convertvector(v, bf16x2_t); return __builtin_bit_cast(unsigned, b); }
DI unsigned short f2bf(float f) { return (unsigned short)(pk2(f, 0.f) & 0xffffu); }
DI float bflo(unsigned w) { return __uint_as_float(w << 16); }
DI float bfhi(unsigned w) { return __uint_as_float(w & 0xffff0000u); }
DI float bf2f(unsigned short b) { return __uint_as_float((unsigned)b << 16); }
DI int crow(int r, int h) { return (r & 3) + 8 * (r >> 2) + 4 * h; }
DI float wave_sum(float v) {
#pragma unroll
    for (int o = 1; o < 64; o <<= 1) v += __shfl_xor(v, o);
    return v;
}
DI s16x4 tr_read(const LAS unsigned char* p) { return __builtin_bit_cast(s16x4, __builtin_amdgcn_ds_read_tr16_b64_v4i16((LAS v4i16_t*)p)); }
DI bf16x8 tr_frag(const LAS unsigned char* lo, int hi_off) { const s16x4 a = tr_read(lo), b = tr_read(lo + hi_off); return __builtin_shufflevector(a, b, 0, 1, 2, 3, 4, 5, 6, 7); }
DI bf16x8 pack8(float a0, float a1, float a2, float a3, float a4, float a5, float a6, float a7) {
    u32x4 p; p.x = pk2(a0, a1); p.y = pk2(a2, a3); p.z = pk2(a4, a5); p.w = pk2(a6, a7); return __builtin_bit_cast(bf16x8, p);
}
#define PACK_STEP(x, s) pack8((x)[8 * (s)], (x)[8 * (s) + 1], (x)[8 * (s) + 2], (x)[8 * (s) + 3], (x)[8 * (s) + 4], (x)[8 * (s) + 5], (x)[8 * (s) + 6], (x)[8 * (s) + 7])
DI f32x16 zero16() { f32x16 z;
#pragma unroll
    for (int i = 0; i < 16; ++i) z[i] = 0.f; return z; }
DI void unpack8(const u32x4 w, float* f) { f[0] = bflo(w.x); f[1] = bfhi(w.x); f[2] = bflo(w.y); f[3] = bfhi(w.y); f[4] = bflo(w.z); f[5] = bfhi(w.z); f[6] = bflo(w.w); f[7] = bfhi(w.w); }

struct Args { const float* in[32]; float* out; unsigned char* ws; int ph_lo, ph_hi; };
struct Frame {
    LAS unsigned char* lds; int tid, lane, wave, G, bid;
    float* out; unsigned char* ws;
    DI bf16* CA() const { return (bf16*)(ws + WS_CA); }
    DI bf16* Win_t() const { return (bf16*)(ws + WS_WIN); }
    DI bf16* Wout_t() const { return (bf16*)(ws + WS_WOUT); }
    DI bf16* Wgu_t(int l) const { return (bf16*)(ws + (l ? WS_WGU1 : WS_WGU0)); }
    DI bf16* Wd_t(int l) const { return (bf16*)(ws + (l ? WS_WD1 : WS_WD0)); }
    DI bf16* Wglu_t() const { return (bf16*)(ws + WS_WGLU); }
    DI bf16* Wada_t() const { return (bf16*)(ws + WS_WADA); }
    DI bf16* XN() const { return (bf16*)(ws + WS_XN); }
    DI bf16* MIX() const { return (bf16*)(ws + WS_MIX); }
    DI bf16* PROJ() const { return (bf16*)(ws + WS_PROJ); }
    DI bf16* SIN() const { return (bf16*)(ws + WS_SIN); }
    DI float* MOD() const { return (float*)(ws + WS_MOD); }
    DI float* RKV() const { return (float*)(ws + WS_RKV); }
    DI float* S5E() const { return (float*)(ws + WS_S5E); }
    DI float* S5H() const { return (float*)(ws + WS_S5H); }
};
enum { I_XP = 0, I_XS, I_CK, I_CV, I_SRET, I_S5R, I_S5I, I_CP, I_CS, I_ADAW, I_ADAB, I_NMIX, I_NFFN, I_WG, I_WU, I_WD, I_WIN, I_QG, I_KG, I_SINK, I_RG, I_WOUT,
       I_ARE, I_AIM, I_LDT, I_BRE, I_BIM, I_CRE, I_CIM, I_DSK, I_GLA, I_GLB };

DI void transpose_item(const float* W, int K, int N, bf16* WT, int rs, int ro, LAS float* scr, int item, int lane) {
    const int nblk = N / 32, kb = item / nblk, nb = item % nblk, k0 = 64 * kb, n0 = 32 * nb;
#pragma unroll 8
    for (int i = 0; i < 32; ++i) { const int kk = 2 * i + (lane >> 5); scr[kk * 33 + (lane & 31)] = W[(size_t)(k0 + kk) * N + n0 + (lane & 31)]; }
    asm volatile("s_waitcnt lgkmcnt(0)" ::: "memory");
    const int c = lane & 7;
#pragma unroll
    for (int j = 0; j < 4; ++j) { const int n = (lane >> 3) + 8 * j; const LAS float* s = scr + (8 * c) * 33 + n;
        u32x4 o; o.x = pk2(s[0 * 33], s[1 * 33]); o.y = pk2(s[2 * 33], s[3 * 33]); o.z = pk2(s[4 * 33], s[5 * 33]); o.w = pk2(s[6 * 33], s[7 * 33]);
        const int nn = n0 + n, drow = (nn >> 4) * rs + (nn & 15) + ro;
        *(u32x4*)(WT + (size_t)drow * K + k0 + 8 * c) = o; }
    asm volatile("s_waitcnt lgkmcnt(0)" ::: "memory");
}
DI void p0_prologue(const Args& A, const Frame& F) {
    LAS float* scr = (LAS float*)(F.lds + F.wave * 16384);
    const int gw = F.bid * NWAVES + F.wave, NGW = F.G * NWAVES;
    constexpr int I_A = 16 * 88, I_B = 16 * 32, I_C = 44 * 32, I_E = 16 * 192;
    constexpr int NITEMS = I_A + I_B + 4 * I_A + 2 * I_C + 2 * I_B + 2 * I_E;
    for (int it = gw; it < NITEMS; it += NGW) {
        int r = it;
        if (r < I_A) { transpose_item(A.in[I_WIN], 1024, NIN, F.Win_t(), 16, 0, scr, r, F.lane); continue; } r -= I_A;
        if (r < I_B) { transpose_item(A.in[I_WOUT], 1024, 1024, F.Wout_t(), 16, 0, scr, r, F.lane); continue; } r -= I_B;
        if (r < 4 * I_A) { const int which = r / I_A, rr = r % I_A, l = which >> 1, up = which & 1;
            transpose_item(A.in[up ? I_WU : I_WG] + (size_t)l * 1024 * DFF, 1024, DFF, F.Wgu_t(l), 32, up * 16, scr, rr, F.lane); continue; } r -= 4 * I_A;
        if (r < 2 * I_C) { const int l = r / I_C, rr = r % I_C; transpose_item(A.in[I_WD] + (size_t)l * DFF * 1024, DFF, 1024, F.Wd_t(l), 16, 0, scr, rr, F.lane); continue; } r -= 2 * I_C;
        if (r < 2 * I_B) { const int b = r / I_B, rr = r % I_B; transpose_item(A.in[b ? I_GLB : I_GLA], 1024, 1024, F.Wglu_t(), 32, b * 16, scr, rr, F.lane); continue; } r -= 2 * I_B;
        { const int l = r / I_E, rr = r % I_E; transpose_item(A.in[I_ADAW] + (size_t)l * 1024 * LMOD, 1024, LMOD, F.Wada_t(), 16, l * LMOD, scr, rr, F.lane); }
    }
    const int gt = F.bid * 512 + F.tid, NGT = F.G * 512;
    for (int idx = gt; idx < 256 * 1024; idx += NGT) { const int row = idx >> 10, col = idx & 1023;
        float v = 0.f; if (row == 0) v = A.in[I_CP][col]; else if (row <= NBATCH) v = A.in[I_CS][(row - 1) * 1024 + col];
        F.CA()[idx] = f2bf(v * pg8::sigm(v)); }
    if (gt < 65536) {
        const int gp = gt >> 4, i = gt & 15, g = gp >> 6, p = gp & 63;
        const float are = A.in[I_ARE][gp], aim = A.in[I_AIM][gp], dt = expf(A.in[I_LDT][g]);
        const float a = are * dt, b = aim * dt; const float mag = expf(a), cb = cosf(b), sb = sinf(b), sh = sinf(0.5f * b);
        const float lr = mag * cb, li = mag * sb;
        const float nr = expm1f(a) * cb - 2.f * sh * sh, ni = li;
        const float den = are * are + aim * aim; const float fr = (nr * are + ni * aim) / den, fi = (ni * are - nr * aim) / den;
        bf16* BBt = (bf16*)(F.ws + WS_S5P + S5_BBT); bf16* CCt = (bf16*)(F.ws + WS_S5P + S5_CCT);
        const float br = A.in[I_BRE][gt], bi = A.in[I_BIM][gt];
        BBt[(g * 128 + p) * 16 + i] = f2bf(fr * br - fi * bi); BBt[(g * 128 + 64 + p) * 16 + i] = f2bf(fr * bi + fi * br);
        { const int go = gt >> 6, pp = gt & 63;
          CCt[go * 128 + pp] = f2bf(A.in[I_CRE][go * 64 + pp]); CCt[go * 128 + 64 + pp] = f2bf(-A.in[I_CIM][go * 64 + pp]); }
        if (i == 0) {
            float* P = (float*)(F.ws + WS_S5P);
            P[(S5_LAM >> 2) + 2 * gp] = lr; P[(S5_LAM >> 2) + 2 * gp + 1] = li;
            float pr = lr, pi = li;
#pragma unroll
            for (int k = 0; k < 7; ++k) { const float t = pr * pr - pi * pi; pi = 2.f * pr * pi; pr = t; }
            P[(S5_LAM128 >> 2) + 2 * gp] = pr; P[(S5_LAM128 >> 2) + 2 * gp + 1] = pi;
        }
    }
}

DI void norm_phase(const Args& A, const Frame& F, const float* xp, const float* xs, const float* gamma, const float* mod, int sh_off, int sc_off, const bf16* part = nullptr, int ns = 0, const float* pgate = nullptr, float* xw = nullptr, const bf16* gpart = nullptr) {
    const int gw = F.bid * NWAVES + F.wave, NGW = F.G * NWAVES;
    f32x4 gmv[4];
#pragma unroll
    for (int j = 0; j < 4; ++j) gmv[j] = *(const f32x4*)(gamma + 4 * (64 * j + F.lane));
    for (int m = gw; m < MT; m += NGW) {
        const float* xrow = m < TP ? xp + (size_t)m * DM : xs + (size_t)(m - TP) * DM;
        const float* mrow = mod + (size_t)pg8::seq_of_row(m) * NMOD;
        f32x4 v[4], scv[4], shv[4]; float ss = 0.f;
#pragma unroll
        for (int j = 0; j < 4; ++j) { const int col = 4 * (64 * j + F.lane); scv[j] = *(const f32x4*)(mrow + sc_off + col); shv[j] = *(const f32x4*)(mrow + sh_off + col); }
#pragma unroll
        for (int j = 0; j < 4; ++j) { v[j] = *(const f32x4*)(xrow + 4 * (64 * j + F.lane));
            if (part && m >= TP) { const int col = 4 * (64 * j + F.lane); const size_t po = (size_t)(m - TP) * 1024 + col;
                const f32x4 g = *(const f32x4*)(pgate + (size_t)pg8::seq_of_row(m) * NMOD + col); f32x4 ps = (f32x4){0.f, 0.f, 0.f, 0.f};
                for (int sl = 0; sl < ns; ++sl) { const u32x2 w = *(const u32x2*)(part + (size_t)sl * TS * 1024 + po); ps += (f32x4){bflo(w.x), bfhi(w.x), bflo(w.y), bfhi(w.y)}; }
                v[j] = v[j] + g * ps; *(f32x4*)(xw + (size_t)m * DM + col) = v[j]; }
            if (gpart && m >= TP) { const int col = 4 * (64 * j + F.lane); const size_t po = (size_t)(m - TP) * 2048 + (col >> 4) * 32 + (col & 15);
                const f32x4 g = *(const f32x4*)(pgate + (size_t)pg8::seq_of_row(m) * NMOD + col); f32x4 pa = (f32x4){0.f, 0.f, 0.f, 0.f}, pb = pa;
                for (int sl = 0; sl < ns; ++sl) { const u32x2 wa = *(const u32x2*)(gpart + (size_t)sl * TS * 2048 + po), wb = *(const u32x2*)(gpart + (size_t)sl * TS * 2048 + po + 16);
                    pa += (f32x4){bflo(wa.x), bfhi(wa.x), bflo(wa.y), bfhi(wa.y)}; pb += (f32x4){bflo(wb.x), bfhi(wb.x), bflo(wb.y), bfhi(wb.y)}; }
                f32x4 gl; gl.x = pa.x * pg8::sigm(pb.x); gl.y = pa.y * pg8::sigm(pb.y); gl.z = pa.z * pg8::sigm(pb.z); gl.w = pa.w * pg8::sigm(pb.w);
                v[j] = v[j] + g * gl; *(f32x4*)(xw + (size_t)m * DM + col) = v[j]; }
            ss += (v[j].x * v[j].x + v[j].y * v[j].y) + (v[j].z * v[j].z + v[j].w * v[j].w); }
        const float rstd = rsqrtf(wave_sum(ss) * (1.f / DM) + EPSN);
#pragma unroll
        for (int j = 0; j < 4; ++j) { const int col = 4 * (64 * j + F.lane);
            const f32x4 g = gmv[j], sc = scv[j], sh = shv[j];
            const f32x4 y = v[j] * rstd * g * (1.f + sc) + sh;
            u32x2 w; w.x = pk2(y.x, y.y); w.y = pk2(y.z, y.w); *(u32x2*)(F.XN() + (size_t)m * DM + col) = w; }
    }
}

template <bool SAMPLE> DI void attn_unit(const Args& A, const Frame& F, int uidx) {
    LAS unsigned char* Kl = F.lds; LAS unsigned char* Vl = F.lds + 46080;
    int tid = F.tid; asm volatile("" : "+v"(tid)); const int lane = tid & 63, w = F.wave;
    const int q0 = SAMPLE ? 0 : 32 * uidx, b = uidx;
    const float* kgain = A.in[I_KG];
    __syncthreads();
#pragma unroll
    for (int it = 0; it < 5; ++it) {
        const int t = tid + 512 * it, ch = t & 7, rr = t >> 3, kv = rr >= 160 ? 1 : 0, kk = rr - 160 * kv;
        float kf[8], vf[8]; bool valid = true, donorm = true; int tok = 0;
        if (SAMPLE) {
            if (kk < 128) { donorm = false; const size_t o = ((size_t)(b * 128 + kk) * 2 + kv) * 64 + 8 * ch;
                const f32x4 k0 = *(const f32x4*)(A.in[I_CK] + o), k1 = *(const f32x4*)(A.in[I_CK] + o + 4), v0 = *(const f32x4*)(A.in[I_CV] + o), v1 = *(const f32x4*)(A.in[I_CV] + o + 4);
                kf[0] = k0.x; kf[1] = k0.y; kf[2] = k0.z; kf[3] = k0.w; kf[4] = k1.x; kf[5] = k1.y; kf[6] = k1.z; kf[7] = k1.w;
                vf[0] = v0.x; vf[1] = v0.y; vf[2] = v0.z; vf[3] = v0.w; vf[4] = v1.x; vf[5] = v1.y; vf[6] = v1.z; vf[7] = v1.w; }
            else { valid = kk < 136; tok = TP + b * 8 + ((kk - 128) & 7); }
        } else { tok = q0 - 128 + kk; valid = tok >= 0; if (!valid) tok = 0; }
        if (!SAMPLE || kk >= 128) {
            const bf16* src = F.PROJ() + (size_t)tok * NIN + 512 + kv * 64 + 8 * ch;
            const u32x4 kw = *(const u32x4*)src, vw = *(const u32x4*)(src + 128);
            unpack8(kw, kf); unpack8(vw, vf);
        }
        float ss = 0.f;
#pragma unroll
        for (int j = 0; j < 8; ++j) ss += kf[j] * kf[j];
        ss += __shfl_xor(ss, 1); ss += __shfl_xor(ss, 2); ss += __shfl_xor(ss, 4);
        const float rstd = rsqrtf(ss * (1.f / 64.f) + EPSN);
#pragma unroll
        for (int j = 0; j < 8; ++j) { if (donorm) kf[j] = kf[j] * rstd * kgain[8 * ch + j]; if (!valid) { kf[j] = 0.f; vf[j] = 0.f; } }
        const int lo = ((kv * 160 + kk) * 72 + 8 * ch) * 2;
        *(LAS u32x4*)(Kl + lo) = (u32x4){pk2(kf[0], kf[1]), pk2(kf[2], kf[3]), pk2(kf[4], kf[5]), pk2(kf[6], kf[7])};
        *(LAS u32x4*)(Vl + lo) = (u32x4){pk2(vf[0], vf[1]), pk2(vf[2], vf[3]), pk2(vf[4], vf[5]), pk2(vf[6], vf[7])};
        float* ok = nullptr; float* ov = nullptr;
        if (SAMPLE) { if (kk >= 8 && kk < 136) { const size_t o = ((size_t)(b * 128 + kk - 8) * 2 + kv) * 64 + 8 * ch; ok = F.out + O_SK + o; ov = F.out + O_SV + o; } }
        else { if (q0 == TP - 32 && kk >= 32) { const size_t o = ((size_t)(kk - 32) * 2 + kv) * 64 + 8 * ch; ok = F.out + O_PK + o; ov = F.out + O_PV + o; } }
        if (ok) { *(f32x4*)ok = (f32x4){kf[0], kf[1], kf[2], kf[3]}; *(f32x4*)(ok + 4) = (f32x4){kf[4], kf[5], kf[6], kf[7]};
                  *(f32x4*)ov = (f32x4){vf[0], vf[1], vf[2], vf[3]}; *(f32x4*)(ov + 4) = (f32x4){vf[4], vf[5], vf[6], vf[7]}; }
    }
    const int n = lane & 31, h = lane >> 5, hh = w, kvh = hh >> 2;
    const int qtok = SAMPLE ? TP + b * 8 + (n & 7) : q0 + n;
    bf16x8 qf[4];
    {
        const bf16* qp = F.PROJ() + (size_t)qtok * NIN + hh * 64 + 8 * h; float qv[4][8]; float ss = 0.f;
#pragma unroll
        for (int s = 0; s < 4; ++s) { const u32x4 raw = *(const u32x4*)(qp + 16 * s); unpack8(raw, qv[s]);
#pragma unroll
            for (int j = 0; j < 8; ++j) ss += qv[s][j] * qv[s][j]; }
        ss += __shfl_xor(ss, 32);
        const float rstd = rsqrtf(ss * (1.f / 64.f) + EPSN) * (0.125f * LOG2E);
        const float* qg = A.in[I_QG];
#pragma unroll
        for (int s = 0; s < 4; ++s) { float t[8];
#pragma unroll
            for (int j = 0; j < 8; ++j) t[j] = qv[s][j] * rstd * qg[16 * s + 8 * h + j];
            qf[s] = pack8(t[0], t[1], t[2], t[3], t[4], t[5], t[6], t[7]); }
    }
    __syncthreads();
    f32x16 S[5];
#pragma unroll
    for (int kt = 0; kt < 5; ++kt) { S[kt] = zero16();
#pragma unroll
        for (int s = 0; s < 4; ++s) { const bf16x8 a = *(const LAS bf16x8*)(Kl + ((kvh * 160 + 32 * kt + n) * 72 + 16 * s + 8 * h) * 2); S[kt] = MFMA32(a, qf[s], S[kt]); } __builtin_amdgcn_sched_barrier(0); }
    const float slope2 = exp2f(-(float)(hh + 1)) * LOG2E, sink2 = A.in[I_SINK][hh] * LOG2E;
    float mx = -1e30f;
#pragma unroll
    for (int kt = 0; kt < 5; ++kt)
#pragma unroll
        for (int r = 0; r < 16; ++r) { const int kidx = 32 * kt + crow(r, h), dist = 128 + n - kidx;
            const bool okk = dist >= 0 && dist < 128 && (SAMPLE || q0 - 128 + kidx >= 0);
            const float v = okk ? S[kt][r] - slope2 * (float)dist : -1e30f; S[kt][r] = v; mx = fmaxf(mx, v); }
    mx = fmaxf(mx, __shfl_xor(mx, 32)); mx = fmaxf(mx, sink2);
    float sum = 0.f;
    bf16x8 pfs[5][2];
#pragma unroll
    for (int kt = 0; kt < 5; ++kt)
#pragma unroll
        for (int s2 = 0; s2 < 2; ++s2) { float p[8];
#pragma unroll
            for (int j = 0; j < 8; ++j) { p[j] = exp2f(S[kt][8 * s2 + j] - mx); sum += p[j]; }
            pfs[kt][s2] = pack8(p[0], p[1], p[2], p[3], p[4], p[5], p[6], p[7]); }
    sum += __shfl_xor(sum, 32);
    const float inv = 1.f / (sum + exp2f(sink2 - mx));
    __builtin_amdgcn_sched_barrier(0);
    f32x16 O[2]; O[0] = zero16(); O[1] = zero16();
    const int i16 = lane & 15, tq = i16 >> 2, tp = i16 & 3, blk = (lane >> 4) & 1;
    const LAS unsigned char* vbase = Vl + ((kvh * 160 + 4 * h + tq) * 72 + 16 * blk + 4 * tp) * 2;
#pragma unroll
    for (int kt = 0; kt < 5; ++kt) {
#pragma unroll
        for (int s2 = 0; s2 < 2; ++s2) {
#pragma unroll
            for (int dt = 0; dt < 2; ++dt) { const bf16x8 vfr = tr_frag(vbase + ((32 * kt + 16 * s2) * 72 + 32 * dt) * 2, 8 * 72 * 2);
                O[dt] = MFMA32(vfr, pfs[kt][s2], O[dt]); } }
        __builtin_amdgcn_sched_barrier(0); }
    if (!SAMPLE || n < 8) {
        bf16* op = F.MIX() + (size_t)qtok * DM + hh * 64;
#pragma unroll
        for (int dt = 0; dt < 2; ++dt)
#pragma unroll
            for (int g4 = 0; g4 < 4; ++g4) { u32x2 wv; wv.x = pk2(O[dt][4 * g4] * inv, O[dt][4 * g4 + 1] * inv); wv.y = pk2(O[dt][4 * g4 + 2] * inv, O[dt][4 * g4 + 3] * inv);
                *(u32x2*)(op + 32 * dt + 8 * g4 + 4 * h) = wv; }
    }
}

DI float ret_log2g(int head) { return log2f(1.0f - exp2f(-5.0f - (float)head)); }
constexpr float KSC = 0.08838834764831845f;
DI void ret_kv_unit(const Args& A, const Frame& F, int uidx) {
    const int c = uidx >> 2, head = uidx & 3; int tid = F.tid; asm volatile("" : "+v"(tid)); const int lane = tid & 63, w = F.wave;
    LAS unsigned char* Kl = F.lds; LAS unsigned char* Vl = F.lds + 34816;
    const float lg = ret_log2g(head);
    __syncthreads();
#pragma unroll
    for (int it = 0; it < 8; ++it) { const int t = tid + 512 * it, ch = t & 15, j = (t >> 4) & 127, isv = t >> 11;
        const bf16* src = F.PROJ() + (size_t)(c * 128 + j) * NIN + (isv ? 1792 : 1280) + head * 128 + 8 * ch;
        u32x4 wv = *(const u32x4*)src;
        if (!isv) { float f[8]; unpack8(wv, f); const float sc = KSC * exp2f(lg * (float)(127 - j));
            wv = (u32x4){pk2(f[0] * sc, f[1] * sc), pk2(f[2] * sc, f[3] * sc), pk2(f[4] * sc, f[5] * sc), pk2(f[6] * sc, f[7] * sc)}; }
        *(LAS u32x4*)((isv ? Vl : Kl) + (j * 136 + 8 * ch) * 2) = wv; }
    __syncthreads();
    const int n = lane & 31, h = lane >> 5, i16 = lane & 15, tq = i16 >> 2, tp = i16 & 3, blk = (lane >> 4) & 1;
    const int et = w >> 1, dt0 = 2 * (w & 1);
    f32x16 acc[2]; acc[0] = zero16(); acc[1] = zero16();
#pragma unroll
    for (int s = 0; s < 8; ++s) { const int rowoff = (16 * s + 8 * h + tq) * 136;
        const bf16x8 a = tr_frag(Vl + (rowoff + 32 * et + 16 * blk + 4 * tp) * 2, 4 * 136 * 2);
#pragma unroll
        for (int x = 0; x < 2; ++x) { const bf16x8 bb = tr_frag(Kl + (rowoff + 32 * (dt0 + x) + 16 * blk + 4 * tp) * 2, 4 * 136 * 2); acc[x] = MFMA32(a, bb, acc[x]); } }
    float* dst = F.RKV() + ((size_t)(c * 4 + head) * 128) * 128;
#pragma unroll
    for (int x = 0; x < 2; ++x)
#pragma unroll
        for (int r = 0; r < 16; ++r) dst[(size_t)(32 * et + crow(r, h)) * 128 + 32 * (dt0 + x) + n] = acc[x][r];
}
DI void ret_scan_phase(const Args& A, const Frame& F) {
    const int gt = F.bid * 512 + F.tid;
    if (gt < 65536) { const int head = gt >> 14, e = (gt >> 7) & 127, d = gt & 127;
        const float dc = exp2f(ret_log2g(head) * 128.f); float S = 0.f;
#pragma unroll 8
        for (int c = 0; c < 128; ++c) { F.SIN()[(size_t)c * 65536 + gt] = f2bf(S); S = S * dc + F.RKV()[(size_t)c * 65536 + gt]; }
        ((float*)(F.ws + WS_S5P + MiB))[gt] = S; (void)head; (void)e; (void)d; }
}
DI void pret_transpose_tile(const Args& A, const Frame& F, int tile) {
    const int head = tile >> 4, et = (tile >> 2) & 3, dt = tile & 3; LAS float* T = (LAS float*)F.lds;
    const float* src = (const float*)(F.ws + WS_S5P + MiB) + (size_t)head * 16384; float* dst = F.out + O_PRET + (size_t)head * 16384;
    __syncthreads();
    for (int idx = F.tid; idx < 1024; idx += 512) { const int el = idx >> 5, dl = idx & 31; T[el * 33 + dl] = src[(32 * et + el) * 128 + 32 * dt + dl]; }
    __syncthreads();
    for (int idx = F.tid; idx < 1024; idx += 512) { const int dl = idx >> 5, el = idx & 31; dst[(32 * dt + dl) * 128 + 32 * et + el] = T[el * 33 + dl]; }
    __syncthreads();
}
DI void ret_out_prompt(const Args& A, const Frame& F, int bu) {
    const int c = bu >> 1, hp = bu & 1; int tid = F.tid; asm volatile("" : "+v"(tid)); const int lane = tid & 63, w = F.wave;
    LAS unsigned char* Vl = F.lds;
    __syncthreads();
#pragma unroll
    for (int it = 0; it < 8; ++it) { const int t = tid + 512 * it, ch = t & 15, j = (t >> 4) & 127, hl = t >> 11;
        *(LAS u32x4*)(Vl + ((hl * 128 + j) * 136 + 8 * ch) * 2) = *(const u32x4*)(F.PROJ() + (size_t)(c * 128 + j) * NIN + 1792 + (2 * hp + hl) * 128 + 8 * ch); }
    __syncthreads();
    const int hl = w >> 2, it = w & 3, head = 2 * hp + hl, n = lane & 31, h = lane >> 5, i16 = lane & 15, tq = i16 >> 2, tp = i16 & 3, blk = (lane >> 4) & 1;
    const int tok = c * 128 + 32 * it + n; const float lg = ret_log2g(head);
    bf16x8 qf[8];
#pragma unroll
    for (int s = 0; s < 8; ++s) qf[s] = *(const bf16x8*)(F.PROJ() + (size_t)tok * NIN + 768 + head * 128 + 16 * s + 8 * h);
    f32x16 acc[4];
#pragma unroll
    for (int et = 0; et < 4; ++et) { acc[et] = zero16();
#pragma unroll
        for (int s = 0; s < 8; ++s) { const bf16x8 a = *(const bf16x8*)(F.SIN() + ((size_t)(c * 4 + head) * 128 + 32 * et + n) * 128 + 16 * s + 8 * h); acc[et] = MFMA32(a, qf[s], acc[et]); } }
    const float dq = exp2f(lg * (float)(32 * it + n + 1));
#pragma unroll
    for (int et = 0; et < 4; ++et) acc[et] = acc[et] * dq;
#pragma unroll 1
    for (int jt = 0; jt <= it; ++jt) {
        f32x16 X = zero16();
#pragma unroll
        for (int s = 0; s < 8; ++s) { const bf16x8 a = *(const bf16x8*)(F.PROJ() + (size_t)(c * 128 + 32 * jt + n) * NIN + 1280 + head * 128 + 16 * s + 8 * h); X = MFMA32(a, qf[s], X); }
#pragma unroll
        for (int r = 0; r < 16; ++r) { const int dd = 32 * it + n - (32 * jt + crow(r, h)); X[r] = dd >= 0 ? X[r] * (KSC * exp2f(lg * (float)dd)) : 0.f; }
#pragma unroll
        for (int s2 = 0; s2 < 2; ++s2) { const bf16x8 pf = PACK_STEP(X, s2);
#pragma unroll
            for (int et = 0; et < 4; ++et) { const bf16x8 vfr = tr_frag(Vl + ((hl * 128 + 32 * jt + 16 * s2 + 4 * h + tq) * 136 + 32 * et + 16 * blk + 4 * tp) * 2, 8 * 136 * 2);
                acc[et] = MFMA32(vfr, pf, acc[et]); } }
    }
    float sum = 0.f;
#pragma unroll
    for (int et = 0; et < 4; ++et)
#pragma unroll
        for (int r = 0; r < 16; ++r) sum += acc[et][r];
    sum += __shfl_xor(sum, 32); const float mean = sum * (1.f / 128.f); float var = 0.f;
#pragma unroll
    for (int et = 0; et < 4; ++et)
#pragma unroll
        for (int r = 0; r < 16; ++r) { const float dlt = acc[et][r] - mean; var += dlt * dlt; }
    var += __shfl_xor(var, 32); const float rstd = rsqrtf(var * (1.f / 128.f) + EPSN);
    const bf16* gp = F.PROJ() + (size_t)tok * NIN + 2304 + head * 128; bf16* op = F.MIX() + (size_t)tok * DM + 512 + head * 128; const float* rg = A.in[I_RG] + head * 128;
#pragma unroll
    for (int et = 0; et < 4; ++et)
#pragma unroll
        for (int g4 = 0; g4 < 4; ++g4) { const int e0 = 32 * et + 8 * g4 + 4 * h; const u32x2 gw = *(const u32x2*)(gp + e0); const f32x4 rgv = *(const f32x4*)(rg + e0);
            float gv[4] = {bflo(gw.x), bfhi(gw.x), bflo(gw.y), bfhi(gw.y)}; float y[4];
#pragma unroll
            for (int i = 0; i < 4; ++i) y[i] = (acc[et][4 * g4 + i] - mean) * rstd * rgv[i] * (gv[i] * pg8::sigm(gv[i]));
            u32x2 wv; wv.x = pk2(y[0], y[1]); wv.y = pk2(y[2], y[3]); *(u32x2*)(op + e0) = wv; }
}
DI void ret_sample_unit(const Args& A, const Frame& F, int uidx) {
    const int b = uidx >> 2, head = uidx & 3; const int tid = F.tid, lane = F.lane, w = F.wave;
    LAS float* Q = (LAS float*)F.lds; LAS float* Ks = Q + 1024; LAS float* V = Ks + 1024; LAS float* INN = V + 1024; LAS float* OO = INN + 64; LAS float* O2 = OO + 1024;
    const float lg = ret_log2g(head);
    __syncthreads();
    for (int idx = tid; idx < 3072; idx += 512) { const int which = idx >> 10, i = (idx >> 7) & 7, d = idx & 127;
        const float v = bf2f(F.PROJ()[(size_t)(TP + b * 8 + i) * NIN + (which == 0 ? 768 : which == 1 ? 1280 : 1792) + head * 128 + d]);
        (which == 0 ? Q : which == 1 ? Ks : V)[i * 128 + d] = which == 1 ? v * KSC : v; }
    __syncthreads();
    if (tid < 64) { const int i = tid >> 3, j = tid & 7; float dot = 0.f;
        for (int d = 0; d < 128; ++d) dot += Q[i * 128 + d] * Ks[j * 128 + d];
        INN[tid] = j <= i ? dot * exp2f(lg * (float)(i - j)) : 0.f; }
    {
        const int e4 = (tid & 31) * 4, dg = tid >> 5; f32x4 vv[8], o2[8];
#pragma unroll
        for (int j = 0; j < 8; ++j) { vv[j] = *(const LAS f32x4*)(V + j * 128 + e4) * exp2f(lg * (float)(7 - j)); o2[j] = (f32x4){0.f, 0.f, 0.f, 0.f}; }
        const float dc = exp2f(lg * 8.f);
        const float* S0 = A.in[I_SRET] + ((size_t)(b * 4 + head) * 128) * 128; float* S1 = F.out + O_SRET + ((size_t)(b * 4 + head) * 128) * 128;
        f32x4 sv[8];
#pragma unroll
        for (int dd = 0; dd < 8; ++dd) sv[dd] = *(const f32x4*)(S0 + (dg * 8 + dd) * 128 + e4);
#pragma unroll
        for (int dd = 0; dd < 8; ++dd) { const int d = dg * 8 + dd; const f32x4 s = sv[dd]; f32x4 sn = s * dc;
#pragma unroll
            for (int j = 0; j < 8; ++j) { o2[j] += Q[j * 128 + d] * s; sn += Ks[j * 128 + d] * vv[j]; }
            *(f32x4*)(S1 + d * 128 + e4) = sn; }
#pragma unroll
        for (int i = 0; i < 8; ++i) *(LAS f32x4*)(O2 + (dg * 8 + i) * 128 + e4) = o2[i];
    }
    __syncthreads();
    { const int e = tid & 127, ig = tid >> 7;
#pragma unroll
        for (int ii = 0; ii < 2; ++ii) { const int i = 2 * ig + ii; float o = 0.f;
#pragma unroll
            for (int dg = 0; dg < 16; ++dg) o += O2[(dg * 8 + i) * 128 + e];
            o *= exp2f(lg * (float)(i + 1));
            for (int j = 0; j <= i; ++j) o += INN[i * 8 + j] * V[j * 128 + e];
            OO[i * 128 + e] = o; } }
    __syncthreads();
    { const int i = w; const float a0 = OO[i * 128 + lane], a1 = OO[i * 128 + 64 + lane];
        const float mean = wave_sum(a0 + a1) * (1.f / 128.f); const float d0 = a0 - mean, d1 = a1 - mean;
        const float rstd = rsqrtf(wave_sum(d0 * d0 + d1 * d1) * (1.f / 128.f) + EPSN);
        const int tok = TP + b * 8 + i; const bf16* gp = F.PROJ() + (size_t)tok * NIN + 2304 + head * 128; bf16* op = F.MIX() + (size_t)tok * DM + 512 + head * 128; const float* rg = A.in[I_RG] + head * 128;
        const float g0 = bf2f(gp[lane]), g1 = bf2f(gp[64 + lane]);
        op[lane] = f2bf(d0 * rstd * rg[lane] * (g0 * pg8::sigm(g0))); op[64 + lane] = f2bf(d1 * rstd * rg[64 + lane] * (g1 * pg8::sigm(g1))); }
}

template <int PASS> DI void s5_phase(const Args& A, const Frame& F) {
    const int lane = F.lane, w = F.wave; const int gw = F.bid * NWAVES + w, NGW = F.G * NWAVES;
    LAS unsigned char* L = F.lds + w * 16896;
    const float* P = (const float*)(F.ws + WS_S5P); const bf16* BBt = (const bf16*)(F.ws + WS_S5P + S5_BBT); const bf16* CCt = (const bf16*)(F.ws + WS_S5P + S5_CCT);
    const int n = lane & 31, h = lane >> 5;
    const int nunits = PASS == 1 ? 64 * 128 : 2 * 64 * 128;
#pragma unroll 1
    for (int u = gw; u < nunits; u += NGW) {
        const bool sample = u >= 8192; const int uu = sample ? u - 8192 : u; const int g = uu & 63, cb = uu >> 6;
        const int tok0 = sample ? TP + cb * 8 : cb * 128, ntok = sample ? 8 : 128;
        const float lr = P[(S5_LAM >> 2) + 2 * (g * 64 + lane)], li = P[(S5_LAM >> 2) + 2 * (g * 64 + lane) + 1];
        float hr = 0.f, hi = 0.f;
        if (PASS == 2) { if (sample) { hr = A.in[I_S5R][(size_t)(cb * 64 + g) * 64 + lane]; hi = A.in[I_S5I][(size_t)(cb * 64 + g) * 64 + lane]; }
                         else { hr = F.S5H()[(size_t)(cb * 64 + g) * 128 + lane]; hi = F.S5H()[(size_t)(cb * 64 + g) * 128 + 64 + lane]; } }
        bf16x8 bbf[4];
#pragma unroll
        for (int qt = 0; qt < 4; ++qt) bbf[qt] = *(const bf16x8*)(BBt + (size_t)(g * 128 + 32 * qt + n) * 16 + 8 * h);
        bf16x8 cfh[8];
        if (PASS == 2) {
#pragma unroll
            for (int s = 0; s < 8; ++s) cfh[s] = *(const bf16x8*)(CCt + (size_t)(g * 16 + (n & 15)) * 128 + 16 * s + 8 * h); }
        bf16x8 dfr = (bf16x8){0, 0, 0, 0, 0, 0, 0, 0};
        if (PASS == 2) { const unsigned dbf = (unsigned)f2bf(A.in[I_DSK][g * 16 + (n & 15)]); const int jd = n < 16 ? (n & 15) - 8 * h : -100;
            u32x4 dw; dw.x = (jd == 0 ? dbf : 0u) | (jd == 1 ? dbf << 16 : 0u); dw.y = (jd == 2 ? dbf : 0u) | (jd == 3 ? dbf << 16 : 0u);
            dw.z = (jd == 4 ? dbf : 0u) | (jd == 5 ? dbf << 16 : 0u); dw.w = (jd == 6 ? dbf : 0u) | (jd == 7 ? dbf << 16 : 0u);
            dfr = __builtin_bit_cast(bf16x8, dw); }
        bf16x8 a4[4];
#pragma unroll
        for (int i = 0; i < 4; ++i) { a4[i] = (bf16x8){0, 0, 0, 0, 0, 0, 0, 0}; if (32 * i + n < ntok) a4[i] = *(const bf16x8*)(F.XN() + (size_t)(tok0 + 32 * i + n) * DM + g * 16 + 8 * h); }
        asm volatile("s_waitcnt vmcnt(0)" ::: "memory");
#pragma unroll
        for (int sti = 0; sti < 4; ++sti) { if (32 * sti < ntok) {
            const int st = 32 * sti;
            const int nv = ntok - st < 32 ? ntok - st : 32;
            const bf16x8 a = a4[sti];
#pragma unroll
            for (int qt = 0; qt < 4; ++qt) { const f32x16 cc = MFMA32(a, bbf[qt], zero16());
#pragma unroll
                for (int r = 0; r < 16; ++r) *(LAS float*)(L + crow(r, h) * 528 + 4 * (32 * qt + n)) = cc[r]; }
#pragma unroll 4
            for (int t = 0; t < nv; ++t) { const float br = *(LAS float*)(L + t * 528 + 4 * lane), bi = *(LAS float*)(L + t * 528 + 256 + 4 * lane);
                const float nr = lr * hr - li * hi + br, ni = lr * hi + li * hr + bi; hr = nr; hi = ni;
                if (PASS == 2) { *(LAS unsigned short*)(L + t * 528 + 2 * lane) = f2bf(hr); *(LAS unsigned short*)(L + t * 528 + 128 + 2 * lane) = f2bf(hi); } }
            if (PASS == 2) {
                f32x16 y = MFMA32(a, dfr, zero16());
#pragma unroll
                for (int s = 0; s < 8; ++s) { const bf16x8 hs = *(const LAS bf16x8*)(L + n * 528 + 32 * s + 16 * h); y = MFMA32(hs, cfh[s], y); }
                if (n < 16) {
#pragma unroll
                    for (int r = 0; r < 16; ++r) { const int t = crow(r, h);
                        if (t < nv) { const size_t o = (size_t)(tok0 + st + t) * DM + g * 16 + n; const float yy = y[r];
                            const float z = 0.7978845608028654f * (yy + 0.044715f * yy * yy * yy); F.MIX()[o] = f2bf(yy * pg8::sigm(2.f * z)); } } }
            }
        } }
        if (PASS == 1) { F.S5E()[(size_t)(cb * 64 + g) * 128 + lane] = hr; F.S5E()[(size_t)(cb * 64 + g) * 128 + 64 + lane] = hi; }
        else { if (sample) { F.out[O_SS5R + (size_t)(cb * 64 + g) * 64 + lane] = hr; F.out[O_SS5I + (size_t)(cb * 64 + g) * 64 + lane] = hi; }
               else if (cb == 127) { F.out[O_PS5R + g * 64 + lane] = hr; F.out[O_PS5I + g * 64 + lane] = hi; } }
    }
}
DI void s5_carry_phase(const Args& A, const Frame& F) {
    const int gt = F.bid * 512 + F.tid;
    if (gt < 4096) { const int g = gt >> 6, p = gt & 63; const float* P = (const float*)(F.ws + WS_S5P);
        const float ar = P[(S5_LAM128 >> 2) + 2 * gt], ai = P[(S5_LAM128 >> 2) + 2 * gt + 1]; float Hr = 0.f, Hi = 0.f;
#pragma unroll 8
        for (int c = 0; c < 128; ++c) { const size_t o = (size_t)(c * 64 + g) * 128 + p; F.S5H()[o] = Hr; F.S5H()[o + 64] = Hi;
            const float er = F.S5E()[o], ei = F.S5E()[o + 64]; const float nr = ar * Hr - ai * Hi + er, ni = ar * Hi + ai * Hr + ei; Hr = nr; Hi = ni; } }
}

#define XB_TMO      128
#define XB_XCNT(j)  (256  + 64 * (j))
#define XB_XSUB(j)  (1280 + 64 * (j))
#define XB_XGEN(j)  (2304 + 64 * (j))
#define XB_TOP      3328
#define XB_TOPGEN   3392
#define XCD_BAR_WORDS 3456
#define XB_SPIN_CAP (1u << 18)

__device__ __forceinline__ unsigned xb_ld(unsigned* p)              { return __hip_atomic_load(p, __ATOMIC_RELAXED, __HIP_MEMORY_SCOPE_AGENT); }
__device__ __forceinline__ unsigned xb_add(unsigned* p, unsigned v) { return __hip_atomic_fetch_add(p, v, __ATOMIC_RELAXED, __HIP_MEMORY_SCOPE_AGENT); }
__device__ __forceinline__ unsigned xb_xcc_id() { return (unsigned)__builtin_amdgcn_s_getreg((3 << 11) | 20) & 0xFu; }
#define XB_SPIN(cond, bar) do { unsigned _sp = 0; while (cond) { __builtin_amdgcn_s_sleep(1); \
    if ((++_sp & 255u) == 0u) { if (xb_ld(&(bar)[XB_TMO])) break; if (_sp > XB_SPIN_CAP) { atomicAdd(&(bar)[XB_TMO], 1u); break; } } } } while (0)

struct XcdBarrier {
    unsigned* bar; unsigned x;
    volatile LAS unsigned* st;
};

__device__ __forceinline__ XcdBarrier xcd_barrier_post(unsigned* bar, volatile LAS unsigned* st) {
    XcdBarrier b; b.bar = bar; b.x = xb_xcc_id(); b.st = st;
    if (threadIdx.x == 0) (void)xb_add(&bar[XB_XCNT(b.x)], 1u);
    return b;
}
__device__ __forceinline__ void xcd_barrier_complete(unsigned* bar, unsigned x, unsigned& nloc, unsigned& nx) {
    const unsigned G = gridDim.x * gridDim.y * gridDim.z;
    unsigned sum, cnt, mine, sp = 0u;
    for (;;) {
        sum = 0u; cnt = 0u; mine = 0u;
#pragma unroll
        for (unsigned j = 0; j < 16; ++j) { const unsigned c = xb_ld(&bar[XB_XCNT(j)]); sum += c; cnt += (c > 0u) ? 1u : 0u; mine = (j == x) ? c : mine; }
        if (sum == G) break;
        __builtin_amdgcn_s_sleep(1);
        if ((++sp & 255u) == 0u) { if (xb_ld(&bar[XB_TMO])) break; if (sp > XB_SPIN_CAP) { atomicAdd(&bar[XB_TMO], 1u); break; } }
    }
    nloc = mine > 0u ? mine : 1u; nx = cnt > 0u ? cnt : 1u;
}

__device__ __forceinline__ void xcd_barrier(const XcdBarrier& b) {
    asm volatile("s_waitcnt vmcnt(0)" ::: "memory");
    __syncthreads();
    if (threadIdx.x == 0) {
        unsigned* bar = b.bar;
        __builtin_amdgcn_s_waitcnt(0);
        unsigned nloc = b.st[0], nx = b.st[1];
        if (nloc == 0u) { xcd_barrier_complete(bar, b.x, nloc, nx); b.st[0] = nloc; b.st[1] = nx; }
        const unsigned old = xb_add(&bar[XB_XSUB(b.x)], 1u);
        const unsigned gen = old / nloc;
        if (old + 1u == (gen + 1u) * nloc) {
            __builtin_amdgcn_fence(__ATOMIC_RELEASE, "agent");
            asm volatile("s_waitcnt vmcnt(0)" ::: "memory");
            const unsigned og = xb_add(&bar[XB_TOP], 1u);
            const unsigned tg = og / nx;
            if (og + 1u == (tg + 1u) * nx) xb_add(&bar[XB_TOPGEN], 1u);
            else XB_SPIN(xb_ld(&bar[XB_TOPGEN]) == tg, bar);
            __builtin_amdgcn_fence(__ATOMIC_ACQUIRE, "");
            xb_add(&bar[XB_XGEN(b.x)], 1u);
            asm volatile("s_waitcnt vmcnt(0)" ::: "memory");
        } else {
            XB_SPIN(xb_ld(&bar[XB_XGEN(b.x)]) == gen, bar);
            __builtin_amdgcn_fence(__ATOMIC_ACQUIRE, "");
            asm volatile("s_waitcnt vmcnt(0)" ::: "memory");
        }
    }
    __syncthreads();
}

constexpr int NPHASE = 17;
__global__ void __launch_bounds__(NWAVES * 64, 2) mega_fwd(Args args) {
    extern __shared__ __attribute__((aligned(16))) unsigned char lds_raw[];
    cg::grid_group grid = cg::this_grid();
    Frame F;
    F.lds = (LAS unsigned char*)lds_raw; F.tid = threadIdx.x; F.lane = F.tid & 63; F.wave = __builtin_amdgcn_readfirstlane(F.tid >> 6); F.G = gridDim.x; F.bid = blockIdx.x;
    F.out = args.out; F.ws = args.ws;
    const int lo = args.ph_lo, hi = args.ph_hi;
    volatile LAS unsigned* misc_ = (volatile LAS unsigned*)(F.lds + LDS_BYTES - 64);
    if (F.tid < 16) misc_[F.tid] = 0u;
    __syncthreads();
    const XcdBarrier xbar_ = xcd_barrier_post((unsigned*)args.ws, misc_);
    if (lo < 0) grid.sync();
#define GSYNC() xcd_barrier(xbar_)
    float* XR = F.out + O_Y;
#ifndef PHMASK
#define PHMASK 0xfffffu
#endif
#define IN(k) (((PHMASK >> (k)) & 1u) && lo <= (k) && (k) < hi)
#define SEAM(k) do { if (IN(k) && IN((k) + 1)) GSYNC(); } while (0)
#ifndef RPTMASK
#define RPTMASK 0u
#endif
#ifndef XSYNC
#define XSYNC 0
#endif
#define RPT(k) (((RPTMASK >> (k)) & 1u) ? 2 : 1)
#define RB(k) for (int rep_ = 0; rep_ < RPT(k); ++rep_) { if (rep_) GSYNC();
#define RE }
#define GEMM_SPLIT(g, E, nM_, nN_, S__) do { pg8::SplitOrder S_; S_.init(nM_, nN_, S__, F.G, (int)blockIdx.x); pg8::gemm_phase<pg8::EpiPartial, pg8::SplitOrder, true, true>(F.lds, g, S_, E); } while (0)
#define GEMM_PHASE(EPI, g, E) do { pg8::StaticOrder S_; S_.init((g).M, (g).N, F.G, (int)blockIdx.x); pg8::gemm_phase<EPI, pg8::StaticOrder, true, true>(F.lds, g, S_, E); } while (0)

    if (IN(0)) { RB(0)  p0_prologue(args, F);  RE } SEAM(0);
    if (IN(1)) { RB(1)  pg8::Gemm g{F.CA(), F.Wada_t(), 256, NMOD, 1024}; pg8::EpiF32Bias E{F.MOD(), NMOD, args.in[I_ADAB]}; GEMM_PHASE(pg8::EpiF32Bias, g, E);  RE } SEAM(1);
    if (IN(2)) { RB(2)  norm_phase(args, F, args.in[I_XP], args.in[I_XS], args.in[I_NMIX], F.MOD(), 0, 1024);  RE } SEAM(2);
    if (IN(3)) { RB(3)  pg8::Gemm g{F.XN(), F.Win_t(), MT, NIN, 1024}; pg8::EpiBf16<0> E{F.PROJ(), NIN, nullptr, 0, 0, 1.f}; GEMM_PHASE(pg8::EpiBf16<0>, g, E);  RE } SEAM(3);
    if (IN(4)) { RB(4)
#ifndef P4SEL
#define P4SEL 7
#endif
        if (P4SEL & 1) for (int u = F.bid; u < 512; u += F.G) attn_unit<false>(args, F, u);
        if (P4SEL & 2) for (int u = (F.bid + 128) % F.G; u < 128; u += F.G) attn_unit<true>(args, F, u);
        if (P4SEL & 4) for (int u = F.bid; u < 512; u += F.G) ret_kv_unit(args, F, u);
        __syncthreads();
    RE } SEAM(4);
    if (IN(5)) { RB(5)  ret_scan_phase(args, F);  RE } SEAM(5);
    if (IN(6)) { RB(6)  if (F.bid < 64) pret_transpose_tile(args, F, F.bid);
        for (int u = F.bid; u < 768; u += F.G) { if (u < 256) ret_out_prompt(args, F, u); else ret_sample_unit(args, F, u - 256); } __syncthreads();  RE } SEAM(6);
    if (IN(7)) { RB(7)  { pg8::Gemm g{F.MIX(), F.Wout_t(), TP, 1024, 1024, 0}; pg8::EpiResid E{args.in[I_XP], args.in[I_XS], XR, F.MOD() + 2048}; GEMM_PHASE(pg8::EpiResid, g, E); }
        { pg8::Gemm g{F.MIX() + (size_t)TP * DM, F.Wout_t(), TS, 1024, 256, 1024}; pg8::EpiPartial E{(bf16*)(F.ws + WS_PART0), TS, 0}; GEMM_SPLIT(g, E, 4, 4, 4); }  RE } SEAM(7);
    if (IN(8)) { RB(8)  norm_phase(args, F, XR, args.in[I_XS], args.in[I_NFFN], F.MOD(), 3072, 4096, (const bf16*)(F.ws + WS_PART0), 4, F.MOD() + 2048, XR);  RE } SEAM(8);
    if (IN(9)) { RB(9)  pg8::Gemm g{F.XN(), F.Wgu_t(0), MT, 2 * DFF, 1024}; pg8::EpiSwiGLU E{F.PROJ(), DFF}; GEMM_PHASE(pg8::EpiSwiGLU, g, E);  RE } SEAM(9);
    if (IN(10)) { RB(10)  { pg8::Gemm g{F.PROJ(), F.Wd_t(0), TP, 1024, DFF, 0}; pg8::EpiResid E{XR, XR + (size_t)TP * DM, XR, F.MOD() + 5120}; GEMM_PHASE(pg8::EpiResid, g, E); }
        { pg8::Gemm g{F.PROJ() + (size_t)TP * DFF, F.Wd_t(0), TS, 1024, 256, DFF}; pg8::EpiPartial E{F.MIX(), TS, 0}; GEMM_SPLIT(g, E, 4, 4, 11); }  RE } SEAM(10);
    if (IN(11)) { RB(11)  norm_phase(args, F, XR, XR + (size_t)TP * DM, args.in[I_NMIX] + 1024, F.MOD() + LMOD, 0, 1024, F.MIX(), 11, F.MOD() + 5120, XR);  RE } SEAM(11);
    if (IN(12)) { RB(12)  s5_phase<1>(args, F);  RE } SEAM(12);
    if (IN(13)) { RB(13)  s5_carry_phase(args, F);  RE } SEAM(13);
    if (IN(14)) { RB(14)  s5_phase<2>(args, F);  RE } SEAM(14);
    if (IN(15)) { RB(15)  { pg8::Gemm g{F.MIX(), F.Wglu_t(), TP, 2048, 1024, 0}; pg8::EpiGLUResid E{XR, F.MOD() + LMOD + 2048}; GEMM_PHASE(pg8::EpiGLUResid, g, E); }
        { pg8::Gemm g{F.MIX() + (size_t)TP * DM, F.Wglu_t(), TS, 2048, 256, 1024}; pg8::EpiPartial E{(bf16*)(F.ws + WS_PART0), TS, 2048}; GEMM_SPLIT(g, E, 4, 8, 4); }  RE } SEAM(15);
    if (IN(16)) { RB(16)  norm_phase(args, F, XR, XR + (size_t)TP * DM, args.in[I_NFFN] + 1024, F.MOD() + LMOD, 3072, 4096, nullptr, 4, F.MOD() + LMOD + 2048, XR, (const bf16*)(F.ws + WS_PART0));  RE } SEAM(16);
    if (IN(17)) { RB(17)  pg8::Gemm g{F.XN(), F.Wgu_t(1), MT, 2 * DFF, 1024}; pg8::EpiSwiGLU E{F.PROJ(), DFF}; GEMM_PHASE(pg8::EpiSwiGLU, g, E);  RE } SEAM(17);
    if (IN(18)) { { pg8::Gemm g{F.PROJ(), F.Wd_t(1), TP, 1024, DFF, 0}; pg8::EpiResid E{XR, XR + (size_t)TP * DM, XR, F.MOD() + LMOD + 5120}; GEMM_PHASE(pg8::EpiResid, g, E); }
        { pg8::Gemm g{F.PROJ() + (size_t)TP * DFF, F.Wd_t(1), TS, 1024, 256, DFF}; pg8::EpiPartial E{F.MIX(), TS, 0}; GEMM_SPLIT(g, E, 4, 4, 11); } } SEAM(18);
    if (IN(19)) {
        const int gw = F.bid * NWAVES + F.wave, NGW = F.G * NWAVES; const bf16* part = F.MIX();
        for (int m = TP + gw; m < MT; m += NGW) { const float* grow = F.MOD() + LMOD + 5120 + (size_t)pg8::seq_of_row(m) * NMOD;
#pragma unroll
            for (int j = 0; j < 4; ++j) { const int col = 4 * (64 * j + F.lane); const size_t po = (size_t)(m - TP) * 1024 + col; f32x4 ps = (f32x4){0.f, 0.f, 0.f, 0.f};
                for (int sl = 0; sl < 11; ++sl) { const u32x2 w = *(const u32x2*)(part + (size_t)sl * TS * 1024 + po); ps += (f32x4){bflo(w.x), bfhi(w.x), bflo(w.y), bfhi(w.y)}; }
                *(f32x4*)(XR + (size_t)m * DM + col) = *(const f32x4*)(XR + (size_t)m * DM + col) + *(const f32x4*)(grow + col) * ps; } }
    }
#undef IN
#undef SEAM
}

extern "C" void kernel_launch(void* const* d_in, const int* in_sizes, int n_in, void* d_out, int out_size, void* d_ws, size_t ws_size, hipStream_t stream) {
    static int grid = 0;
    if (grid == 0) {
        if (n_in != 32 || (size_t)out_size != O_END || ws_size < WS_END) { fprintf(stderr, "kernel_launch: unexpected shapes n_in %d out %d ws %zu\n", n_in, out_size, ws_size); grid = -1; return; }
        int dev = 0, cus = 0, per_cu = 0;
        hipGetDevice(&dev); hipDeviceGetAttribute(&cus, hipDeviceAttributeMultiprocessorCount, dev);
        hipFuncSetAttribute((const void*)mega_fwd, hipFuncAttributeMaxDynamicSharedMemorySize, LDS_BYTES);
        hipOccupancyMaxActiveBlocksPerMultiprocessor(&per_cu, (const void*)mega_fwd, NWAVES * 64, LDS_BYTES);
        if (per_cu < 1) { fprintf(stderr, "kernel_launch: occupancy query says %d blocks/CU\n", per_cu); per_cu = 1; }
        (void)hipGetLastError();
        grid = cus;
    }
    if (grid < 0) return;
    if (hipMemsetAsync(d_ws, 0, 65536, stream) != hipSuccess) { fprintf(stderr, "kernel_launch: memset failed\n"); return; }
    Args a{};
    for (int i = 0; i < 32; ++i) a.in[i] = (const float*)d_in[i];
    a.out = (float*)d_out; a.ws = (unsigned char*)d_ws; a.ph_lo = 0; a.ph_hi = 20;
    void* kargs[] = {&a};
    hipError_t e = hipLaunchCooperativeKernel((const void*)mega_fwd, dim3(grid), dim3(NWAVES * 64), kargs, LDS_BYTES, stream);
    if (e != hipSuccess) fprintf(stderr, "cooperative launch failed: %s (grid %d)\n", hipGetErrorString(e), grid);
}
```
